# Optimizing an MI355X kernel written in HIP

```python
import jax
import jax.numpy as jnp
from jax import lax
import numpy as np

D_MODEL = 2048
BATCH = 2
SEQ = 8192
DEPTH = 1

CHUNK = 64
EPS = 1e-6
NEG_INF = -1e30
GMLP_BLOCK = 128
GMLP_GROUPS = 8
GMLP_WIDTH = 1024
GMLP_GROUP_DIM = GMLP_WIDTH // GMLP_GROUPS
ATT_HEADS = 16
ATT_HEAD_DIM = 64
ATT_WIDTH = ATT_HEADS * ATT_HEAD_DIM
LEFT_CHUNKS = 8
BAND = LEFT_CHUNKS + 1
MAX_REL = 256
N_BRANCH = 2
IN_COLS = 2 * GMLP_WIDTH + 3 * ATT_WIDTH + N_BRANCH * D_MODEL
N_GROUPS = 4
EXPERTS_PER_GROUP = 8
TOP_K = 2
D_EXPERT = 512
N_MOD = 6

kernel_name = 'hybrid_gmlp_bandattn_hmoe_adaln'


def _rmsnorm(x, g):
    xf = x.astype(jnp.float32)
    y = xf * lax.rsqrt(jnp.mean(xf * xf, axis=-1, keepdims=True) + EPS)
    return (y * g.astype(jnp.float32)).astype(x.dtype)


def _layernorm(x, g, b):
    xf = x.astype(jnp.float32)
    mu = jnp.mean(xf, axis=-1, keepdims=True)
    var = jnp.mean(jnp.square(xf - mu), axis=-1, keepdims=True)
    y = (xf - mu) * lax.rsqrt(var + EPS)
    return (y * g.astype(jnp.float32) + b.astype(jnp.float32)).astype(x.dtype)


def _gmlp_mask():
    pos = np.arange(GMLP_BLOCK)
    return (pos[None, :] // CHUNK) <= (pos[:, None] // CHUNK)


def _rel_index():
    i = np.arange(CHUNK)[:, None, None]
    j = np.arange(BAND)[None, :, None]
    l = np.arange(CHUNK)[None, None, :]
    dist = (LEFT_CHUNKS - j) * CHUNK + i - l
    return (np.clip(dist, -MAX_REL, MAX_REL) + MAX_REL).reshape(CHUNK, BAND * CHUNK).astype(np.int32)


def _spatial_gating(u, v, w_s, b_s, ln_g, ln_b):
    b, s, _ = v.shape
    nb = s // GMLP_BLOCK
    v = _layernorm(v, ln_g, ln_b).reshape(b, nb, GMLP_BLOCK, GMLP_GROUPS, GMLP_GROUP_DIM)
    w = jnp.where(jnp.asarray(_gmlp_mask())[None], w_s, jnp.zeros_like(w_s))
    mixed = jnp.einsum('gts,bnsgc->bntgc', w, v) + b_s.T[:, :, None]
    return u * mixed.reshape(b, s, GMLP_WIDTH)


def _band_attention(q, k, v, rel_table):
    b, s, h, dh = q.shape
    nc = s // CHUNK
    q = q.reshape(b, nc, CHUNK, h, dh)
    pad = ((0, 0), (LEFT_CHUNKS, 0), (0, 0), (0, 0), (0, 0))
    kp = jnp.pad(k.reshape(b, nc, CHUNK, h, dh), pad)
    vp = jnp.pad(v.reshape(b, nc, CHUNK, h, dh), pad)
    scores = jnp.concatenate(
        [jnp.einsum('bcqhd,bckhd->bhcqk', q, kp[:, j:j + nc]) for j in range(BAND)],
        axis=-1).astype(jnp.float32)
    bias = rel_table.astype(jnp.float32)[:, jnp.asarray(_rel_index())]
    scores = scores * (dh ** -0.5) + bias[None, :, None]
    key_chunk = jnp.arange(nc)[:, None] + jnp.arange(BAND)[None, :] - LEFT_CHUNKS
    key_valid = jnp.repeat(key_chunk >= 0, CHUNK, axis=1)
    scores = jnp.where(key_valid[None, None, :, None, :], scores, NEG_INF)
    probs = jax.nn.softmax(scores, axis=-1).astype(v.dtype).reshape(b, h, nc, CHUNK, BAND, CHUNK)
    out = jnp.einsum('bhcqk,bckhd->bcqhd', probs[:, :, :, :, 0], vp[:, 0:nc])
    for j in range(1, BAND):
        out = out + jnp.einsum('bhcqk,bckhd->bcqhd', probs[:, :, :, :, j], vp[:, j:j + nc])
    return out.reshape(b, s, h * dh)


def _hierarchical_moe(h, w_group, w_expert, w1, w3, w2):
    g_logits = (h @ w_group).astype(jnp.float32)
    g_probs = jax.nn.softmax(g_logits, axis=-1)
    _, g_idx = lax.top_k(g_logits, 1)
    g_onehot = jax.nn.one_hot(g_idx[:, 0], N_GROUPS, dtype=jnp.float32)
    g_weight = jnp.sum(g_probs * g_onehot, axis=-1, keepdims=True)
    e_logits = jnp.einsum('nd,gde->nge', h, w_expert).astype(jnp.float32)
    e_sel = jnp.einsum('nge,ng->ne', e_logits, g_onehot)
    e_top, e_idx = lax.top_k(e_sel, TOP_K)
    e_w = jax.nn.softmax(e_top, axis=-1)
    e_weight = jnp.einsum('nk,nke->ne', e_w, jax.nn.one_hot(e_idx, EXPERTS_PER_GROUP, dtype=jnp.float32))
    combine = ((g_weight * g_onehot)[:, :, None] * e_weight[:, None, :]).astype(h.dtype)
    out = jnp.zeros_like(h)
    for g in range(N_GROUPS):
        a = jnp.einsum('nd,edf->nef', h, w1[g])
        bgate = jnp.einsum('nd,edf->nef', h, w3[g])
        act = jax.nn.silu(a) * bgate * combine[:, g, :, None]
        out = out + jnp.einsum('nef,efd->nd', act, w2[g])
    return out


def setup_inputs(seed: int = 0) -> dict:
    key = jax.random.key(seed)
    ks = jax.random.split(key, 24)
    f32 = jnp.float32
    L, D = DEPTH, D_MODEL

    def nrm(k, shape, scale):
        return jax.random.normal(k, shape, f32) * scale

    return {
        'x': nrm(ks[0], (BATCH, SEQ, D), 1.0),
        'c': nrm(ks[1], (BATCH, D), 1.0),
        'ada_w': nrm(ks[2], (L, D, N_MOD * D), 0.5 * D ** -0.5),
        'ada_b': nrm(ks[3], (L, N_MOD * D), 0.02),
        'norm1_g': 1.0 + nrm(ks[4], (L, D), 0.1),
        'w_in': nrm(ks[5], (L, D, IN_COLS), D ** -0.5),
        'gmlp_ln_g': 1.0 + nrm(ks[6], (L, GMLP_WIDTH), 0.1),
        'gmlp_ln_b': nrm(ks[7], (L, GMLP_WIDTH), 0.02),
        'gmlp_w_s': nrm(ks[8], (L, GMLP_GROUPS, GMLP_BLOCK, GMLP_BLOCK), GMLP_BLOCK ** -0.5),
        'gmlp_b_s': 1.0 + nrm(ks[9], (L, GMLP_GROUPS, GMLP_BLOCK), 0.1),
        'rel_bias': nrm(ks[10], (L, ATT_HEADS, 2 * MAX_REL + 1), 0.5),
        'w_branch_a': nrm(ks[11], (L, GMLP_WIDTH, D), GMLP_WIDTH ** -0.5),
        'w_branch_b': nrm(ks[12], (L, ATT_WIDTH, D), ATT_WIDTH ** -0.5),
        'w_out': nrm(ks[13], (L, D, D), D ** -0.5),
        'norm2_g': 1.0 + nrm(ks[14], (L, D), 0.1),
        'w_group': nrm(ks[15], (L, D, N_GROUPS), D ** -0.5),
        'w_expert': nrm(ks[16], (L, N_GROUPS, D, EXPERTS_PER_GROUP), D ** -0.5),
        'w1': nrm(ks[17], (L, N_GROUPS, EXPERTS_PER_GROUP, D, D_EXPERT), D ** -0.5),
        'w3': nrm(ks[18], (L, N_GROUPS, EXPERTS_PER_GROUP, D, D_EXPERT), D ** -0.5),
        'w2': nrm(ks[19], (L, N_GROUPS, EXPERTS_PER_GROUP, D_EXPERT, D), D_EXPERT ** -0.5),
        'final_g': 1.0 + nrm(ks[20], (D,), 0.1),
    }


def reference(x, c, ada_w, ada_b, norm1_g, w_in, gmlp_ln_g, gmlp_ln_b, gmlp_w_s, gmlp_b_s,
              rel_bias, w_branch_a, w_branch_b, w_out, norm2_g, w_group, w_expert, w1, w3, w2,
              final_g):
    b, s, d = x.shape
    cut = [GMLP_WIDTH, 2 * GMLP_WIDTH, 2 * GMLP_WIDTH + ATT_WIDTH,
           2 * GMLP_WIDTH + 2 * ATT_WIDTH, 2 * GMLP_WIDTH + 3 * ATT_WIDTH]
    for layer in range(DEPTH):
        mod = jax.nn.silu(c) @ ada_w[layer] + ada_b[layer]
        shift1, scale1, gate1, shift2, scale2, gate2 = jnp.split(mod[:, None, :], N_MOD, axis=-1)

        h = _rmsnorm(x, norm1_g[layer]) * (1 + scale1) + shift1
        proj = h @ w_in[layer]
        u_a, v_a, q, k, v_b, gates = jnp.split(proj, cut, axis=-1)
        y_a = _spatial_gating(jax.nn.gelu(u_a, approximate=False), jax.nn.gelu(v_a, approximate=False),
                              gmlp_w_s[layer], gmlp_b_s[layer], gmlp_ln_g[layer], gmlp_ln_b[layer])
        y_a = y_a @ w_branch_a[layer]
        hs = (b, s, ATT_HEADS, ATT_HEAD_DIM)
        y_b = _band_attention(q.reshape(hs), k.reshape(hs), v_b.reshape(hs), rel_bias[layer])
        y_b = y_b @ w_branch_b[layer]
        gate_a, gate_b = jnp.split(jax.nn.sigmoid(gates), N_BRANCH, axis=-1)
        mixed = (gate_a * y_a + gate_b * y_b) @ w_out[layer]
        x = x + gate1 * mixed

        h = _rmsnorm(x, norm2_g[layer]) * (1 + scale2) + shift2
        y = _hierarchical_moe(h.reshape(b * s, d), w_group[layer], w_expert[layer],
                              w1[layer], w3[layer], w2[layer]).reshape(b, s, d)
        x = x + gate2 * y
    return _rmsnorm(x, final_g)
```

```cpp
#include <hip/hip_runtime.h>
#include <cstdio>
#include <cstdint>

#ifndef GMLP_ITEMS
#define GMLP_ITEMS 0
#endif
constexpr int D = 2048, NB = 2, SEQ = 8192, M = NB * SEQ;
constexpr int NCOLS = 9216, GW = 1024, AW = 1024, NH = 16, HD = 64;
constexpr int NEXP = 32, FE = 512, NMOD = 6 * D;
constexpr int MAXRT = 160, MPAD = MAXRT * 256;
constexpr float EPS = 1e-6f;
constexpr float LOG2E = 1.4426950408889634f;
constexpr float QSCALE = 0.125f * LOG2E;

constexpr size_t MiB = 1u << 20;
constexpr size_t WS_CTL = 0, CTL_BYTES = 1 * MiB;
constexpr size_t WS_MODP = 1 * MiB;
constexpr size_t WS_MOD = 4 * MiB;
constexpr size_t WS_HSC = 4 * MiB + 512 * 1024;
constexpr size_t WS_CS = WS_HSC + 64 * 1024;
constexpr size_t WS_WSB = WS_HSC + 128 * 1024;
constexpr size_t WS_COLMAX_O = WS_CTL + 576 * 1024;
constexpr size_t WS_CSO = WS_HSC + 112 * 1024;
constexpr size_t WS_SM = WS_HSC;
constexpr size_t WS_COLMAX = WS_CTL + 512 * 1024;
constexpr size_t WS_TOKLIST = 5 * MiB;
constexpr size_t WS_SLOTE = 7 * MiB;
constexpr size_t WS_SLOTW = 7 * MiB + 256 * 1024;
constexpr size_t WS_WRT = 7 * MiB + 512 * 1024;
constexpr size_t WS_WIN_T = 8 * MiB;
constexpr size_t WS_WA_T = 44 * MiB;
constexpr size_t WS_WB_T = 48 * MiB;
constexpr size_t WS_WOUT_T = 52 * MiB;
constexpr size_t WS_W13_T = 60 * MiB;
constexpr size_t WS_W2_T = 188 * MiB;
constexpr size_t WS_H = 252 * MiB;
constexpr size_t WS_YA8 = WS_H, WS_YB8 = WS_H + 16 * MiB;
constexpr size_t WS_U = 316 * MiB;
constexpr size_t WS_V = 348 * MiB;
constexpr size_t WS_Q = 380 * MiB;
constexpr size_t WS_K = 412 * MiB;
constexpr size_t WS_VT = 444 * MiB;
constexpr size_t WS_G = 476 * MiB;
constexpr size_t WS_MIX = 604 * MiB;
constexpr size_t WS_END = 668 * MiB;
constexpr size_t WS_X1B = 540 * MiB;
constexpr size_t WS_ROWW = WS_MIX;
constexpr size_t WS_ACT = WS_U;
constexpr size_t WS_YS = WS_U + 40 * MiB;
static_assert(WS_YS + (size_t)MPAD * D * 2 <= WS_X1B && WS_X1B + (size_t)M * D * 2 <= WS_MIX && WS_X1B >= WS_G, "MoE buffers overlay the dead mixer buffers");
constexpr int CW_TMO = 0, CW_CODE = 1, CW_CNT = 1024  , CW_BAR = 4096;

typedef unsigned short bf16_t;
typedef float f32x4 __attribute__((ext_vector_type(4)));
typedef float f32x2 __attribute__((ext_vector_type(2)));
typedef unsigned u32x4 __attribute__((ext_vector_type(4)));
typedef unsigned u32x2 __attribute__((ext_vector_type(2)));
#define LAS __attribute__((address_space(3)))

__device__ __forceinline__ int fresh_lane() { int l; asm volatile("v_mbcnt_lo_u32_b32 %0, -1, 0\n\tv_mbcnt_hi_u32_b32 %0, -1, %0" : "=v"(l)); return l; }
__device__ __forceinline__ float bf2f(bf16_t v) { return __uint_as_float(((unsigned)v) << 16); }
__device__ __forceinline__ unsigned f2bf(float f) { unsigned u = __float_as_uint(f); return (u + 0x7fffu + ((u >> 16) & 1u)) >> 16; }
typedef __bf16 bf16x2v_t __attribute__((ext_vector_type(2)));
__device__ __forceinline__ unsigned pk2(float lo, float hi) { f32x2 v = {lo, hi}; bf16x2v_t b = __builtin_convertvector(v, bf16x2v_t); return __builtin_bit_cast(unsigned, b); }
__device__ __forceinline__ float clamp448(float x) { return __builtin_fminf(__builtin_fmaxf(x, -448.f), 448.f); }
__device__ __forceinline__ unsigned pk4_f8(float a, float b, float c, float d) {
    const unsigned w = __builtin_amdgcn_cvt_pk_fp8_f32(clamp448(a), clamp448(b), 0, false); return __builtin_amdgcn_cvt_pk_fp8_f32(clamp448(c), clamp448(d), w, true); }
constexpr float F8_SW = 256.f, F8_SH2 = 16.f, F8_SACT = 8.f, F8_SY = 16.f;
__device__ __forceinline__ float wave_max(float v) {
#pragma unroll
    for (int o = 32; o > 0; o >>= 1) v = fmaxf(v, __shfl_xor(v, o, 64));
    return v; }
constexpr float I8MAGIC = 12582912.f;
__device__ __forceinline__ unsigned pack4_i8(unsigned a, unsigned b, unsigned c, unsigned d) { return (a & 0xffu) | ((b & 0xffu) << 8) | ((c & 0xffu) << 16) | (d << 24); }
__device__ __forceinline__ float wave_sum(float v) {
#pragma unroll
    for (int o = 1; o < 64; o <<= 1) v += __shfl_xor(v, o);
    return v;
}
__device__ __forceinline__ float gelu_erf(float x) { return 0.5f * x * (1.0f + erff(x * 0.70710678118654752f)); }
__device__ __forceinline__ float sigmoidf_(float x) { return 1.0f / (1.0f + __expf(-x)); }
__device__ __forceinline__ float siluf_(float x) { return x / (1.0f + __expf(-x)); }

struct Params {
    const float* in[21];
    float* out;
    unsigned char* ws;
    int ph_lo, ph_hi;
    unsigned char* alt;
    float* altg;
};
enum { I_X = 0, I_C, I_ADAW, I_ADAB, I_N1G, I_WIN, I_LNG, I_LNB, I_WS, I_BS, I_REL, I_WA, I_WB, I_WOUT, I_N2G, I_WGRP, I_WEXP, I_W1, I_W3, I_W2, I_FING };

struct MoeTab { LAS int* tb; LAS int* cn; LAS int* rte; };
__device__ __forceinline__ void build_tables(const unsigned* ctl, const MoeTab& T, int tid) {
    if (tid == 0) {
        int acc = 0;
        for (int e = 0; e < NEXP; ++e) {
            const int c = (int)__hip_atomic_load(ctl + CW_CNT + 64 * e, __ATOMIC_RELAXED, __HIP_MEMORY_SCOPE_AGENT);
            T.cn[e] = c; T.tb[e] = acc; const int nt = (c + 255) >> 8;
            for (int t = 0; t < nt; ++t) T.rte[acc + t] = e;
            acc += nt;
        }
        T.tb[NEXP] = acc;
    }
    __syncthreads();
}

namespace pg8 {
typedef short bf16x8 __attribute__((ext_vector_type(8)));
typedef int i32x4 __attribute__((ext_vector_type(4)));
typedef int i32x8 __attribute__((ext_vector_type(8)));
constexpr int BM = 256, BK = 64, HALF = 128, HTB = HALF * BK * 2, STAGE_BYTES = 8 * HTB;
__device__ __forceinline__ int lds_byte(int r, int c) { const int st = (r >> 4) * 2 + (c >> 5), rr = r & 15, cc = c & 31, ob = rr * 64 + cc * 2; return st * 1024 + (ob ^ (((ob >> 9) & 1) << 5)); }
__device__ __forceinline__ void stage_rc(int b, int& R, int& C) { const int st = b / 1024, sb = b % 1024, swz = sb ^ (((sb >> 9) & 1) << 5); R = (st >> 1) * 16 + swz / 64; C = (st & 1) * 32 + (swz % 64) / 2; }
__device__ __forceinline__ int perm32(int rho) { const int n = rho >> 4, i = rho & 15; return 8 * (i >> 2) + 4 * n + (i & 3); }
struct Unit { const char* A; const char* B; int pm, pn, aux, aux2; };
typedef __bf16 bf16x2_t __attribute__((ext_vector_type(2)));
__device__ __forceinline__ unsigned cvt_pk_bf16(float lo, float hi) { f32x2 v = {lo, hi}; bf16x2_t b = __builtin_convertvector(v, bf16x2_t); return __builtin_bit_cast(unsigned, b); }
__device__ __forceinline__ f32x2 gelu_pk(f32x2 v) {
    const f32x2 av = __builtin_elementwise_abs(v), d = av * 0.2316418882f + 1.0f;
    f32x2 t; t.x = __builtin_amdgcn_rcpf(d.x); t.y = __builtin_amdgcn_rcpf(d.y);
    f32x2 q = t * 0.5307027145f + (-0.7265760135f); q = q * t + 0.7107068705f; q = q * t + (-0.142248368f); q = q * t + 0.127414796f; q = q * t;
    const f32x2 s = (v * v) * (-0.72134752044f);
    f32x2 e; e.x = __builtin_amdgcn_exp2f(s.x); e.y = __builtin_amdgcn_exp2f(s.y);
    const f32x2 m = v * (q * e), r = v - m;
    f32x2 o; o.x = v.x < 0.f ? m.x : r.x; o.y = v.y < 0.f ? m.y : r.y; return o;
}
__device__ __forceinline__ bool static_tile(int L, int nM, int nN, int& pm, int& pn) {
    const int nwg = nM * nN; if (L >= nwg) return false;
    int wgid = L; { const int q = nwg / 8, r = nwg % 8, xcd = wgid % 8, off = wgid / 8; wgid = (xcd < r ? xcd * (q + 1) : r * (q + 1) + (xcd - r) * q) + off; }
    const int nig = 8 * nN, gid = wgid / nig, fm = gid * 8, gsz = (nM - fm) < 8 ? (nM - fm) : 8;
    pm = fm + ((wgid % nig) % gsz); pn = (wgid % nig) / gsz; return true;
}

template <class Epi, class Sched>
__device__ __forceinline__ void gemm_phase(LAS unsigned char* lds, const int K, const Sched& S, const Epi& E, const int wid) {
    const int lane = fresh_lane(), tid = wid * 64 + lane, wr = wid >> 2, wc = wid & 3, fr = lane & 15, fq = lane >> 4;
    const int nt = K / BK;
    int R[2], C[2]; unsigned voffB[2];
#pragma unroll
    for (int i = 0; i < 2; ++i) { stage_rc(tid * 16 + i * 8192, R[i], C[i]); const int Rb = Epi::PERM ? ((R[i] & ~31) + perm32(R[i] & 31)) : R[i]; voffB[i] = (unsigned)(Rb * K + C[i]) * 2u; }
    const size_t kstep = (size_t)(BK * 2);
    const size_t hstep = (size_t)HALF * K * 2;
    const unsigned ldsw = (unsigned)wid * 1024u;
    const int aoff = lds_byte(wr * 64 + fr, fq * 8), boff = lds_byte(wc * 32 + fr, fq * 8);
#define PG8_SA(b, h) (((b) * 2 + (h)) * HTB)
#define PG8_SB(b, h) ((4 + (b) * 2 + (h)) * HTB)
#define PG8_STAGE(bufoff, gbase, voff) do { _Pragma("unroll") for (int _i = 0; _i < 2; ++_i) \
        __builtin_amdgcn_global_load_lds((const unsigned*)((const char*)(gbase) + (voff)[_i]), (LAS unsigned*)(lds + (bufoff) + ldsw + _i * 8192), 16, 0, 0); } while (0)
#define PG8_LDA(dst, b, h) do { if constexpr (Epi::MODE == 2) { _Pragma("unroll") for (int m = 0; m < 4; ++m) dst##8[m] = __builtin_shufflevector(*(const LAS i32x4*)(lds + PG8_SA(b, h) + aoff + m * 2048), *(const LAS i32x4*)(lds + PG8_SA(b, h) + aoff + m * 2048 + 1024), 0, 1, 2, 3, 4, 5, 6, 7); } \
        else { _Pragma("unroll") for (int m = 0; m < 4; ++m) _Pragma("unroll") for (int k = 0; k < 2; ++k) dst[m][k] = *(const LAS bf16x8*)(lds + PG8_SA(b, h) + aoff + m * 2048 + k * 1024); } } while (0)
#define PG8_LDB(dst, b, h) do { if constexpr (Epi::MODE == 2) { _Pragma("unroll") for (int n = 0; n < 2; ++n) dst##8[n] = __builtin_shufflevector(*(const LAS i32x4*)(lds + PG8_SB(b, h) + boff + n * 2048), *(const LAS i32x4*)(lds + PG8_SB(b, h) + boff + n * 2048 + 1024), 0, 1, 2, 3, 4, 5, 6, 7); } \
        else { _Pragma("unroll") for (int n = 0; n < 2; ++n) _Pragma("unroll") for (int k = 0; k < 2; ++k) dst[n][k] = *(const LAS bf16x8*)(lds + PG8_SB(b, h) + boff + n * 2048 + k * 1024); } } while (0)
#define PG8_MMA(ai, bj, At, Bt) do { __builtin_amdgcn_s_setprio(1); _Pragma("unroll") for (int m = 0; m < 4; ++m) _Pragma("unroll") for (int n = 0; n < 2; ++n) _Pragma("unroll") for (int k = 0; k < 2; ++k) \
        { if constexpr (Epi::MODE == 1) acc[ai][bj][m][n] = __builtin_bit_cast(f32x4, __builtin_amdgcn_mfma_i32_16x16x64_i8(__builtin_bit_cast(i32x4, Bt[n][k]), __builtin_bit_cast(i32x4, At[m][k]), __builtin_bit_cast(i32x4, acc[ai][bj][m][n]), 0, 0, 0)); \
          else if constexpr (Epi::MODE == 2) { if (k == 0) asm volatile("v_mfma_f32_16x16x128_f8f6f4 %0, %1, %2, %0" : "+v"(acc[ai][bj][m][n]) : "v"(Bt##8[n]), "v"(At##8[m])); } \
          else acc[ai][bj][m][n] = __builtin_amdgcn_mfma_f32_16x16x32_bf16(Bt[n][k], At[m][k], acc[ai][bj][m][n], 0, 0, 0); } __builtin_amdgcn_s_setprio(0); } while (0)
#define PG8_WAIT_V(n) asm volatile("s_waitcnt vmcnt(" #n ")" ::: "memory")
#define PG8_WAIT_L(n) asm volatile("s_waitcnt lgkmcnt(" #n ")" ::: "memory")
#define PG8_BAR __builtin_amdgcn_s_barrier()
#define PG8_SCHED __builtin_amdgcn_sched_barrier(0)
    Unit cur, nxt; int ui = 0;
    if (!S.next(0, cur)) return;
    f32x4 acc[2][2][4][2];
#pragma unroll
    for (int a = 0; a < 2; ++a)
#pragma unroll
        for (int b = 0; b < 2; ++b)
#pragma unroll
            for (int m = 0; m < 4; ++m)
#pragma unroll
                for (int n = 0; n < 2; ++n) acc[a][b][m][n] = (f32x4){0.f, 0.f, 0.f, 0.f};
    bf16x8 At[4][2], B0[2][2], B1[2][2];
    i32x8 At8[4], B08[2], B18[2];
    unsigned voffA[2][2], nvoffA[2][2];
    S.arows(cur, voffA, R, C);
    const char* cA = cur.A; const char* cB = cur.B;
    PG8_STAGE(PG8_SB(0, 0), cB, voffB); PG8_STAGE(PG8_SB(0, 1), cB + hstep, voffB); PG8_STAGE(PG8_SA(0, 0), cA, voffA[0]); PG8_STAGE(PG8_SA(0, 1), cA, voffA[1]);
    if (wr == 1) PG8_BAR;
    PG8_WAIT_V(2); PG8_BAR;
    PG8_STAGE(PG8_SB(1, 0), cB + kstep, voffB); PG8_STAGE(PG8_SA(1, 0), cA + kstep, voffA[0]); PG8_STAGE(PG8_SB(1, 1), cB + hstep + kstep, voffB);
    PG8_WAIT_V(6); PG8_BAR;
    for (;;) {
        const bool has_next = S.next(ui + 1, nxt);
        if (has_next && Sched::GATHER) S.arows(nxt, nvoffA, R, C);
        else {
#pragma unroll
            for (int h = 0; h < 2; ++h)
#pragma unroll
                for (int i = 0; i < 2; ++i) nvoffA[h][i] = voffA[h][i]; }
        const char* nA = has_next ? nxt.A : cA; const char* nB = has_next ? nxt.B : cB;
#pragma nounroll
        for (int t = 0; t < nt; t += 2) {
            const bool last = (t == nt - 2);
            const char* a1 = cA + (size_t)(t + 1) * kstep;
            const char* a2 = last ? nA : cA + (size_t)(t + 2) * kstep; const char* b2 = last ? nB : cB + (size_t)(t + 2) * kstep;
            const char* a3 = a2 + kstep; const char* b3 = b2 + kstep;
            unsigned o2[2][2];
#pragma unroll
            for (int h = 0; h < 2; ++h)
#pragma unroll
                for (int i = 0; i < 2; ++i) o2[h][i] = (Sched::GATHER && last) ? nvoffA[h][i] : voffA[h][i];
            PG8_LDB(B0, 0, 0); PG8_LDB(B1, 0, 1); PG8_SCHED; PG8_LDA(At, 0, 0); PG8_STAGE(PG8_SA(1, 1), a1, voffA[1]);
            PG8_WAIT_V(8); PG8_WAIT_L(0); PG8_BAR; PG8_MMA(0, 0, At, B0); PG8_MMA(0, 1, At, B1); PG8_BAR; PG8_SCHED;
            PG8_LDA(At, 0, 1); PG8_STAGE(PG8_SB(0, 0), b2, voffB); PG8_STAGE(PG8_SB(0, 1), b2 + hstep, voffB); PG8_STAGE(PG8_SA(0, 0), a2, o2[0]);
            PG8_WAIT_V(8); PG8_WAIT_L(0); PG8_BAR; PG8_MMA(1, 0, At, B0); PG8_MMA(1, 1, At, B1); PG8_BAR; PG8_SCHED;
            PG8_LDB(B0, 1, 0); PG8_LDB(B1, 1, 1); PG8_SCHED; PG8_LDA(At, 1, 0); PG8_STAGE(PG8_SA(0, 1), a2, o2[1]);
            PG8_WAIT_V(8); PG8_WAIT_L(0); PG8_BAR; PG8_MMA(0, 0, At, B0); PG8_MMA(0, 1, At, B1); PG8_BAR; PG8_SCHED;
            PG8_LDA(At, 1, 1); PG8_STAGE(PG8_SB(1, 0), b3, voffB); PG8_STAGE(PG8_SB(1, 1), b3 + hstep, voffB); PG8_STAGE(PG8_SA(1, 0), a3, o2[0]);
            PG8_WAIT_V(8); PG8_WAIT_L(0); PG8_BAR; PG8_MMA(1, 0, At, B0); PG8_MMA(1, 1, At, B1); PG8_BAR; PG8_SCHED;
        }
        if constexpr (Epi::MODE == 2) asm volatile("s_nop 15\n\ts_nop 15" ::: "memory");
        if (wr == 0) PG8_BAR;
        const int le = fresh_lane();
        const bool keep = E(acc, cur, wr, wc, le & 15, le >> 4);
        if (!has_next) break;
        if (!keep) {
#pragma unroll
            for (int a = 0; a < 2; ++a)
#pragma unroll
                for (int b = 0; b < 2; ++b)
#pragma unroll
                    for (int m = 0; m < 4; ++m)
#pragma unroll
                        for (int n = 0; n < 2; ++n) acc[a][b][m][n] = (f32x4){0.f, 0.f, 0.f, 0.f}; }
        cur = nxt; cA = nA; cB = nB; ++ui;
#pragma unroll
        for (int h = 0; h < 2; ++h)
#pragma unroll
            for (int i = 0; i < 2; ++i) if (Sched::GATHER) voffA[h][i] = nvoffA[h][i];
        if (wr == 1) PG8_BAR;
    }
    PG8_WAIT_V(0);
    PG8_BAR;
#undef PG8_SA
#undef PG8_SB
#undef PG8_STAGE
#undef PG8_LDA
#undef PG8_LDB
#undef PG8_MMA
#undef PG8_WAIT_V
#undef PG8_WAIT_L
#undef PG8_BAR
#undef PG8_SCHED
}

struct SchedGrid {
    static constexpr bool GATHER = false;
    const char* A; const char* B; int lda, K, nM, nN, G, c;
    __device__ __forceinline__ bool next(int i, Unit& u) const { int pm, pn; if (!static_tile(i * G + c, nM, nN, pm, pn)) return false;
        u.A = A + (size_t)pm * 256 * lda * 2; u.B = B + (size_t)pn * 256 * K * 2; u.pm = pm; u.pn = pn; u.aux = 0; u.aux2 = 0; return true; }
    __device__ __forceinline__ void arows(const Unit&, unsigned (&off)[2][2], const int (&R)[2], const int (&C)[2]) const {
#pragma unroll
        for (int h = 0; h < 2; ++h)
#pragma unroll
            for (int i = 0; i < 2; ++i) off[h][i] = (unsigned)((h * 128 + R[i]) * lda + C[i]) * 2u; }
};
struct SchedBranch {
    static constexpr bool GATHER = false;
    const char* A0; const char* B0; const char* A1; const char* B1; int G, c;
    __device__ __forceinline__ bool next(int i, Unit& u) const { int pm, pn; if (!static_tile((i >> 1) * G + c, 64, 8, pm, pn)) return false; const int br = i & 1;
        u.A = (br ? A1 : A0) + (size_t)pm * 256 * 1024; u.B = (br ? B1 : B0) + (size_t)pn * 256 * 1024; u.pm = pm; u.pn = pn; u.aux = br; u.aux2 = 0; return true; }
    __device__ __forceinline__ void arows(const Unit&, unsigned (&off)[2][2], const int (&R)[2], const int (&C)[2]) const {
#pragma unroll
        for (int h = 0; h < 2; ++h)
#pragma unroll
            for (int i = 0; i < 2; ++i) off[h][i] = (unsigned)((h * 128 + R[i]) * 1024) + 2u * (unsigned)C[i]; }
};
struct SchedMoeUp {
    static constexpr bool GATHER = true;
    const char* H2; const char* W13; const LAS int* ltok; MoeTab T; int G, c;
    __device__ __forceinline__ bool next(int i, Unit& u) const { const int L = i * G + c, rt = L >> 2, ct = L & 3; if (rt >= __builtin_amdgcn_readfirstlane(T.tb[NEXP])) return false;
        const int e = __builtin_amdgcn_readfirstlane(T.rte[rt]), r0 = (rt - __builtin_amdgcn_readfirstlane(T.tb[e])) * 256, nv = __builtin_amdgcn_readfirstlane(T.cn[e]) - r0;
        u.A = H2; u.B = W13 + ((size_t)e * 1024 + ct * 256) * D; u.pm = rt; u.pn = ct; u.aux = nv < 256 ? nv : 256; u.aux2 = i; return true; }
    __device__ __forceinline__ void arows(const Unit& u, unsigned (&off)[2][2], const int (&R)[2], const int (&C)[2]) const {
#pragma unroll
        for (int h = 0; h < 2; ++h)
#pragma unroll
            for (int i = 0; i < 2; ++i) { const int tok = ltok[u.aux2 * 256 + h * 128 + R[0] + 64 * i]; off[h][i] = (unsigned)(tok * D) + 2u * (unsigned)C[0]; } }
};
struct SchedMoeDown {
    static constexpr bool GATHER = false;
    const char* ACT; const char* W2; MoeTab T; int G, c;
    __device__ __forceinline__ bool next(int i, Unit& u) const { const int L = i * G + c, rt = L >> 3, ct = L & 7; if (rt >= __builtin_amdgcn_readfirstlane(T.tb[NEXP])) return false;
        const int e = __builtin_amdgcn_readfirstlane(T.rte[rt]), r0 = (rt - __builtin_amdgcn_readfirstlane(T.tb[e])) * 256, nv = __builtin_amdgcn_readfirstlane(T.cn[e]) - r0;
        u.A = ACT + (size_t)rt * 256 * FE; u.B = W2 + ((size_t)e * D + ct * 256) * FE; u.pm = rt; u.pn = ct; u.aux = nv < 256 ? nv : 256; u.aux2 = e * 16384 + r0; return true; }
    __device__ __forceinline__ void arows(const Unit&, unsigned (&off)[2][2], const int (&R)[2], const int (&C)[2]) const {
#pragma unroll
        for (int h = 0; h < 2; ++h)
#pragma unroll
            for (int i = 0; i < 2; ++i) off[h][i] = (unsigned)((h * 128 + R[i]) * FE) + 2u * (unsigned)C[i]; }
};

__device__ __forceinline__ u32x4 pack8(const f32x4& v0, const f32x4& v1) { u32x4 w; w.x = cvt_pk_bf16(v0[0], v0[1]); w.y = cvt_pk_bf16(v0[2], v0[3]); w.z = cvt_pk_bf16(v1[0], v1[1]); w.w = cvt_pk_bf16(v1[2], v1[3]); return w; }
__device__ __forceinline__ void unpack8(const u32x4& w, f32x4& v0, f32x4& v1) {
    v0[0] = __uint_as_float(w.x << 16); v0[1] = __uint_as_float(w.x & 0xffff0000u); v0[2] = __uint_as_float(w.y << 16); v0[3] = __uint_as_float(w.y & 0xffff0000u);
    v1[0] = __uint_as_float(w.z << 16); v1[1] = __uint_as_float(w.z & 0xffff0000u); v1[2] = __uint_as_float(w.w << 16); v1[3] = __uint_as_float(w.w & 0xffff0000u); }
__device__ __forceinline__ f32x4 sig4(const f32x4& v) { f32x4 o;
#pragma unroll
    for (int j = 0; j < 4; ++j) o[j] = __builtin_amdgcn_rcpf(1.0f + __builtin_amdgcn_exp2f(-LOG2E * v[j])); return o; }

struct EpiProj {
    static constexpr bool PERM = true; static constexpr int MODE = 1;
    bf16_t *U, *V, *Q, *Kb, *VT, *G; const float *HSC, *CS;
    __device__ __forceinline__ bool operator()(f32x4 (&acc)[2][2][4][2], const Unit& u, int wr, int wc, int fr, int fq) const {
        const int pn = u.pn, row0 = u.pm * BM + wr * 64 + fr, cl = wc * 32 + 8 * fq;
        {
            const float* hs = HSC + row0; const f32x4* cp = (const f32x4*)(CS + pn * 256 + cl);
            float rs[2][4]; f32x4 cs[2][2];
#pragma unroll
            for (int ai = 0; ai < 2; ++ai)
#pragma unroll
                for (int m = 0; m < 4; ++m) rs[ai][m] = hs[ai * HALF + m * 16];
#pragma unroll
            for (int bj = 0; bj < 2; ++bj) { cs[bj][0] = cp[bj * 32]; cs[bj][1] = cp[bj * 32 + 1]; }
#pragma unroll
            for (int ai = 0; ai < 2; ++ai)
#pragma unroll
                for (int bj = 0; bj < 2; ++bj)
#pragma unroll
                    for (int m = 0; m < 4; ++m)
#pragma unroll
                        for (int n = 0; n < 2; ++n) acc[ai][bj][m][n] = __builtin_convertvector(__builtin_bit_cast(i32x4, acc[ai][bj][m][n]), f32x4) * (cs[bj][n] * rs[ai][m]);
        }
        if (pn < 8) {
            bf16_t* base = (pn < 4 ? U : V) + (pn & 3) * 256 + cl;
#pragma unroll
            for (int ai = 0; ai < 2; ++ai)
#pragma unroll
                for (int m = 0; m < 4; ++m) { bf16_t* rowp = base + (size_t)(row0 + ai * HALF + m * 16) * 1024;
#pragma unroll
                    for (int bj = 0; bj < 2; ++bj) { const f32x4 v0 = acc[ai][bj][m][0], v1 = acc[ai][bj][m][1];
                        const f32x2 a = gelu_pk((f32x2){v0[0], v0[1]}), b = gelu_pk((f32x2){v0[2], v0[3]}), c = gelu_pk((f32x2){v1[0], v1[1]}), d = gelu_pk((f32x2){v1[2], v1[3]});
                        *(u32x4*)(rowp + bj * HALF) = pack8((f32x4){a.x, a.y, b.x, b.y}, (f32x4){c.x, c.y, d.x, d.y}); } }
        } else if (pn < 16) {
            bf16_t* base = (pn < 12 ? Q : Kb) + (pn & 3) * 256 + cl; const float sc = pn < 12 ? QSCALE : 1.0f;
#pragma unroll
            for (int ai = 0; ai < 2; ++ai)
#pragma unroll
                for (int m = 0; m < 4; ++m) { bf16_t* rowp = base + (size_t)(row0 + ai * HALF + m * 16) * 1024;
#pragma unroll
                    for (int bj = 0; bj < 2; ++bj) *(u32x4*)(rowp + bj * HALF) = pack8(acc[ai][bj][m][0] * sc, acc[ai][bj][m][1] * sc); }
        } else if (pn < 20) {
#ifndef DIAG_NOVT
#pragma unroll
            for (int ai = 0; ai < 2; ++ai)
#pragma unroll
                for (int m = 0; m < 4; ++m) { const int row = row0 + ai * HALF + m * 16, b = row >> 13, s = row & 8191;
#pragma unroll
                    for (int bj = 0; bj < 2; ++bj) { const int c5 = (pn - 16) * 256 + bj * HALF + cl, hh = c5 >> 6, d = c5 & 63;
                        bf16_t* bp = VT + ((size_t)((b * 16 + hh) * 64 + d)) * 8192 + s; const u32x4 w = pack8(acc[ai][bj][m][0], acc[ai][bj][m][1]);
                        bp[0 * 8192] = (bf16_t)(w.x & 0xffffu); bp[1 * 8192] = (bf16_t)(w.x >> 16); bp[2 * 8192] = (bf16_t)(w.y & 0xffffu); bp[3 * 8192] = (bf16_t)(w.y >> 16);
                        bp[4 * 8192] = (bf16_t)(w.z & 0xffffu); bp[5 * 8192] = (bf16_t)(w.z >> 16); bp[6 * 8192] = (bf16_t)(w.w & 0xffffu); bp[7 * 8192] = (bf16_t)(w.w >> 16); } }
#endif
        } else {
            unsigned short* base = (unsigned short*)G + (pn - 20) * 128 + cl;
#pragma unroll
            for (int ai = 0; ai < 2; ++ai)
#pragma unroll
                for (int m = 0; m < 4; ++m) { unsigned short* rowp = base + (size_t)(row0 + ai * HALF + m * 16) * D;
                    const f32x4 a0 = sig4(acc[ai][0][m][0]), a1 = sig4(acc[ai][0][m][1]), b0 = sig4(acc[ai][1][m][0]), b1 = sig4(acc[ai][1][m][1]);
                    unsigned q[8];
#pragma unroll
                    for (int j = 0; j < 4; ++j) { unsigned qa = (unsigned)(a0[j] * 255.f + 0.5f), qb = (unsigned)(b0[j] * 255.f + 0.5f); qa = qa < 1u ? 1u : qa; qb = qb < 1u ? 1u : qb; q[j] = qa | (qb << 8);
                        unsigned ra = (unsigned)(a1[j] * 255.f + 0.5f), rb = (unsigned)(b1[j] * 255.f + 0.5f); ra = ra < 1u ? 1u : ra; rb = rb < 1u ? 1u : rb; q[4 + j] = ra | (rb << 8); }
                    u32x4 w; w.x = q[0] | (q[1] << 16); w.y = q[2] | (q[3] << 16); w.z = q[4] | (q[5] << 16); w.w = q[6] | (q[7] << 16);
                    __builtin_nontemporal_store(w, (u32x4*)rowp); }
        }
        return false;
    }
};
struct EpiBranch {
    static constexpr bool PERM = true; static constexpr int MODE = 2;
    const unsigned short* G; bf16_t* MIX;
    mutable unsigned gbk[2][4][2][2];
    __device__ __forceinline__ bool operator()(f32x4 (&acc)[2][2][4][2], const Unit& u, int wr, int wc, int fr, int fq) const {
        const int row0 = u.pm * BM + wr * 64 + fr, col0 = u.pn * BM + wc * 32 + 8 * fq; const bool brb = u.aux != 0;
        if (!brb) {
#pragma unroll
            for (int ai = 0; ai < 2; ++ai) {
                u32x4 g[4][2];
#pragma unroll
                for (int m = 0; m < 4; ++m)
#pragma unroll
                    for (int bj = 0; bj < 2; ++bj) g[m][bj] = __builtin_nontemporal_load((const u32x4*)(G + (size_t)(row0 + ai * HALF + m * 16) * D + col0 + bj * HALF));
#pragma unroll
                for (int m = 0; m < 4; ++m)
#pragma unroll
                    for (int bj = 0; bj < 2; ++bj) {
                        const unsigned w[4] = {g[m][bj].x, g[m][bj].y, g[m][bj].z, g[m][bj].w};
#pragma unroll
                        for (int j = 0; j < 4; ++j) {
                            const float r0 = (float)(w[j] & 0xffu) * __builtin_amdgcn_rcpf((float)((w[j] >> 8) & 0xffu)), r1 = (float)((w[j] >> 16) & 0xffu) * __builtin_amdgcn_rcpf((float)(w[j] >> 24));
                            acc[ai][bj][m][j >> 1][2 * (j & 1)] *= r0; acc[ai][bj][m][j >> 1][2 * (j & 1) + 1] *= r1; }
                        gbk[ai][m][bj][0] = ((w[0] >> 8) & 0xffu) | ((w[0] >> 24) << 8) | (((w[1] >> 8) & 0xffu) << 16) | ((w[1] >> 24) << 24);
                        gbk[ai][m][bj][1] = ((w[2] >> 8) & 0xffu) | ((w[2] >> 24) << 8) | (((w[3] >> 8) & 0xffu) << 16) | ((w[3] >> 24) << 24);
                    }
            }
            return true;
        }
#pragma unroll
        for (int ai = 0; ai < 2; ++ai)
#pragma unroll
            for (int m = 0; m < 4; ++m)
#pragma unroll
                for (int bj = 0; bj < 2; ++bj) {
                    const unsigned k0 = gbk[ai][m][bj][0], k1 = gbk[ai][m][bj][1];
                    const f32x4 b0 = (f32x4){(float)(k0 & 0xffu), (float)((k0 >> 8) & 0xffu), (float)((k0 >> 16) & 0xffu), (float)(k0 >> 24)} * (1.f / (255.f * F8_SY * F8_SW));
                    const f32x4 b1 = (f32x4){(float)(k1 & 0xffu), (float)((k1 >> 8) & 0xffu), (float)((k1 >> 16) & 0xffu), (float)(k1 >> 24)} * (1.f / (255.f * F8_SY * F8_SW));
                    *(u32x4*)(MIX + (size_t)(row0 + ai * HALF + m * 16) * D + col0 + bj * HALF) = pack8(acc[ai][bj][m][0] * b0, acc[ai][bj][m][1] * b1);
                }
        return false;
    }
};
struct EpiOut {
    static constexpr bool PERM = true; static constexpr int MODE = 1;
    const float* x; const float* mod; bf16_t* out; const float *SM, *CSO;
    __device__ __forceinline__ bool operator()(f32x4 (&acc)[2][2][4][2], const Unit& u, int wr, int wc, int fr, int fq) const {
        const int row0 = u.pm * BM + wr * 64 + fr, col0 = u.pn * BM + wc * 32 + 8 * fq; const float* g1 = mod + ((u.pm * BM) >> 13) * NMOD + 2 * D;
        f32x4 gv[2][2];
#pragma unroll
        for (int bj = 0; bj < 2; ++bj)
#pragma unroll
            for (int n = 0; n < 2; ++n) gv[bj][n] = *(const f32x4*)(g1 + col0 + bj * HALF + 4 * n) * *(const f32x4*)(CSO + col0 + bj * HALF + 4 * n);
#pragma unroll
        for (int ai = 0; ai < 2; ++ai)
#pragma unroll
            for (int m = 0; m < 4; ++m) { const float rs = SM[row0 + ai * HALF + m * 16];
#pragma unroll
                for (int bj = 0; bj < 2; ++bj)
#pragma unroll
                    for (int n = 0; n < 2; ++n) acc[ai][bj][m][n] = __builtin_convertvector(__builtin_bit_cast(i32x4, acc[ai][bj][m][n]), f32x4) * rs; }
#pragma unroll
        for (int ai = 0; ai < 2; ++ai)
#pragma unroll
            for (int mh = 0; mh < 2; ++mh) {
                f32x4 xv[2][2][2];
#pragma unroll
                for (int m = 0; m < 2; ++m)
#pragma unroll
                    for (int bj = 0; bj < 2; ++bj)
#pragma unroll
                        for (int n = 0; n < 2; ++n) xv[m][bj][n] = __builtin_nontemporal_load((const f32x4*)(x + (size_t)(row0 + ai * HALF + (2 * mh + m) * 16) * D + col0 + bj * HALF + 4 * n));
#pragma unroll
                for (int m = 0; m < 2; ++m)
#pragma unroll
                    for (int bj = 0; bj < 2; ++bj)
                        *(u32x4*)(out + (size_t)(row0 + ai * HALF + (2 * mh + m) * 16) * D + col0 + bj * HALF) =
                            pack8(xv[m][bj][0] + gv[bj][0] * acc[ai][bj][2 * mh + m][0], xv[m][bj][1] + gv[bj][1] * acc[ai][bj][2 * mh + m][1]);
            }
        return false;
    }
};
struct EpiMoeUp {
    static constexpr bool PERM = true; static constexpr int MODE = 2;
    unsigned char* ACT;
    __device__ __forceinline__ bool operator()(f32x4 (&acc)[2][2][4][2], const Unit& u, int wr, int wc, int fr, int fq) const {
        const int f0 = u.pn * 128 + wc * 32 + 8 * fq;
#pragma unroll
        for (int ai = 0; ai < 2; ++ai)
#pragma unroll
            for (int m = 0; m < 4; ++m) { const int r = ai * HALF + wr * 64 + m * 16 + fr; const bool valid = r < u.aux;
                f32x4 o[2];
#pragma unroll
                for (int n = 0; n < 2; ++n) { const f32x4 a = acc[ai][0][m][n] * (1.f / (F8_SH2 * F8_SW)), b = acc[ai][1][m][n] * (F8_SACT / (F8_SH2 * F8_SW));
#pragma unroll
                    for (int j = 0; j < 4; ++j) o[n][j] = valid ? a[j] * __builtin_amdgcn_rcpf(1.0f + __builtin_amdgcn_exp2f(-LOG2E * a[j])) * b[j] : 0.f; }
                *(u32x2*)(ACT + ((size_t)u.pm * 256 + r) * FE + f0) = (u32x2){pk4_f8(o[0][0], o[0][1], o[0][2], o[0][3]), pk4_f8(o[1][0], o[1][1], o[1][2], o[1][3])}; }
        return false;
    }
};
struct EpiMoeDown {
    static constexpr bool PERM = true; static constexpr int MODE = 2;
    const float* roww; unsigned char* YS;
    __device__ __forceinline__ bool operator()(f32x4 (&acc)[2][2][4][2], const Unit& u, int wr, int wc, int fr, int fq) const {
        const int col0 = u.pn * BM + wc * 32 + 8 * fq;
        float w[2][4];
#pragma unroll
        for (int ai = 0; ai < 2; ++ai)
#pragma unroll
            for (int m = 0; m < 4; ++m) { const int r = ai * HALF + wr * 64 + m * 16 + fr; w[ai][m] = (64.0f / (F8_SACT * F8_SW)) * roww[u.aux2 + (r < u.aux ? r : 0)]; }
#pragma unroll
        for (int ai = 0; ai < 2; ++ai)
#pragma unroll
            for (int m = 0; m < 4; ++m) { const int r = ai * HALF + wr * 64 + m * 16 + fr;
#pragma unroll
                for (int bj = 0; bj < 2; ++bj) { const f32x4 v0 = acc[ai][bj][m][0] * w[ai][m], v1 = acc[ai][bj][m][1] * w[ai][m];
                    unsigned lo = __builtin_amdgcn_cvt_pk_fp8_f32(v0[0], v0[1], 0, false); lo = __builtin_amdgcn_cvt_pk_fp8_f32(v0[2], v0[3], lo, true);
                    unsigned hi = __builtin_amdgcn_cvt_pk_fp8_f32(v1[0], v1[1], 0, false); hi = __builtin_amdgcn_cvt_pk_fp8_f32(v1[2], v1[3], hi, true);
                    *(u32x2*)(YS + ((size_t)u.pm * 256 + r) * D + col0 + bj * HALF) = (u32x2){lo, hi}; } }
        return false;
    }
};
}

#define XB_TMO      128
#define XB_XCNT(j)  (256  + 64 * (j))
#define XB_XSUB(j)  (1280 + 64 * (j))
#define XB_XGEN(j)  (2304 + 64 * (j))
#define XB_TOP      3328
#define XB_TOPGEN   3392
#define XCD_BAR_WORDS 3456
#define XB_SPIN_CAP (1u << 18)

__device__ __forceinline__ unsigned xb_ld(unsigned* p)              { return __hip_atomic_load(p, __ATOMIC_RELAXED, __HIP_MEMORY_SCOPE_AGENT); }
__device__ __forceinline__ unsigned xb_add(unsigned* p, unsigned v) { return __hip_atomic_fetch_add(p, v, __ATOMIC_RELAXED, __HIP_MEMORY_SCOPE_AGENT); }
__device__ __forceinline__ unsigned xb_xcc_id() { return (unsigned)__builtin_amdgcn_s_getreg((3 << 11) | 20) & 0xFu; }
#define XB_SPIN(cond, bar) do { unsigned _sp = 0; while (cond) { __builtin_amdgcn_s_sleep(1); \
    if ((++_sp & 255u) == 0u) { if (xb_ld(&(bar)[XB_TMO])) break; if (_sp > XB_SPIN_CAP) { atomicAdd(&(bar)[XB_TMO], 1u); break; } } } } while (0)

struct XcdBarrier {
    unsigned* bar; unsigned x;
    volatile LAS unsigned* st;
};

__device__ __forceinline__ XcdBarrier xcd_barrier_post(unsigned* bar, volatile LAS unsigned* st) {
    XcdBarrier b; b.bar = bar; b.x = xb_xcc_id(); b.st = st;
    if (threadIdx.x == 0) (void)xb_add(&bar[XB_XCNT(b.x)], 1u);
    return b;
}
__device__ __forceinline__ void xcd_barrier_complete(unsigned* bar, unsigned x, unsigned& nloc, unsigned& nx) {
    const unsigned G = gridDim.x * gridDim.y * gridDim.z;
    unsigned sum, cnt, mine, sp = 0u;
    for (;;) {
        sum = 0u; cnt = 0u; mine = 0u;
#pragma unroll
        for (unsigned j = 0; j < 16; ++j) { const unsigned c = xb_ld(&bar[XB_XCNT(j)]); sum += c; cnt += (c > 0u) ? 1u : 0u; mine = (j == x) ? c : mine; }
        if (sum == G) break;
        __builtin_amdgcn_s_sleep(1);
        if ((++sp & 255u) == 0u) { if (xb_ld(&bar[XB_TMO])) break; if (sp > XB_SPIN_CAP) { atomicAdd(&bar[XB_TMO], 1u); break; } }
    }
    nloc = mine > 0u ? mine : 1u; nx = cnt > 0u ? cnt : 1u;
}

__device__ __forceinline__ void xcd_barrier(const XcdBarrier& b) {
    asm volatile("s_waitcnt vmcnt(0)" ::: "memory");
    __syncthreads();
    if (threadIdx.x == 0) {
        unsigned* bar = b.bar;
        __builtin_amdgcn_s_waitcnt(0);
        unsigned nloc = b.st[0], nx = b.st[1];
        if (nloc == 0u) { xcd_barrier_complete(bar, b.x, nloc, nx); b.st[0] = nloc; b.st[1] = nx; }
        const unsigned old = xb_add(&bar[XB_XSUB(b.x)], 1u);
        const unsigned gen = old / nloc;
        if (old + 1u == (gen + 1u) * nloc) {
            __builtin_amdgcn_fence(__ATOMIC_RELEASE, "agent");
            asm volatile("s_waitcnt vmcnt(0)" ::: "memory");
            const unsigned og = xb_add(&bar[XB_TOP], 1u);
            const unsigned tg = og / nx;
            if (og + 1u == (tg + 1u) * nx) xb_add(&bar[XB_TOPGEN], 1u);
            else XB_SPIN(xb_ld(&bar[XB_TOPGEN]) == tg, bar);
            __builtin_amdgcn_fence(__ATOMIC_ACQUIRE, "agent");
            xb_add(&bar[XB_XGEN(b.x)], 1u);
            asm volatile("s_waitcnt vmcnt(0)" ::: "memory");
        } else {
            XB_SPIN(xb_ld(&bar[XB_XGEN(b.x)]) == gen, bar);
            __builtin_amdgcn_fence(__ATOMIC_ACQUIRE, "agent");
            asm volatile("s_waitcnt vmcnt(0)" ::: "memory");
        }
    }
    __syncthreads();
}

constexpr int NWAVES = 8, NTHREADS = NWAVES * 64;
constexpr int RING_BYTES = 131072, MISC_OFF = 147456, LDS_BYTES = 155648;

__device__ __forceinline__ void p0_mod_unit(const float* c, const float* ada_w, float* modp, int unit, int lane) {
    const int rb = unit >> 6, cc = unit & 63;
    if (lane < 48) {
        f32x4 a0 = {0.f, 0.f, 0.f, 0.f}, a1 = {0.f, 0.f, 0.f, 0.f};
        const float* wp = ada_w + (size_t)(rb * 64) * NMOD + cc * 192 + lane * 4;
#pragma unroll 8
        for (int r = 0; r < 64; ++r) {
            const float c0 = c[rb * 64 + r], c1 = c[D + rb * 64 + r];
            const float s0 = siluf_(c0), s1 = siluf_(c1);
            const f32x4 w = __builtin_nontemporal_load((const f32x4*)(wp + (size_t)r * NMOD));
            a0 += s0 * w; a1 += s1 * w;
        }
        *(f32x4*)(modp + (size_t)(rb * 2 + 0) * NMOD + cc * 192 + lane * 4) = a0;
        *(f32x4*)(modp + (size_t)(rb * 2 + 1) * NMOD + cc * 192 + lane * 4) = a1;
    }
}
__device__ __forceinline__ void p0_amax_item(const float* Wsrc  , int ldw, unsigned* colmax  , int lane) {
    const float* src = Wsrc + (size_t)(lane >> 5) * ldw + (lane & 31);
    float wv[32];
#pragma unroll
    for (int i = 0; i < 32; ++i) wv[i] = src[(size_t)(2 * i) * ldw];
    float am = 0.f;
#pragma unroll
    for (int i = 0; i < 32; ++i) am = fmaxf(am, fabsf(wv[i]));
    am = fmaxf(am, __shfl_xor(am, 32, 64));
    if (lane < 32) __hip_atomic_fetch_max(colmax + lane, __float_as_uint(am), __ATOMIC_RELAXED, __HIP_MEMORY_SCOPE_AGENT);
}
constexpr int ADA_EARLY = 22;
__device__ __forceinline__ void p2_ada_late(const Params& p, int blk, int wave, int lane) {
    const int idx = wave * 256 + blk;
    if (idx < 32 * (64 - ADA_EARLY)) p0_mod_unit(p.in[I_C], p.in[I_ADAW], (float*)(p.ws + WS_MODP), (idx / (64 - ADA_EARLY)) * 64 + ADA_EARLY + idx % (64 - ADA_EARLY), lane);
}
__device__ __forceinline__ void p0_transpose_item(const float* Wsrc  , int ldw, unsigned char* dst  , int ldd, LAS float* scr, int lane) {
#pragma unroll 8
    for (int i = 0; i < 32; ++i) { const int kk = 2 * i + (lane >> 5); scr[kk * 33 + (lane & 31)] = __builtin_nontemporal_load(Wsrc + (size_t)kk * ldw + (lane & 31)); }
    asm volatile("s_waitcnt lgkmcnt(0)" ::: "memory");
    const int cch = lane & 7;
#pragma unroll
    for (int j = 0; j < 4; ++j) { const int n = (lane >> 3) + 8 * j; const LAS float* s = scr + (8 * cch) * 33 + n;
        u32x2 o; o.x = pk4_f8(s[0 * 33] * F8_SW, s[1 * 33] * F8_SW, s[2 * 33] * F8_SW, s[3 * 33] * F8_SW); o.y = pk4_f8(s[4 * 33] * F8_SW, s[5 * 33] * F8_SW, s[6 * 33] * F8_SW, s[7 * 33] * F8_SW);
        *(u32x2*)(dst + (size_t)n * ldd + 8 * cch) = o; }
    asm volatile("s_waitcnt lgkmcnt(0)" ::: "memory");
}
__device__ __forceinline__ void p1_quant_item(const float* Wsrc, int ldw, unsigned char* dst  , int ldd, const unsigned* colmax  , float* cs  , LAS float* scr, int lane) {
    const float amax = __uint_as_float(__hip_atomic_load(colmax + (lane & 31), __ATOMIC_RELAXED, __HIP_MEMORY_SCOPE_AGENT)), inv = amax > 0.f ? 127.f / amax : 0.f;
    if (cs && lane < 32) cs[lane] = amax * (1.f / 127.f);
#pragma unroll 8
    for (int i = 0; i < 32; ++i) { const int kk = 2 * i + (lane >> 5); scr[kk * 33 + (lane & 31)] = __builtin_nontemporal_load(Wsrc + (size_t)kk * ldw + (lane & 31)) * inv + I8MAGIC; }
    asm volatile("s_waitcnt lgkmcnt(0)" ::: "memory");
    const int c4 = lane & 3;
#pragma unroll
    for (int j = 0; j < 2; ++j) { const int n = (lane >> 2) + 16 * j; const LAS unsigned* s = (const LAS unsigned*)scr + (16 * c4) * 33 + n;
        u32x4 o; o.x = pack4_i8(s[0 * 33], s[1 * 33], s[2 * 33], s[3 * 33]); o.y = pack4_i8(s[4 * 33], s[5 * 33], s[6 * 33], s[7 * 33]);
        o.z = pack4_i8(s[8 * 33], s[9 * 33], s[10 * 33], s[11 * 33]); o.w = pack4_i8(s[12 * 33], s[13 * 33], s[14 * 33], s[15 * 33]);
        *(u32x4*)(dst + (size_t)n * ldd + 16 * c4) = o; }
    asm volatile("s_waitcnt lgkmcnt(0)" ::: "memory");
}
struct XpItem { const float* src; unsigned char* dst; int ldw, ldd, f8; };
__device__ __forceinline__ void xp_issue(const XpItem& x, int lane, float (&xr)[32]) {
    const float* q = x.src + (size_t)(lane >> 5) * x.ldw + (lane & 31); const size_t step = (size_t)2 * x.ldw;
#pragma unroll
    for (int i = 0; i < 32; ++i) { xr[i] = __builtin_nontemporal_load(q); q += step; asm volatile("" : "+v"(q)); }
}
__device__ __forceinline__ void xp_finish(const XpItem& x, int lane, const float (&xr)[32], LAS float* scr) {
#pragma unroll
    for (int i = 0; i < 32; ++i) { const int kk = 2 * i + (lane >> 5); scr[kk * 33 + (lane & 31)] = xr[i]; }
    asm volatile("s_waitcnt lgkmcnt(0)" ::: "memory");
    const int cch = lane & 7;
#pragma unroll
    for (int j = 0; j < 4; ++j) { const int n = (lane >> 3) + 8 * j; const LAS float* s = scr + (8 * cch) * 33 + n;
        u32x2 o; o.x = pk4_f8(s[0 * 33] * F8_SW, s[1 * 33] * F8_SW, s[2 * 33] * F8_SW, s[3 * 33] * F8_SW); o.y = pk4_f8(s[4 * 33] * F8_SW, s[5 * 33] * F8_SW, s[6 * 33] * F8_SW, s[7 * 33] * F8_SW);
        *(u32x2*)(x.dst + (size_t)n * x.ldd + 8 * cch) = o; }
    asm volatile("s_waitcnt lgkmcnt(0)" ::: "memory");
}
constexpr int NMOE_ITEMS = 2 * NEXP * 512;
__device__ __forceinline__ void moe_xp_item(const Params& p, int r, XpItem& x) {
    constexpr int I_E = 512; unsigned char* ws = p.ws;
    if (r < 2 * NEXP * I_E) {
        const int which = r / (NEXP * I_E); r -= which * NEXP * I_E; const int e = r / I_E, q = r % I_E, kb = q / 16, nb = q % 16, f0 = 32 * nb;
        x.src = p.in[which ? I_W3 : I_W1] + (size_t)e * D * FE + (size_t)(64 * kb) * FE + f0; x.ldw = FE;
        x.dst = ws + WS_W13_T + ((size_t)e * 1024 + 256 * (f0 >> 7) + 128 * which + (f0 & 127)) * D + 64 * kb; x.ldd = D; x.f8 = 1;
    } else { r -= 2 * NEXP * I_E; const int e = r / I_E, q = r % I_E, kb = q / 64, nb = q % 64;
        x.src = p.in[I_W2] + (size_t)e * FE * D + (size_t)(64 * kb) * D + 32 * nb; x.ldw = D;
        x.dst = ws + WS_W2_T + ((size_t)e * D + 32 * nb) * FE + 64 * kb; x.ldd = FE; x.f8 = 1; }
}
__device__ __forceinline__ void p0_prologue(const Params& p, LAS unsigned char* lds, int gw, int ngw, int wave, int lane) {
    unsigned char* ws = p.ws;
    LAS float* scr = (LAS float*)(lds + wave * 16384);
    const int blk = gw >> 3, nada = blk < (32 * ADA_EARLY - 512) ? 3 : 2;
    if (wave < nada) { const int idx = wave * 256 + blk; p0_mod_unit(p.in[I_C], p.in[I_ADAW], (float*)(ws + WS_MODP), (idx / ADA_EARLY) * 64 + idx % ADA_EARLY, lane); }
    if (gw < 8 * 128) { const int t = gw & 127; const float* wsrc = p.in[I_WS] + (size_t)gw * 128 + 2 * lane; float w0 = wsrc[0], w1 = wsrc[1];
        if (t < 64 && lane >= 32) { w0 = 0.f; w1 = 0.f; }
        ((unsigned*)(ws + WS_WSB))[gw * 64 + lane] = pk2(w0, w1); }
    for (int it = gw; it < 48 * 32; it += ngw) {
        const int col = it >> 5, k = 64 * (it & 31) + lane;
        float w = 0.f;
        if (col < 4) w = p.in[I_WGRP][k * 4 + col];
        else if (col < 36) w = p.in[I_WEXP][(size_t)((col - 4) >> 3) * D * 8 + (size_t)k * 8 + ((col - 4) & 7)];
        const unsigned hi = f2bf(w), lo = f2bf(w - __uint_as_float(hi << 16));
        bf16_t* wrt = (bf16_t*)(ws + WS_WRT);
        wrt[col * D + k] = (bf16_t)hi; wrt[48 * D + col * D + k] = (bf16_t)lo;
    }
    constexpr int I_IN = 32 * 288, I_A = 16 * 64, I_O = 32 * 64, I_E = 512;
    constexpr int NITEMS = I_IN;
    if (wave >= nada) for (int j = wave - nada; j < NITEMS / 256; j += 8 - nada) {
        int r = blk + 256 * j;
        if (r < I_IN) { const int kb = r / 288, nb = r % 288; int drow = 32 * nb;
            if (drow >= 5120) { const int c = drow - 5120, which = c >> 11, cc = c & 2047; drow = 5120 + 256 * (cc >> 7) + 128 * which + (cc & 127); }
            p0_amax_item(p.in[I_WIN] + (size_t)(64 * kb) * NCOLS + 32 * nb, NCOLS, (unsigned*)(ws + WS_COLMAX) + drow, lane); }
    }
    if (wave >= nada) for (int j = wave - nada; j < I_O / 256; j += 8 - nada) { const int it = blk + 256 * j, kb = it >> 6, nb = it & 63;
        p0_amax_item(p.in[I_WOUT] + (size_t)(64 * kb) * D + 32 * nb, D, (unsigned*)(ws + WS_COLMAX_O) + 32 * nb, lane); }
}
__device__ __forceinline__ void p1_norm1(const Params& p, LAS unsigned char* lds, int blk, int tid, int wave, int lane) {
    unsigned char* ws = p.ws; const float* modp = (const float*)(ws + WS_MODP); float* mod = (float*)(ws + WS_MOD);
    LAS float* A1 = (LAS float*)lds; LAS float* S1 = A1 + D;
    const int bb = blk >> 7;
    for (int k = tid; k < D; k += NTHREADS) {
        float sh = p.in[I_ADAB][k], sc = p.in[I_ADAB][D + k];
        for (int q = 0; q < 32; ++q) { sh += modp[(size_t)(q * 2 + bb) * NMOD + k]; sc += modp[(size_t)(q * 2 + bb) * NMOD + D + k]; }
        A1[k] = p.in[I_N1G][k] * (1.f + sc); S1[k] = sh;
    }
    __syncthreads();
    LAS float* scr = (LAS float*)(lds + 16384 + wave * 16384);
    for (int it = blk * NWAVES + wave; it < 32 * 288; it += 256 * NWAVES) {
        const int kb = it / 288, nb = it % 288; int drow = 32 * nb;
        if (drow >= 5120) { const int c = drow - 5120, which = c >> 11, cc = c & 2047; drow = 5120 + 256 * (cc >> 7) + 128 * which + (cc & 127); }
        p1_quant_item(p.in[I_WIN] + (size_t)(64 * kb) * NCOLS + 32 * nb, NCOLS, ws + WS_WIN_T + (size_t)drow * D + 64 * kb, D, (const unsigned*)(ws + WS_COLMAX) + drow,
                      kb == 0 ? (float*)(ws + WS_CS) + drow : (float*)nullptr, scr, lane);
    }
    for (int it = blk * NWAVES + wave; it < 32 * 64; it += 256 * NWAVES) { const int kb = it >> 6, nb = it & 63;
        p1_quant_item(p.in[I_WOUT] + (size_t)(64 * kb) * D + 32 * nb, D, ws + WS_WOUT_T + (size_t)(32 * nb) * D + 64 * kb, D, (const unsigned*)(ws + WS_COLMAX_O) + 32 * nb,
                      kb == 0 ? (float*)(ws + WS_CSO) + 32 * nb : (float*)nullptr, scr, lane);
    }
    const float* x = p.in[I_X]; unsigned char* H = ws + WS_H; float* hsc = (float*)(ws + WS_HSC);
    for (int i = 0; i < 8; i += 2) {
        const int row = blk * 64 + wave * 8 + i;
        const f32x4* xr = (const f32x4*)(x + (size_t)row * D) + lane;
        f32x4 v[2][8]; float ss[2] = {0.f, 0.f};
#pragma unroll
        for (int r = 0; r < 2; ++r)
#pragma unroll
            for (int j = 0; j < 8; ++j) v[r][j] = __builtin_nontemporal_load(xr + (size_t)r * (D / 4) + 64 * j);
#pragma unroll
        for (int r = 0; r < 2; ++r)
#pragma unroll
            for (int j = 0; j < 8; ++j) ss[r] += (v[r][j].x * v[r][j].x + v[r][j].y * v[r][j].y) + (v[r][j].z * v[r][j].z + v[r][j].w * v[r][j].w);
#pragma unroll
        for (int r = 0; r < 2; ++r) {
            const float rstd = rsqrtf(wave_sum(ss[r]) * (1.f / D) + EPS);
            unsigned* o = (unsigned*)(H + (size_t)(row + r) * D) + lane;
            float am = 0.f;
#pragma unroll
            for (int j = 0; j < 8; ++j) { const f32x4 a = *(const LAS f32x4*)(A1 + 256 * j + 4 * lane), s = *(const LAS f32x4*)(S1 + 256 * j + 4 * lane);
                v[r][j] = v[r][j] * rstd * a + s; am = fmaxf(fmaxf(am, fmaxf(fabsf(v[r][j].x), fabsf(v[r][j].y))), fmaxf(fabsf(v[r][j].z), fabsf(v[r][j].w))); }
            am = wave_max(am); const float sq = am > 0.f ? 127.f / am : 0.f;
            if (lane == 0) hsc[row + r] = am * (1.f / 127.f);
#pragma unroll
            for (int j = 0; j < 8; ++j) { const f32x4 h = v[r][j] * sq + I8MAGIC;
                o[64 * j] = pack4_i8(__float_as_uint(h.x), __float_as_uint(h.y), __float_as_uint(h.z), __float_as_uint(h.w)); }
        }
    }
    __syncthreads();
}
typedef short bf16x8_t __attribute__((ext_vector_type(8)));
typedef short bf16x4_t __attribute__((ext_vector_type(4)));
__device__ __forceinline__ void p3_gmlp(const Params& p, LAS unsigned char* lds, int blk, int tid, int wave, int lane, size_t out_off, int gw) {
    unsigned char* ws = p.ws; bf16_t* U = (bf16_t*)(ws + WS_U); const bf16_t* V = (const bf16_t*)(ws + WS_V);
    const int tb0 = (blk >> 1) * 128, gh = blk & 1, l15 = lane & 15, lg = lane >> 4;
    LAS float* st = (LAS float*)lds;
    LAS unsigned char* XT = lds + 1024;
    LAS unsigned char* WL = lds + 1024 + 34816;
    for (int i0 = 0; i0 < 16; i0 += 8) {
        u32x4 raw[8][2];
#pragma unroll
        for (int i = 0; i < 8; ++i) { const u32x4* vp = (const u32x4*)(V + (size_t)(tb0 + 16 * wave + i0 + i) * 1024) + lane * 2; raw[i][0] = vp[0]; raw[i][1] = vp[1]; }
        float s[8], q[8];
#pragma unroll
        for (int i = 0; i < 8; ++i) { f32x4 x[4]; pg8::unpack8(raw[i][0], x[0], x[1]); pg8::unpack8(raw[i][1], x[2], x[3]);
            s[i] = ((x[0].x + x[0].y) + (x[0].z + x[0].w)) + ((x[1].x + x[1].y) + (x[1].z + x[1].w)) + ((x[2].x + x[2].y) + (x[2].z + x[2].w)) + ((x[3].x + x[3].y) + (x[3].z + x[3].w)); }
#pragma unroll
        for (int o = 32; o > 0; o >>= 1)
#pragma unroll
            for (int i = 0; i < 8; ++i) s[i] += __shfl_xor(s[i], o, 64);
#pragma unroll
        for (int i = 0; i < 8; ++i) { f32x4 x[4]; pg8::unpack8(raw[i][0], x[0], x[1]); pg8::unpack8(raw[i][1], x[2], x[3]); const float mean = s[i] * (1.f / 1024.f); s[i] = mean; q[i] = 0.f;
#pragma unroll
            for (int j = 0; j < 4; ++j) { const f32x4 d = x[j] - mean; q[i] += (d.x * d.x + d.y * d.y) + (d.z * d.z + d.w * d.w); } }
#pragma unroll
        for (int o = 32; o > 0; o >>= 1)
#pragma unroll
            for (int i = 0; i < 8; ++i) q[i] += __shfl_xor(q[i], o, 64);
#pragma unroll
        for (int i = 0; i < 8; ++i) if (lane == 0) { st[2 * (16 * wave + i0 + i)] = s[i]; st[2 * (16 * wave + i0 + i) + 1] = rsqrtf(q[i] * (1.f / 1024.f) + EPS); }
    }
    __syncthreads();
    const float* lng = p.in[I_LNG]; const float* lnb = p.in[I_LNB]; const float* w_s = p.in[I_WS]; const float* b_s = p.in[I_BS];
    LAS float* scr = (LAS float*)(lds + 77824 + wave * 8448);
    int xk = 0; bool xpend = false; XpItem xi; xi.src = nullptr; xi.dst = nullptr; xi.ldw = 0; xi.ldd = 0; xi.f8 = 1; float xr[32];
#pragma unroll
    for (int q = 0; q < 32; ++q) xr[q] = 0.f;
    for (int gi = 0; gi < 4; ++gi) {
        const int g = gh * 4 + gi;
#pragma unroll
        for (int i = 0; i < 4; ++i) {
            const int q = tid + 512 * i, s = q & 127, cch = q >> 7;
            const u32x4 raw = *(const u32x4*)(V + (size_t)(tb0 + s) * 1024 + 128 * g + 8 * cch);
            f32x4 x0, x1; pg8::unpack8(raw, x0, x1);
            const float mean = st[2 * s], rstd = st[2 * s + 1];
            const f32x4 g0 = *(const f32x4*)(lng + 128 * g + 8 * cch), g1 = *(const f32x4*)(lng + 128 * g + 8 * cch + 4), b0 = *(const f32x4*)(lnb + 128 * g + 8 * cch), b1 = *(const f32x4*)(lnb + 128 * g + 8 * cch + 4);
            x0 = (x0 - mean) * rstd * g0 + b0; x1 = (x1 - mean) * rstd * g1 + b1;
            LAS bf16_t* xp = (LAS bf16_t*)(XT + (8 * cch) * 272 + 2 * s);
            xp[0 * 136] = (bf16_t)f2bf(x0.x); xp[1 * 136] = (bf16_t)f2bf(x0.y); xp[2 * 136] = (bf16_t)f2bf(x0.z); xp[3 * 136] = (bf16_t)f2bf(x0.w);
            xp[4 * 136] = (bf16_t)f2bf(x1.x); xp[5 * 136] = (bf16_t)f2bf(x1.y); xp[6 * 136] = (bf16_t)f2bf(x1.z); xp[7 * 136] = (bf16_t)f2bf(x1.w);
        }
#pragma unroll
        for (int i = 0; i < 4; ++i) {
            const int q = tid + 512 * i, t = q >> 4, c16 = q & 15;
            *(LAS u32x4*)(WL + t * 272 + 16 * c16) = *(const u32x4*)(ws + WS_WSB + (size_t)(g * 128 + t) * 256 + 16 * c16);
        }
        __syncthreads();
        if (xpend) { xp_finish(xi, lane, xr, scr); xpend = false; }
        if (xk < GMLP_ITEMS) { moe_xp_item(p, gw * GMLP_ITEMS + xk, xi); xp_issue(xi, lane, xr); ++xk; xpend = true; }
        f32x4 acc[8];
#pragma unroll
        for (int cb = 0; cb < 8; ++cb) acc[cb] = (f32x4){0.f, 0.f, 0.f, 0.f};
        const int nks = (wave < 4) ? 2 : 4;
        for (int ks = 0; ks < nks; ++ks) {
            const bf16x8_t bfrag = *(const LAS bf16x8_t*)(WL + (16 * wave + l15) * 272 + (32 * ks + 8 * lg) * 2);
#pragma unroll
            for (int cb = 0; cb < 8; ++cb) { const bf16x8_t afrag = *(const LAS bf16x8_t*)(XT + (16 * cb + l15) * 272 + (32 * ks + 8 * lg) * 2);
                acc[cb] = __builtin_amdgcn_mfma_f32_16x16x32_bf16(afrag, bfrag, acc[cb], 0, 0, 0); }
        }
        const int t = 16 * wave + l15; const float bias = b_s[g * 128 + t];
        bf16_t* up = U + (size_t)(tb0 + t) * 1024 + 128 * g + 4 * lg; unsigned char* ya = ws + WS_YA8 + (size_t)(tb0 + t) * 1024 + 128 * g + 4 * lg;
#pragma unroll
        for (int cb = 0; cb < 8; ++cb) { const u32x2 uu = *(const u32x2*)(up + 16 * cb);
            const float u0 = __uint_as_float(uu.x << 16), u1 = __uint_as_float(uu.x & 0xffff0000u), u2 = __uint_as_float(uu.y << 16), u3 = __uint_as_float(uu.y & 0xffff0000u);
            *(unsigned*)(ya + 16 * cb) = pk4_f8(F8_SY * u0 * (acc[cb].x + bias), F8_SY * u1 * (acc[cb].y + bias), F8_SY * u2 * (acc[cb].z + bias), F8_SY * u3 * (acc[cb].w + bias)); }
        if (xpend) { xp_finish(xi, lane, xr, scr); xpend = false; }
        if (xk < GMLP_ITEMS) { moe_xp_item(p, gw * GMLP_ITEMS + xk, xi); xp_issue(xi, lane, xr); ++xk; xpend = true; }
        __syncthreads();
    }
    if (xpend) xp_finish(xi, lane, xr, scr);
    for (; xk < GMLP_ITEMS; ++xk) { moe_xp_item(p, gw * GMLP_ITEMS + xk, xi); xp_issue(xi, lane, xr); xp_finish(xi, lane, xr, scr); }
}
constexpr int XPG_DONE = 2048 * GMLP_ITEMS;
constexpr int XP3_W13 = 0;
constexpr int NW13_ITEMS = XP3_W13 + 2 * 2048;
__device__ __forceinline__ void lds_dma16(const void* gsrc, unsigned lds_dst) {
    unsigned keep;
    asm volatile("s_mov_b32 %0, m0\n\ts_mov_b32 m0, %2\n\ts_nop 0\n\tglobal_load_lds_dwordx4 %1, off\n\ts_mov_b32 m0, %0" : "=&s"(keep) : "v"(gsrc), "s"(lds_dst) : "memory");
}
__device__ __forceinline__ void p3_attn(const Params& p, LAS unsigned char* lds, int blk, int tid, int wave, int lane, size_t out_off, int gw, int ngw) {
    unsigned char* ws = p.ws; bf16_t* Q = (bf16_t*)(ws + WS_Q); const bf16_t* Kb = (const bf16_t*)(ws + WS_K); const bf16_t* VT = (const bf16_t*)(ws + WS_VT); const float* rel = p.in[I_REL];
    constexpr int TILE = 8192, STEPB = 4 * TILE;
    constexpr int QS_OFF = 2 * STEPB;
    constexpr int XS_OFF = QS_OFF + 16384;
    static_assert(XS_OFF + 8 * 8192 <= MISC_OFF, "attention LDS map");
    LAS float* bt2 = (LAS float*)(lds + MISC_OFF + 2048);
    const int l15 = lane & 15, lg = lane >> 4;
    const unsigned onew = ((l15 & 3) == 0) ? 0x3f803f80u : 0u;
    const bf16x8_t ones = __builtin_bit_cast(bf16x8_t, (u32x4){onew, onew, onew, onew});
    const int bh = (blk * 8) >> 6, cpb = (blk * 8) & 63, b = bh >> 4, h = bh & 15;
    __syncthreads();
    if (tid < 384) { int idx = 575 - tid; idx = idx > 512 ? 512 : idx; bt2[tid] = rel[h * 513 + idx] * LOG2E; }
    const float bfar = rel[h * 513 + 512] * LOG2E;
    const f32x4 farv = {bfar, bfar, bfar, bfar}, negv = {-1e30f, -1e30f, -1e30f, -1e30f};
    const int srow = tid >> 3, spc = (tid & 7) ^ (((tid >> 4) & 7) ^ (((tid >> 7) & 1) << 1));
    const bf16_t* gk = Kb + (size_t)(b * SEQ + srow) * 1024 + h * 64 + 8 * spc;
    const bf16_t* gv = VT + ((size_t)((b * 16 + h) * 64 + srow)) * 8192 + 8 * spc;
    const bf16_t* gq = Q + (size_t)(b * SEQ + cpb * 128 + 16 * wave + (lane >> 3)) * 1024 + h * 64;
    const int qpc0 = (lane & 7) ^ ((lane >> 4) & 7), qpc1 = (lane & 7) ^ ((((lane >> 3) + 8) >> 1) & 7);
    const unsigned wbase = (unsigned)wave * 1024u;
    int T = 0;
    for (int i = 0; i < 8; ++i) { const int j0 = 4 - (cpb + i); T += 5 - (j0 > 0 ? j0 : 0); }
    int li = 0, ljp = (4 - cpb) > 0 ? (4 - cpb) : 0, lbuf = 0;
#define AT_DMA() do { const int _kc = 2 * (cpb + li) - 8 + 2 * ljp; const unsigned _d = (unsigned)(lbuf * STEPB) + wbase; \
        lds_dma16(gk + (size_t)_kc * 64 * 1024, _d); lds_dma16(gk + (size_t)(_kc + 1) * 64 * 1024, _d + TILE); lds_dma16(gv + _kc * 64, _d + 2 * TILE); lds_dma16(gv + (_kc + 1) * 64, _d + 3 * TILE); \
        lbuf ^= 1; if (++ljp == 5) { ++li; const int _j0 = 4 - (cpb + li); ljp = _j0 > 0 ? _j0 : 0; } } while (0)
#define AT_QDMA(unit) do { const unsigned _d = (unsigned)QS_OFF + (unsigned)wave * 2048u; const bf16_t* _g = gq + (size_t)(unit) * 128 * 1024; \
        lds_dma16(_g + 8 * qpc0, _d); lds_dma16(_g + (size_t)8 * 1024 + 8 * qpc1, _d + 1024); } while (0)
    AT_QDMA(0);
    AT_DMA();
    asm volatile("s_waitcnt vmcnt(0)" ::: "memory");
    __builtin_amdgcn_s_barrier();
    asm volatile("" ::: "memory");
    const int xv0 = (l15 >> 1) & 7, rl = 8 * (l15 >> 2) + (l15 & 3);
    const int xk0 = ((4 * ((l15 >> 2) & 1)) + ((l15 >> 1) & 1)) ^ (2 * ((l15 >> 3) & 1));
    int kofs[2][2], vofs[2][2];
#pragma unroll
    for (int e = 0; e < 2; ++e)
#pragma unroll
        for (int ks = 0; ks < 2; ++ks) { kofs[e][ks] = rl * 128 + (((lg + 4 * ks) ^ (xk0 ^ (2 * e))) << 4); vofs[e][ks] = l15 * 128 + (((lg + 4 * ks) ^ (xv0 ^ (2 * e))) << 4); }
    const int ko0 = vofs[0][0], ko1 = vofs[0][1];
    int ci = 0, cjp = (4 - cpb) > 0 ? (4 - cpb) : 0, cbuf = 0;
    bf16_t* qp = Q + (size_t)(b * SEQ + cpb * 128 + 16 * wave + l15) * 1024 + h * 64;
    bf16x8_t qf0, qf1;
    f32x4 o[4], osum = {0.f, 0.f, 0.f, 0.f};
#pragma unroll
    for (int db = 0; db < 4; ++db) o[db] = (f32x4){0.f, 0.f, 0.f, 0.f};
    float m = -1e30f;
    const int iq = 16 * (wave & 3) + l15;
    bool ufirst = true;
    int xit = gw; bool xp0 = false, xp1 = false; XpItem x0, x1; x0.src = nullptr; x0.dst = nullptr; x0.ldw = 0; x0.ldd = 0; x0.f8 = 0; x1 = x0;
    auto xdecode = [&](int r, XpItem& x) {
        if (r < XP3_W13) { const int it64 = XPG_DONE + (r >> 1), hk = r & 1;
            const int which = it64 >> 14, rr = it64 & 16383, e = rr >> 9, q = rr & 511, kb = 2 * (q >> 4) + hk, nb = q & 15, f0 = 32 * nb;
            x.src = p.in[which ? I_W3 : I_W1] + (size_t)e * D * FE + (size_t)(32 * kb) * FE + f0; x.ldw = FE;
            x.dst = ws + WS_W13_T + ((size_t)e * 1024 + 256 * (f0 >> 7) + 128 * which + (f0 & 127)) * D + 32 * kb; x.ldd = D; x.f8 = 1; }
        else { const int r2 = r - XP3_W13;
            { const int which = r2 >> 11, q = r2 & 2047, kb = q >> 6, nb = q & 63;
                x.src = p.in[which ? I_WB : I_WA] + (size_t)(32 * kb) * D + 32 * nb; x.ldw = D;
                x.dst = ws + (which ? WS_WB_T : WS_WA_T) + (size_t)(32 * nb) * 1024 + 32 * kb; x.ldd = 1024; x.f8 = 1; } } };
    auto xissue = [&](const XpItem& x, int slot) {
        const unsigned d = (unsigned)XS_OFF + (unsigned)wave * 8192u + (unsigned)slot * 4096u; const float* g = x.src + (size_t)(lane >> 3) * x.ldw + 4 * (lane & 7);
#pragma unroll
        for (int i2 = 0; i2 < 4; ++i2) lds_dma16(g + (size_t)(8 * i2) * x.ldw, d + 1024u * i2); };
    auto xfinish = [&](const XpItem& x, int slot) {
        const LAS float* s = (const LAS float*)(lds + XS_OFF + wave * 8192 + slot * 4096) + (lane & 31);
#pragma unroll
        for (int r = 0; r < 2; ++r) { const int cch = 2 * r + (lane >> 5); const LAS float* sp = s + (8 * cch) * 32;
            if (x.f8) { u32x2 ov; ov.x = pk4_f8(sp[0 * 32] * F8_SW, sp[1 * 32] * F8_SW, sp[2 * 32] * F8_SW, sp[3 * 32] * F8_SW); ov.y = pk4_f8(sp[4 * 32] * F8_SW, sp[5 * 32] * F8_SW, sp[6 * 32] * F8_SW, sp[7 * 32] * F8_SW);
                *(u32x2*)(x.dst + (size_t)(lane & 31) * x.ldd + 8 * cch) = ov; }
            else { u32x4 ov; ov.x = pk2(sp[0 * 32], sp[1 * 32]); ov.y = pk2(sp[2 * 32], sp[3 * 32]); ov.z = pk2(sp[4 * 32], sp[5 * 32]); ov.w = pk2(sp[6 * 32], sp[7 * 32]);
                *(u32x4*)(x.dst + (size_t)(lane & 31) * x.ldd + 16 * cch) = ov; } }
        asm volatile("s_waitcnt lgkmcnt(0)" ::: "memory"); };
    for (int t = 0; t < T; ++t) {
        if (ufirst) {
            const LAS unsigned char* qs = lds + QS_OFF + wave * 2048; qf0 = *(const LAS bf16x8_t*)(qs + ko0); qf1 = *(const LAS bf16x8_t*)(qs + ko1);
            asm volatile("s_waitcnt lgkmcnt(0)" ::: "memory");
            if (ci + 1 < 8) AT_QDMA(ci + 1);
            ufirst = false; }
        const bool tile = li < 8;
        if (tile) AT_DMA();
        bool conv = false;
        if (t & 1) { if (xp1) { xfinish(x1, 1); xp1 = false; } if (xit < NW13_ITEMS) { xdecode(xit, x1); xissue(x1, 1); xp1 = true; xit += ngw; conv = true; } }
        else       { if (xp0) { xfinish(x0, 0); xp0 = false; } if (xit < NW13_ITEMS) { xdecode(xit, x0); xissue(x0, 0); xp0 = true; xit += ngw; conv = true; } }
        const int cp = cpb + ci, kc = 2 * cp - 8 + 2 * cjp, cw = 2 * cp + (wave >> 2);
        const LAS unsigned char* kb_ = lds + cbuf * STEPB; const LAS unsigned char* vb_ = kb_ + 2 * TILE;
        f32x4 s[8];
#pragma unroll
        for (int hf = 0; hf < 2; ++hf) {
            const int dc = cw - kc - hf;
            const LAS unsigned char* kt_ = kb_ + hf * TILE;
            if (dc >= 0 && dc <= 4) {
                const LAS float* bp = bt2 + (319 - dc * 64 - iq + 8 * lg);
#pragma unroll
                for (int kb = 0; kb < 4; ++kb) { const int ko = 32 * (kb >> 1) + 4 * (kb & 1); const f32x4 cin = {bp[ko], bp[ko + 1], bp[ko + 2], bp[ko + 3]};
                    const LAS unsigned char* kr = kt_ + (32 * (kb >> 1) + 4 * (kb & 1)) * 128;
                    const bf16x8_t a0 = *(const LAS bf16x8_t*)(kr + kofs[kb & 1][0]), a1 = *(const LAS bf16x8_t*)(kr + kofs[kb & 1][1]);
                    s[4 * hf + kb] = __builtin_amdgcn_mfma_f32_16x16x32_bf16(a0, qf0, cin, 0, 0, 0);
                    s[4 * hf + kb] = __builtin_amdgcn_mfma_f32_16x16x32_bf16(a1, qf1, s[4 * hf + kb], 0, 0, 0); }
            } else {
                const f32x4 cin = (dc >= 5 && dc <= 8) ? farv : negv;
#pragma unroll
                for (int kb = 0; kb < 4; ++kb) { const LAS unsigned char* kr = kt_ + (32 * (kb >> 1) + 4 * (kb & 1)) * 128;
                    const bf16x8_t a0 = *(const LAS bf16x8_t*)(kr + kofs[kb & 1][0]), a1 = *(const LAS bf16x8_t*)(kr + kofs[kb & 1][1]);
                    s[4 * hf + kb] = __builtin_amdgcn_mfma_f32_16x16x32_bf16(a0, qf0, cin, 0, 0, 0);
                    s[4 * hf + kb] = __builtin_amdgcn_mfma_f32_16x16x32_bf16(a1, qf1, s[4 * hf + kb], 0, 0, 0); }
            }
        }
        float lm = s[0].x;
#pragma unroll
        for (int kb = 0; kb < 8; ++kb) lm = fmaxf(lm, fmaxf(fmaxf(s[kb].x, s[kb].y), fmaxf(s[kb].z, s[kb].w)));
        if (__any(lm > m + 64.0f)) {
            float mx = fmaxf(lm, __shfl_xor(lm, 16)); mx = fmaxf(mx, __shfl_xor(mx, 32));
            const float mn = fmaxf(m, mx), alpha = __builtin_amdgcn_exp2f(m - mn); m = mn;
#pragma unroll
            for (int db = 0; db < 4; ++db) o[db] *= alpha;
            osum *= alpha;
        }
#pragma unroll
        for (int kb = 0; kb < 8; ++kb)
#pragma unroll
            for (int r = 0; r < 4; ++r) s[kb][r] = __builtin_amdgcn_exp2f(s[kb][r] - m);
#pragma unroll
        for (int hf = 0; hf < 2; ++hf) {
            const u32x4 pw0 = pg8::pack8(s[4 * hf + 0], s[4 * hf + 1]), pw1 = pg8::pack8(s[4 * hf + 2], s[4 * hf + 3]);
            const bf16x8_t pb0 = __builtin_bit_cast(bf16x8_t, pw0), pb1 = __builtin_bit_cast(bf16x8_t, pw1);
#pragma unroll
            for (int db = 0; db < 4; ++db) {
                const LAS unsigned char* vr = vb_ + hf * TILE + db * 2048;
                const bf16x8_t v0 = *(const LAS bf16x8_t*)(vr + vofs[db & 1][0]), v1 = *(const LAS bf16x8_t*)(vr + vofs[db & 1][1]);
                o[db] = __builtin_amdgcn_mfma_f32_16x16x32_bf16(v0, pb0, o[db], 0, 0, 0);
                o[db] = __builtin_amdgcn_mfma_f32_16x16x32_bf16(v1, pb1, o[db], 0, 0, 0);
            }
            osum = __builtin_amdgcn_mfma_f32_16x16x32_bf16(ones, pb0, osum, 0, 0, 0);
            osum = __builtin_amdgcn_mfma_f32_16x16x32_bf16(ones, pb1, osum, 0, 0, 0);
        }
        cbuf ^= 1;
        if (++cjp == 5) {
            const float inv = F8_SY / osum.x;
#pragma unroll
            for (int db = 0; db < 4; ++db) *(unsigned*)(ws + WS_YB8 + (size_t)(qp - Q) + 16 * db + 4 * lg) = pk4_f8(o[db].x * inv, o[db].y * inv, o[db].z * inv, o[db].w * inv);
            ++ci; const int j0 = 4 - (cpb + ci); cjp = j0 > 0 ? j0 : 0; ufirst = true;
            if (ci < 8) {
                qp += (size_t)128 * 1024;
#pragma unroll
                for (int db = 0; db < 4; ++db) o[db] = (f32x4){0.f, 0.f, 0.f, 0.f};
                osum = (f32x4){0.f, 0.f, 0.f, 0.f}; m = -1e30f;
            }
        }
        if (conv) asm volatile("s_waitcnt vmcnt(4) lgkmcnt(0)" ::: "memory"); else asm volatile("s_waitcnt vmcnt(0) lgkmcnt(0)" ::: "memory");
        __builtin_amdgcn_s_barrier();
        asm volatile("" ::: "memory");
        (void)tile;
    }
#undef AT_DMA
#undef AT_QDMA
    asm volatile("s_waitcnt vmcnt(0)" ::: "memory");
    if (xp0) xfinish(x0, 0);
    if (xp1) xfinish(x1, 1);
    for (; xit < NW13_ITEMS; xit += ngw) { xdecode(xit, x0); xissue(x0, 0); asm volatile("s_waitcnt vmcnt(0)" ::: "memory"); xfinish(x0, 0); }
}
__device__ __forceinline__ void p6_norm2_route(const Params& p, LAS unsigned char* lds, int blk, int tid, int wave, int lane, bool dry) {
    unsigned char* ws = p.ws; const float* mod = (const float*)(ws + WS_MOD);
    LAS float* A2 = (LAS float*)lds; LAS float* S2 = A2 + D; LAS float* rs = (LAS float*)(lds + 16384);
    LAS int* hist = (LAS int*)(lds + 16640); LAS int* base = hist + 32; LAS int* ent_e = base + 32; LAS int* ent_r = ent_e + 128; LAS float* ent_w = (LAS float*)(ent_r + 128);
    LAS float* part = (LAS float*)(lds + 32768);
    const int bb = blk >> 7, l15 = lane & 15, kg = lane >> 4;
    for (int k = tid; k < D; k += NTHREADS) { A2[k] = p.in[I_N2G][k] * (1.f + mod[bb * NMOD + 4 * D + k]); S2[k] = mod[bb * NMOD + 3 * D + k]; }
    if (tid < 32) hist[tid] = 0;
    const bf16_t* x1 = (const bf16_t*)(ws + WS_X1B); unsigned char* H2 = ws + WS_H;
    for (int i = 0; i < 8; i += 4) {
        const int r = wave * 8 + i; const u32x4* xr = (const u32x4*)(x1 + (size_t)(blk * 64 + r) * D) + lane; u32x4 raw[4][4];
#pragma unroll
        for (int q = 0; q < 4; ++q)
#pragma unroll
            for (int j = 0; j < 4; ++j) raw[q][j] = xr[(size_t)q * (D / 8) + 64 * j];
#pragma unroll
        for (int q = 0; q < 4; ++q) { float ss = 0.f;
#pragma unroll
            for (int j = 0; j < 4; ++j) { f32x4 v, w; pg8::unpack8(raw[q][j], v, w); ss += ((v.x * v.x + v.y * v.y) + (v.z * v.z + v.w * v.w)) + ((w.x * w.x + w.y * w.y) + (w.z * w.z + w.w * w.w)); }
            ss = wave_sum(ss);
            if (lane == 0) rs[r + q] = rsqrtf(ss * (1.f / D) + EPS); }
    }
    __syncthreads();
    {
        float rs4[4];
#pragma unroll
        for (int rb = 0; rb < 4; ++rb) rs4[rb] = rs[16 * rb + l15];
        f32x4 acc[4][3];
#pragma unroll
        for (int rb = 0; rb < 4; ++rb)
#pragma unroll
            for (int cb = 0; cb < 3; ++cb) acc[rb][cb] = (f32x4){0.f, 0.f, 0.f, 0.f};
        const bf16_t* wrt = (const bf16_t*)(ws + WS_WRT);
        for (int kh = 0; kh < 2; ++kh) {
            const int k0 = 256 * wave + 128 * kh + 32 * kg;
            u32x4 xr[4][4];
#pragma unroll
            for (int rb = 0; rb < 4; ++rb)
#pragma unroll
                for (int j = 0; j < 4; ++j) xr[rb][j] = *(const u32x4*)(x1 + (size_t)(blk * 64 + 16 * rb + l15) * D + k0 + 8 * j);
            unsigned f8w[4][8];
#pragma unroll
            for (int j = 0; j < 4; ++j) {
                const f32x4 a0 = *(const LAS f32x4*)(A2 + k0 + 8 * j), a1 = *(const LAS f32x4*)(A2 + k0 + 8 * j + 4), s0 = *(const LAS f32x4*)(S2 + k0 + 8 * j), s1 = *(const LAS f32x4*)(S2 + k0 + 8 * j + 4);
                bf16x8_t bh[3], bl[3];
#pragma unroll
                for (int cb = 0; cb < 3; ++cb) { bh[cb] = *(const bf16x8_t*)(wrt + (size_t)(16 * cb + l15) * D + k0 + 8 * j); bl[cb] = *(const bf16x8_t*)(wrt + (size_t)(48 + 16 * cb + l15) * D + k0 + 8 * j); }
#pragma unroll
                for (int rb = 0; rb < 4; ++rb) {
                    f32x4 x0, x1v; pg8::unpack8(xr[rb][j], x0, x1v);
                    const f32x4 h0 = x0 * rs4[rb] * a0 + s0, h1 = x1v * rs4[rb] * a1 + s1;
                    const u32x4 hw = pg8::pack8(h0, h1);
                    f8w[rb][2 * j] = pk4_f8(h0.x * F8_SH2, h0.y * F8_SH2, h0.z * F8_SH2, h0.w * F8_SH2); f8w[rb][2 * j + 1] = pk4_f8(h1.x * F8_SH2, h1.y * F8_SH2, h1.z * F8_SH2, h1.w * F8_SH2);
                    f32x4 c0, c1; pg8::unpack8(hw, c0, c1);
                    const u32x4 lw = pg8::pack8(h0 - c0, h1 - c1);
                    const bf16x8_t hi = __builtin_bit_cast(bf16x8_t, hw), lo = __builtin_bit_cast(bf16x8_t, lw);
#pragma unroll
                    for (int cb = 0; cb < 3; ++cb) {
                        acc[rb][cb] = __builtin_amdgcn_mfma_f32_16x16x32_bf16(hi, bh[cb], acc[rb][cb], 0, 0, 0);
                        acc[rb][cb] = __builtin_amdgcn_mfma_f32_16x16x32_bf16(lo, bh[cb], acc[rb][cb], 0, 0, 0);
                        acc[rb][cb] = __builtin_amdgcn_mfma_f32_16x16x32_bf16(hi, bl[cb], acc[rb][cb], 0, 0, 0);
                    }
                }
            }
#pragma unroll
            for (int rb = 0; rb < 4; ++rb) { unsigned char* hp = H2 + (size_t)(blk * 64 + 16 * rb + l15) * D + k0;
                *(u32x4*)hp = (u32x4){f8w[rb][0], f8w[rb][1], f8w[rb][2], f8w[rb][3]}; *(u32x4*)(hp + 16) = (u32x4){f8w[rb][4], f8w[rb][5], f8w[rb][6], f8w[rb][7]}; }
        }
#pragma unroll
        for (int rb = 0; rb < 4; ++rb)
#pragma unroll
            for (int cb = 0; cb < 3; ++cb)
#pragma unroll
                for (int rr = 0; rr < 4; ++rr) part[(wave * 64 + 16 * rb + 4 * kg + rr) * 48 + 16 * cb + l15] = acc[rb][cb][rr];
    }
    __syncthreads();
    for (int q = tid; q < 64 * 48; q += NTHREADS) { float s = 0.f;
#pragma unroll
        for (int w = 0; w < 8; ++w) s += part[w * 64 * 48 + q];
        part[q] = s; }
    __syncthreads();
    if (tid < 64) {
        const LAS float* lg = part + tid * 48;
        const float g0 = lg[0], g1 = lg[1], g2 = lg[2], g3 = lg[3];
        int g = 0; float gm = g0;
        if (g1 > gm) { gm = g1; g = 1; } if (g2 > gm) { gm = g2; g = 2; } if (g3 > gm) { gm = g3; g = 3; }
        const float gweight = 1.f / (expf(g0 - gm) + expf(g1 - gm) + expf(g2 - gm) + expf(g3 - gm));
        const LAS float* el = lg + 4 + 8 * g;
        int i1 = 0; float m1 = el[0];
        for (int q = 1; q < 8; ++q) { const float v = el[q]; if (v > m1) { m1 = v; i1 = q; } }
        int i2 = -1; float m2 = -3.0e38f;
        for (int q = 0; q < 8; ++q) { const float v = el[q]; if (q != i1 && v > m2) { m2 = v; i2 = q; } }
        const float t = expf(m2 - m1), p1 = 1.f / (1.f + t), p2 = t / (1.f + t);
        const int e1 = g * 8 + i1, e2 = g * 8 + i2;
        ent_e[2 * tid] = e1; ent_r[2 * tid] = __hip_atomic_fetch_add(hist + e1, 1, __ATOMIC_RELAXED, __HIP_MEMORY_SCOPE_WORKGROUP); ent_w[2 * tid] = gweight * p1;
        ent_e[2 * tid + 1] = e2; ent_r[2 * tid + 1] = __hip_atomic_fetch_add(hist + e2, 1, __ATOMIC_RELAXED, __HIP_MEMORY_SCOPE_WORKGROUP); ent_w[2 * tid + 1] = gweight * p2;
    }
    __syncthreads();
    unsigned* ctl = (unsigned*)(ws + WS_CTL);
    if (tid < 32) base[tid] = (hist[tid] && !dry) ? (int)__hip_atomic_fetch_add(ctl + CW_CNT + 64 * tid, (unsigned)hist[tid], __ATOMIC_RELAXED, __HIP_MEMORY_SCOPE_AGENT) : 0;
    __syncthreads();
    if (tid < 128 && !dry) {
        const int e = ent_e[tid], idx = base[e] + ent_r[tid], slot = (blk * 64 + (tid >> 1)) * 2 + (tid & 1);
        ((int*)(ws + WS_TOKLIST))[e * 16384 + idx] = slot; ((int*)(ws + WS_SLOTE))[slot] = e * 16384 + idx; ((float*)(ws + WS_ROWW))[e * 16384 + idx] = ent_w[tid];
    }
    __syncthreads();
}
__device__ __forceinline__ void p9_final(const Params& p, LAS unsigned char* lds, const MoeTab& T, int blk, int tid, int wave, int lane, bool build, size_t dry_off, unsigned char* dry_base) {
    unsigned char* ws = p.ws; const float* mod = (const float*)(ws + WS_MOD);
    if (build) build_tables((const unsigned*)(ws + WS_CTL), T, tid);
    const int bb = blk >> 7; const float* g2 = mod + bb * NMOD + 5 * D; const float* fg = p.in[I_FING];
    const unsigned char* YS = (const unsigned char*)(ws + WS_YS); const int* slote = (const int*)(ws + WS_SLOTE);
    for (int i = 0; i < 8; ++i) {
        const int row = blk * 64 + wave * 8 + i;
        const int se0 = slote[2 * row], se1 = slote[2 * row + 1];
        const size_t p0 = (size_t)T.tb[se0 >> 14] * 256 + (se0 & 16383), p1 = (size_t)T.tb[se1 >> 14] * 256 + (se1 & 16383);
        f32x4* xr = (f32x4*)(p.out + (size_t)row * D) + lane; const u32x2* x1r = (const u32x2*)((const bf16_t*)(ws + WS_X1B) + (size_t)row * D) + lane;
        const unsigned* y0 = (const unsigned*)(YS + p0 * D) + lane; const unsigned* y1 = (const unsigned*)(YS + p1 * D) + lane;
        f32x4 v[8]; float ss = 0.f;
#pragma unroll
        for (int j = 0; j < 8; ++j) { const u32x2 xw = __builtin_nontemporal_load(x1r + 64 * j); const f32x4 xv = {__uint_as_float(xw.x << 16), __uint_as_float(xw.x & 0xffff0000u), __uint_as_float(xw.y << 16), __uint_as_float(xw.y & 0xffff0000u)}; const unsigned a = __builtin_nontemporal_load(y0 + 64 * j), b = __builtin_nontemporal_load(y1 + 64 * j); const f32x4 gg = *(const f32x4*)(g2 + 256 * j + 4 * lane) * (1.0f / 64.0f);
            f32x4 ys; ys.x = __builtin_amdgcn_cvt_f32_fp8(a, 0) + __builtin_amdgcn_cvt_f32_fp8(b, 0); ys.y = __builtin_amdgcn_cvt_f32_fp8(a, 1) + __builtin_amdgcn_cvt_f32_fp8(b, 1);
            ys.z = __builtin_amdgcn_cvt_f32_fp8(a, 2) + __builtin_amdgcn_cvt_f32_fp8(b, 2); ys.w = __builtin_amdgcn_cvt_f32_fp8(a, 3) + __builtin_amdgcn_cvt_f32_fp8(b, 3);
            v[j] = xv + gg * ys; ss += (v[j].x * v[j].x + v[j].y * v[j].y) + (v[j].z * v[j].z + v[j].w * v[j].w); }
        const float rstd = rsqrtf(wave_sum(ss) * (1.f / D) + EPS);
        f32x4* xo = dry_base ? (f32x4*)(dry_base + dry_off + (size_t)row * D * 4) + lane : xr;
#pragma unroll
        for (int j = 0; j < 8; ++j) { const f32x4 f = *(const f32x4*)(fg + 256 * j + 4 * lane); xo[64 * j] = v[j] * rstd * f; }
    }
}

__device__ __forceinline__ void rowquant2048(const bf16_t* src, unsigned char* dst, float* step, int gw, int lane) {
    for (int i = 0; i < 8; i += 4) {
        const int row = gw * 8 + i; u32x4 raw[4][4];
#pragma unroll
        for (int r = 0; r < 4; ++r)
#pragma unroll
            for (int j = 0; j < 4; ++j) raw[r][j] = *((const u32x4*)(src + (size_t)(row + r) * D) + lane + 64 * j);
#pragma unroll
        for (int r = 0; r < 4; ++r) {
            f32x4 v[4][2]; float am = 0.f;
#pragma unroll
            for (int j = 0; j < 4; ++j) { pg8::unpack8(raw[r][j], v[j][0], v[j][1]);
#pragma unroll
                for (int h = 0; h < 2; ++h) am = fmaxf(fmaxf(am, fmaxf(fabsf(v[j][h].x), fabsf(v[j][h].y))), fmaxf(fabsf(v[j][h].z), fabsf(v[j][h].w))); }
            am = wave_max(am); const float sq = am > 0.f ? 127.f / am : 0.f;
            if (lane == 0) step[row + r] = am * (1.f / 127.f);
#pragma unroll
            for (int j = 0; j < 4; ++j) { const f32x4 a = v[j][0] * sq + I8MAGIC, b = v[j][1] * sq + I8MAGIC;
                u32x2 o; o.x = pack4_i8(__float_as_uint(a.x), __float_as_uint(a.y), __float_as_uint(a.z), __float_as_uint(a.w)); o.y = pack4_i8(__float_as_uint(b.x), __float_as_uint(b.y), __float_as_uint(b.z), __float_as_uint(b.w));
                *((u32x2*)(dst + (size_t)(row + r) * D) + lane + 64 * j) = o; }
        }
    }
}

__device__ __forceinline__ void xq_issue(const XpItem& x, int lane, f32x4 (&v)[8]) {
    const float* q = x.src + (size_t)(lane >> 3) * x.ldw + 4 * (lane & 7); const size_t step = (size_t)8 * x.ldw;
#pragma unroll
    for (int i = 0; i < 8; ++i) { v[i] = __builtin_nontemporal_load((const f32x4*)q); q += step; asm volatile("" : "+v"(q)); }
}
__device__ __forceinline__ void xq_finish(const XpItem& x, int lane, const f32x4 (&v)[8], LAS float* scr) {
#pragma unroll
    for (int i = 0; i < 8; ++i) { LAS float* d = scr + (8 * i + (lane >> 3)) * 33 + 4 * (lane & 7); d[0] = v[i].x; d[1] = v[i].y; d[2] = v[i].z; d[3] = v[i].w; }
    asm volatile("s_waitcnt lgkmcnt(0)" ::: "memory");
    const int cch = lane & 7;
#pragma unroll
    for (int j = 0; j < 4; ++j) { const int n = (lane >> 3) + 8 * j; const LAS float* s = scr + (8 * cch) * 33 + n;
        u32x2 o; o.x = pk4_f8(s[0 * 33] * F8_SW, s[1 * 33] * F8_SW, s[2 * 33] * F8_SW, s[3 * 33] * F8_SW); o.y = pk4_f8(s[4 * 33] * F8_SW, s[5 * 33] * F8_SW, s[6 * 33] * F8_SW, s[7 * 33] * F8_SW);
        *(u32x2*)(x.dst + (size_t)n * x.ldd + 8 * cch) = o; }
    asm volatile("s_waitcnt lgkmcnt(0)" ::: "memory");
}
__device__ __forceinline__ void p2_w13_convert(const Params& p, LAS unsigned char* lds, int gw, int ngw, int wave, int lane) {
    LAS float* scr = (LAS float*)(lds + wave * 16384);
    XpItem x0, x1, x2, x3; x0.src = nullptr; x0.dst = nullptr; x0.ldw = 0; x0.ldd = 0; x0.f8 = 1; x1 = x0; x2 = x0; x3 = x0; f32x4 r0[8], r1[8], r2[8], r3[8];
    int it = gw; bool p0 = false, p1 = false, p2 = false, p3 = false;
#define P2C_ISSUE(X, R, P) do { if (it < 2 * NEXP * 512) { moe_xp_item(p, it, X); xq_issue(X, lane, R); P = true; it += ngw; } } while (0)
#define P2C_STEP(X, R, P) do { if (P) { xq_finish(X, lane, R, scr); P = false; P2C_ISSUE(X, R, P); } } while (0)
    P2C_ISSUE(x0, r0, p0); P2C_ISSUE(x1, r1, p1); P2C_ISSUE(x2, r2, p2); P2C_ISSUE(x3, r3, p3);
    while (p0 || p1 || p2 || p3) { P2C_STEP(x0, r0, p0); P2C_STEP(x1, r1, p1); P2C_STEP(x2, r2, p2); P2C_STEP(x3, r3, p3); }
#undef P2C_ISSUE
#undef P2C_STEP
}

__global__ void __launch_bounds__(NTHREADS, 2) mk_fwd(Params p) {
    extern __shared__ __attribute__((aligned(16))) unsigned char lds_raw[];
    LAS unsigned char* lds = (LAS unsigned char*)lds_raw;
    const int wave = __builtin_amdgcn_readfirstlane(threadIdx.x >> 6);
    const int G = gridDim.x, blk = blockIdx.x, gw = blk * NWAVES + wave, ngw = G * NWAVES;
#define FRESH_IDS const int lane = fresh_lane(), tid = wave * 64 + lane; (void)tid; (void)lane
    MoeTab T{(LAS int*)(lds + MISC_OFF + 64), (LAS int*)(lds + MISC_OFF + 256), (LAS int*)(lds + MISC_OFF + 512)};
    const int lo = p.ph_lo, hi = p.ph_hi;
    if (threadIdx.x < 4) ((LAS unsigned*)(lds + MISC_OFF))[threadIdx.x] = 0u;
    __syncthreads();
    XcdBarrier bar = xcd_barrier_post((unsigned*)(p.ws + WS_CTL) + CW_BAR, (volatile LAS unsigned*)(lds + MISC_OFF));
#define IN(k) (lo <= (k) && (k) < hi)
#define SEAM(k) do { if (IN(k) && IN((k) + 1)) xcd_barrier(bar); } while (0)
    if (IN(0)) { FRESH_IDS; p0_prologue(p, lds, gw, ngw, wave, lane); }
    SEAM(0);
    if (IN(1)) { FRESH_IDS; p1_norm1(p, lds, blk, tid, wave, lane); }
    SEAM(1);
    unsigned char* ws = p.ws;
    if (IN(2)) {
        pg8::SchedGrid S{(const char*)(ws + WS_H), (const char*)(ws + WS_WIN_T), D / 2, D / 2, 64, 36, G, blk};
        pg8::EpiProj E{(bf16_t*)(p.alt), (bf16_t*)(p.alt + (WS_V - WS_U)), (bf16_t*)(p.alt + (WS_Q - WS_U)), (bf16_t*)(p.alt + (WS_K - WS_U)), (bf16_t*)(p.alt + (WS_VT - WS_U)), (bf16_t*)p.altg,
                       (const float*)(ws + WS_HSC), (const float*)(ws + WS_CS)};
        const bool early = (blk >> 3) & 1;
        if (early) { FRESH_IDS; p2_ada_late(p, blk, wave, lane); p2_w13_convert(p, lds, gw, ngw, wave, lane); __syncthreads(); }
        pg8::gemm_phase(lds, D / 2, S, E, wave);
        if (!early) { FRESH_IDS; p2_ada_late(p, blk, wave, lane); p2_w13_convert(p, lds, gw, ngw, wave, lane); }
    }
    SEAM(2);
    if (IN(3)) { FRESH_IDS;
        if (blk < 96 && tid < 256) {
            const float* modp = (const float*)(ws + WS_MODP); const int j = blk * 256 + tid, b2 = j / NMOD, col = j % NMOD; float v = p.in[I_ADAB][col];
            for (int q = 0; q < 32; ++q) v += modp[(size_t)(q * 2 + b2) * NMOD + col];
            ((float*)(ws + WS_MOD))[j] = v; }
        p3_gmlp(p, lds, blk, tid, wave, lane, 0, gw); p3_attn(p, lds, blk, tid, wave, lane, 0, gw, ngw); }
    SEAM(3);
    if (IN(4)) {
        pg8::SchedBranch S{(const char*)(ws + WS_YA8), (const char*)(ws + WS_WA_T), (const char*)(ws + WS_YB8), (const char*)(ws + WS_WB_T), G, blk};
        pg8::EpiBranch E{(const unsigned short*)(ws + WS_G), (bf16_t*)(ws + WS_MIX), {}};
        pg8::gemm_phase(lds, 512, S, E, wave);
    }
    SEAM(4);
    if (IN(5)) {
        { FRESH_IDS; rowquant2048((const bf16_t*)(ws + WS_MIX), ws + WS_V, (float*)(ws + WS_SM), gw, lane); }
        xcd_barrier(bar);
        pg8::SchedGrid S{(const char*)(ws + WS_V), (const char*)(ws + WS_WOUT_T), D / 2, D / 2, 64, 8, G, blk};
        pg8::EpiOut E{p.in[I_X], (const float*)(ws + WS_MOD), (bf16_t*)(ws + WS_X1B), (const float*)(ws + WS_SM), (const float*)(ws + WS_CSO)};
        pg8::gemm_phase(lds, D / 2, S, E, wave);
    }
    SEAM(5);
    if (IN(6)) { FRESH_IDS; p6_norm2_route(p, lds, blk, tid, wave, lane, false); }
    SEAM(6);
    if (IN(7)) {
        { FRESH_IDS; build_tables((const unsigned*)(ws + WS_CTL), T, tid); }
        LAS int* ltok = (LAS int*)(lds + MISC_OFF + 4096);
        { FRESH_IDS; const int* toklist = (const int*)(ws + WS_TOKLIST);
          if (tid < 256) for (int i = 0; i < 3; ++i) { const int L = i * G + blk, rt = L >> 2; if (rt < T.tb[NEXP]) { const int e = T.rte[rt], r0 = (rt - T.tb[e]) * 256, nv = T.cn[e] - r0; ltok[i * 256 + tid] = toklist[e * 16384 + r0 + (tid < nv ? tid : 0)] >> 1; } }
          __syncthreads(); }
        pg8::SchedMoeUp S{(const char*)(ws + WS_H), (const char*)(ws + WS_W13_T), (const LAS int*)ltok, T, G, blk};
        pg8::EpiMoeUp E{ws + WS_ACT};
        pg8::gemm_phase(lds, D / 2, S, E, wave);
        {
            FRESH_IDS; const int U = 4 * T.tb[NEXP], fi = (U - 2 * G) > 0 ? (U - 2 * G) : 0;
            if (blk >= fi) { const int nidle = G - fi; LAS float* scr = (LAS float*)(lds + wave * 16384); XpItem xi;
                for (int it = (blk - fi) * NWAVES + wave; it < NEXP * 512; it += nidle * NWAVES) { moe_xp_item(p, 2 * NEXP * 512 + it, xi); p0_transpose_item(xi.src, xi.ldw, xi.dst, xi.ldd, scr, lane); } }
        }
    }
    SEAM(7);
    if (IN(8)) {
        if (lo == 8) { FRESH_IDS; build_tables((const unsigned*)(ws + WS_CTL), T, tid); }
        pg8::SchedMoeDown S{(const char*)(ws + WS_ACT), (const char*)(ws + WS_W2_T), T, G, blk};
        pg8::EpiMoeDown E{(const float*)(ws + WS_ROWW), (unsigned char*)(ws + WS_YS)};
        pg8::gemm_phase(lds, FE / 2, S, E, wave);
    }
    SEAM(8);
    if (IN(9)) { FRESH_IDS; p9_final(p, lds, T, blk, tid, wave, lane, lo == 9, 0, nullptr); }
#undef IN
#undef SEAM
}

extern "C" void kernel_launch(void* const* d_in, const int* in_sizes, int n_in, void* d_out, int out_size, void* d_ws, size_t ws_size, hipStream_t stream) {
    static int grid = 0;
    if (grid == 0) {
        if (n_in != 21 || out_size != M * D || ws_size < WS_END) { fprintf(stderr, "kernel_launch: unexpected problem (n_in %d out %d ws %zu)\n", n_in, out_size, ws_size); grid = -1; return; }
        if (hipFuncSetAttribute((const void*)mk_fwd, hipFuncAttributeMaxDynamicSharedMemorySize, LDS_BYTES) != hipSuccess) { fprintf(stderr, "kernel_launch: hipFuncSetAttribute failed\n"); grid = -1; return; }
        int dev = 0, cus = 0, per_cu = 0;
        if (hipGetDevice(&dev) != hipSuccess || hipDeviceGetAttribute(&cus, hipDeviceAttributeMultiprocessorCount, dev) != hipSuccess) { fprintf(stderr, "kernel_launch: device query failed\n"); grid = -1; return; }
        if (hipOccupancyMaxActiveBlocksPerMultiprocessor(&per_cu, (const void*)mk_fwd, NTHREADS, LDS_BYTES) != hipSuccess) per_cu = 0;
        (void)hipGetLastError();
        if (cus != 256 || per_cu < 1) { fprintf(stderr, "kernel_launch: built for 256 CUs with one resident workgroup each (got %d CUs, %d per CU)\n", cus, per_cu); grid = -1; return; }
        grid = 256;
    }
    if (grid < 0) return;
    unsigned char* ws = (unsigned char*)d_ws;
    (void)hipMemsetAsync(ws + WS_CTL, 0, CTL_BYTES, stream);
    Params p{};
    for (int i = 0; i < 21; ++i) p.in[i] = (const float*)d_in[i];
    p.out = (float*)d_out; p.ws = ws; p.alt = ws + WS_U; p.altg = (float*)(ws + WS_G);
    auto frame = [&](int lo, int hi) { p.ph_lo = lo; p.ph_hi = hi; hipLaunchKernelGGL(mk_fwd, dim3(grid), dim3(NTHREADS), LDS_BYTES, stream, p); };
    frame(0, 10);
}
```

```cpp
#include <hip/hip_runtime.h>
#include <cstdio>
#include <cstdint>

#ifndef GMLP_ITEMS
#define GMLP_ITEMS 0
#endif
constexpr int D = 2048, NB = 2, SEQ = 8192, M = NB * SEQ;
constexpr int NCOLS = 9216, GW = 1024, AW = 1024, NH = 16, HD = 64;
constexpr int NEXP = 32, FE = 512, NMOD = 6 * D;
constexpr int MAXRT = 160, MPAD = MAXRT * 256;
constexpr float EPS = 1e-6f;
constexpr float LOG2E = 1.4426950408889634f;
constexpr float QSCALE = 0.125f * LOG2E;

constexpr size_t MiB = 1u << 20;
constexpr size_t WS_CTL = 0, CTL_BYTES = 1 * MiB;
constexpr size_t WS_MODP = 1 * MiB;
constexpr size_t WS_MOD = 4 * MiB;
constexpr size_t WS_HSC = 4 * MiB + 512 * 1024;
constexpr size_t WS_CS = WS_HSC + 64 * 1024;
constexpr size_t WS_WSB = WS_HSC + 128 * 1024;
constexpr size_t WS_COLMAX_O = WS_CTL + 576 * 1024;
constexpr size_t WS_CSO = WS_HSC + 112 * 1024;
constexpr size_t WS_SM = WS_HSC;
constexpr size_t WS_COLMAX = WS_CTL + 512 * 1024;
constexpr size_t WS_TOKLIST = 5 * MiB;
constexpr size_t WS_SLOTE = 7 * MiB;
constexpr size_t WS_SLOTW = 7 * MiB + 256 * 1024;
constexpr size_t WS_WRT = 7 * MiB + 512 * 1024;
constexpr size_t WS_WIN_T = 8 * MiB;
constexpr size_t WS_WA_T = 44 * MiB;
constexpr size_t WS_WB_T = 48 * MiB;
constexpr size_t WS_WOUT_T = 52 * MiB;
constexpr size_t WS_W13_T = 60 * MiB;
constexpr size_t WS_W2_T = 188 * MiB;
constexpr size_t WS_H = 252 * MiB;
constexpr size_t WS_YA8 = WS_H, WS_YB8 = WS_H + 16 * MiB;
constexpr size_t WS_U = 316 * MiB;
constexpr size_t WS_V = 348 * MiB;
constexpr size_t WS_Q = 380 * MiB;
constexpr size_t WS_K = 412 * MiB;
constexpr size_t WS_VT = 444 * MiB;
constexpr size_t WS_G = 476 * MiB;
constexpr size_t WS_MIX = 604 * MiB;
constexpr size_t WS_END = 668 * MiB;
constexpr size_t WS_X1B = 540 * MiB;
constexpr size_t WS_ROWW = WS_MIX;
constexpr size_t WS_ACT = WS_U;
constexpr size_t WS_YS = WS_U + 40 * MiB;
static_assert(WS_YS + (size_t)MPAD * D * 2 <= WS_X1B && WS_X1B + (size_t)M * D * 2 <= WS_MIX && WS_X1B >= WS_G, "MoE buffers overlay the dead mixer buffers");
constexpr int CW_TMO = 0, CW_CODE = 1, CW_CNT = 1024  , CW_BAR = 4096;

typedef unsigned short bf16_t;
typedef float f32x4 __attribute__((ext_vector_type(4)));
typedef float f32x2 __attribute__((ext_vector_type(2)));
typedef unsigned u32x4 __attribute__((ext_vector_type(4)));
typedef unsigned u32x2 __attribute__((ext_vector_type(2)));
#define LAS __attribute__((address_space(3)))

__device__ __forceinline__ int fresh_lane() { int l; asm volatile("v_mbcnt_lo_u32_b32 %0, -1, 0\n\tv_mbcnt_hi_u32_b32 %0, -1, %0" : "=v"(l)); return l; }
__device__ __forceinline__ float bf2f(bf16_t v) { return __uint_as_float(((unsigned)v) << 16); }
__device__ __forceinline__ unsigned f2bf(float f) { unsigned u = __float_as_uint(f); return (u + 0x7fffu + ((u >> 16) & 1u)) >> 16; }
typedef __bf16 bf16x2v_t __attribute__((ext_vector_type(2)));
__device__ __forceinline__ unsigned pk2(float lo, float hi) { f32x2 v = {lo, hi}; bf16x2v_t b = __builtin_convertvector(v, bf16x2v_t); return __builtin_bit_cast(unsigned, b); }
__device__ __forceinline__ float clamp448(float x) { return __builtin_fminf(__builtin_fmaxf(x, -448.f), 448.f); }
__device__ __forceinline__ unsigned pk4_f8(float a, float b, float c, float d) {
    const unsigned w = __builtin_amdgcn_cvt_pk_fp8_f32(clamp448(a), clamp448(b), 0, false); return __builtin_amdgcn_cvt_pk_fp8_f32(clamp448(c), clamp448(d), w, true); }
constexpr float F8_SW = 256.f, F8_SH2 = 16.f, F8_SACT = 8.f, F8_SY = 16.f;
__device__ __forceinline__ float wave_max(float v) {
#pragma unroll
    for (int o = 32; o > 0; o >>= 1) v = fmaxf(v, __shfl_xor(v, o, 64));
    return v; }
constexpr float I8MAGIC = 12582912.f;
__device__ __forceinline__ unsigned pack4_i8(unsigned a, unsigned b, unsigned c, unsigned d) { return (a & 0xffu) | ((b & 0xffu) << 8) | ((c & 0xffu) << 16) | (d << 24); }
__device__ __forceinline__ float wave_sum(float v) {
#pragma unroll
    for (int o = 1; o < 64; o <<= 1) v += __shfl_xor(v, o);
    return v;
}
__device__ __forceinline__ float gelu_erf(float x) { return 0.5f * x * (1.0f + erff(x * 0.70710678118654752f)); }
__device__ __forceinline__ float sigmoidf_(float x) { return 1.0f / (1.0f + __expf(-x)); }
__device__ __forceinline__ float siluf_(float x) { return x / (1.0f + __expf(-x)); }

struct Params {
    const float* in[21];
    float* out;
    unsigned char* ws;
    int ph_lo, ph_hi;
    unsigned char* alt;
    float* altg;
};
enum { I_X = 0, I_C, I_ADAW, I_ADAB, I_N1G, I_WIN, I_LNG, I_LNB, I_WS, I_BS, I_REL, I_WA, I_WB, I_WOUT, I_N2G, I_WGRP, I_WEXP, I_W1, I_W3, I_W2, I_FING };

struct MoeTab { LAS int* tb; LAS int* cn; LAS int* rte; };
__device__ __forceinline__ void build_tables(const unsigned* ctl, const MoeTab& T, int tid) {
    if (tid == 0) {
        int acc = 0;
        for (int e = 0; e < NEXP; ++e) {
            const int c = (int)__hip_atomic_load(ctl + CW_CNT + 64 * e, __ATOMIC_RELAXED, __HIP_MEMORY_SCOPE_AGENT);
            T.cn[e] = c; T.tb[e] = acc; const int nt = (c + 255) >> 8;
            for (int t = 0; t < nt; ++t) T.rte[acc + t] = e;
            acc += nt;
        }
        T.tb[NEXP] = acc;
    }
    __syncthreads();
}

namespace pg8 {
typedef short bf16x8 __attribute__((ext_vector_type(8)));
typedef int i32x4 __attribute__((ext_vector_type(4)));
typedef int i32x8 __attribute__((ext_vector_type(8)));
constexpr int BM = 256, BK = 64, HALF = 128, HTB = HALF * BK * 2, STAGE_BYTES = 8 * HTB;
__device__ __forceinline__ int lds_byte(int r, int c) { const int st = (r >> 4) * 2 + (c >> 5), rr = r & 15, cc = c & 31, ob = rr * 64 + cc * 2; return st * 1024 + (ob ^ (((ob >> 9) & 1) << 5)); }
__device__ __forceinline__ void stage_rc(int b, int& R, int& C) { const int st = b / 1024, sb = b % 1024, swz = sb ^ (((sb >> 9) & 1) << 5); R = (st >> 1) * 16 + swz / 64; C = (st & 1) * 32 + (swz % 64) / 2; }
__device__ __forceinline__ int perm32(int rho) { const int n = rho >> 4, i = rho & 15; return 8 * (i >> 2) + 4 * n + (i & 3); }
struct Unit { const char* A; const char* B; int pm, pn, aux, aux2; };
typedef __bf16 bf16x2_t __attribute__((ext_vector_type(2)));
__device__ __forceinline__ unsigned cvt_pk_bf16(float lo, float hi) { f32x2 v = {lo, hi}; bf16x2_t b = __builtin_convertvector(v, bf16x2_t); return __builtin_bit_cast(unsigned, b); }
__device__ __forceinline__ f32x2 gelu_pk(f32x2 v) {
    const f32x2 av = __builtin_elementwise_abs(v), d = av * 0.2316418882f + 1.0f;
    f32x2 t; t.x = __builtin_amdgcn_rcpf(d.x); t.y = __builtin_amdgcn_rcpf(d.y);
    f32x2 q = t * 0.5307027145f + (-0.7265760135f); q = q * t + 0.7107068705f; q = q * t + (-0.142248368f); q = q * t + 0.127414796f; q = q * t;
    const f32x2 s = (v * v) * (-0.72134752044f);
    f32x2 e; e.x = __builtin_amdgcn_exp2f(s.x); e.y = __builtin_amdgcn_exp2f(s.y);
    const f32x2 m = v * (q * e), r = v - m;
    f32x2 o; o.x = v.x < 0.f ? m.x : r.x; o.y = v.y < 0.f ? m.y : r.y; return o;
}
__device__ __forceinline__ bool static_tile(int L, int nM, int nN, int& pm, int& pn) {
    const int nwg = nM * nN; if (L >= nwg) return false;
    int wgid = L; { const int q = nwg / 8, r = nwg % 8, xcd = wgid % 8, off = wgid / 8; wgid = (xcd < r ? xcd * (q + 1) : r * (q + 1) + (xcd - r) * q) + off; }
    const int nig = 8 * nN, gid = wgid / nig, fm = gid * 8, gsz = (nM - fm) < 8 ? (nM - fm) : 8;
    pm = fm + ((wgid % nig) % gsz); pn = (wgid % nig) / gsz; return true;
}

template <class Epi, class Sched>
__device__ __forceinline__ void gemm_phase(LAS unsigned char* lds, const int K, const Sched& S, const Epi& E, const int wid) {
    const int lane = fresh_lane(), tid = wid * 64 + lane, wr = wid >> 2, wc = wid & 3, fr = lane & 15, fq = lane >> 4;
    const int nt = K / BK;
    int R[2], C[2]; unsigned voffB[2];
#pragma unroll
    for (int i = 0; i < 2; ++i) { stage_rc(tid * 16 + i * 8192, R[i], C[i]); const int Rb = Epi::PERM ? ((R[i] & ~31) + perm32(R[i] & 31)) : R[i]; voffB[i] = (unsigned)(Rb * K + C[i]) * 2u; }
    const size_t kstep = (size_t)(BK * 2);
    const size_t hstep = (size_t)HALF * K * 2;
    const unsigned ldsw = (unsigned)wid * 1024u;
    const int aoff = lds_byte(wr * 64 + fr, fq * 8), boff = lds_byte(wc * 32 + fr, fq * 8);
#define PG8_SA(b, h) (((b) * 2 + (h)) * HTB)
#define PG8_SB(b, h) ((4 + (b) * 2 + (h)) * HTB)
#define PG8_STAGE(bufoff, gbase, voff) do { _Pragma("unroll") for (int _i = 0; _i < 2; ++_i) \
        __builtin_amdgcn_global_load_lds((const unsigned*)((const char*)(gbase) + (voff)[_i]), (LAS unsigned*)(lds + (bufoff) + ldsw + _i * 8192), 16, 0, 0); } while (0)
#define PG8_LDA(dst, b, h) do { if constexpr (Epi::MODE == 2) { _Pragma("unroll") for (int m = 0; m < 4; ++m) dst##8[m] = __builtin_shufflevector(*(const LAS i32x4*)(lds + PG8_SA(b, h) + aoff + m * 2048), *(const LAS i32x4*)(lds + PG8_SA(b, h) + aoff + m * 2048 + 1024), 0, 1, 2, 3, 4, 5, 6, 7); } \
        else { _Pragma("unroll") for (int m = 0; m < 4; ++m) _Pragma("unroll") for (int k = 0; k < 2; ++k) dst[m][k] = *(const LAS bf16x8*)(lds + PG8_SA(b, h) + aoff + m * 2048 + k * 1024); } } while (0)
#define PG8_LDB(dst, b, h) do { if constexpr (Epi::MODE == 2) { _Pragma("unroll") for (int n = 0; n < 2; ++n) dst##8[n] = __builtin_shufflevector(*(const LAS i32x4*)(lds + PG8_SB(b, h) + boff + n * 2048), *(const LAS i32x4*)(lds + PG8_SB(b, h) + boff + n * 2048 + 1024), 0, 1, 2, 3, 4, 5, 6, 7); } \
        else { _Pragma("unroll") for (int n = 0; n < 2; ++n) _Pragma("unroll") for (int k = 0; k < 2; ++k) dst[n][k] = *(const LAS bf16x8*)(lds + PG8_SB(b, h) + boff + n * 2048 + k * 1024); } } while (0)
#define PG8_MMA(ai, bj, At, Bt) do { __builtin_amdgcn_s_setprio(1); _Pragma("unroll") for (int m = 0; m < 4; ++m) _Pragma("unroll") for (int n = 0; n < 2; ++n) _Pragma("unroll") for (int k = 0; k < 2; ++k) \
        { if constexpr (Epi::MODE == 1) acc[ai][bj][m][n] = __builtin_bit_cast(f32x4, __builtin_amdgcn_mfma_i32_16x16x64_i8(__builtin_bit_cast(i32x4, Bt[n][k]), __builtin_bit_cast(i32x4, At[m][k]), __builtin_bit_cast(i32x4, acc[ai][bj][m][n]), 0, 0, 0)); \
          else if constexpr (Epi::MODE == 2) { if (k == 0) asm volatile("v_mfma_f32_16x16x128_f8f6f4 %0, %1, %2, %0" : "+v"(acc[ai][bj][m][n]) : "v"(Bt##8[n]), "v"(At##8[m])); } \
          else acc[ai][bj][m][n] = __builtin_amdgcn_mfma_f32_16x16x32_bf16(Bt[n][k], At[m][k], acc[ai][bj][m][n], 0, 0, 0); } __builtin_amdgcn_s_setprio(0); } while (0)
#define PG8_WAIT_V(n) asm volatile("s_waitcnt vmcnt(" #n ")" ::: "memory")
#define PG8_WAIT_L(n) asm volatile("s_waitcnt lgkmcnt(" #n ")" ::: "memory")
#define PG8_BAR __builtin_amdgcn_s_barrier()
#define PG8_SCHED __builtin_amdgcn_sched_barrier(0)
    Unit cur, nxt; int ui = 0;
    if (!S.next(0, cur)) return;
    f32x4 acc[2][2][4][2];
#pragma unroll
    for (int a = 0; a < 2; ++a)
#pragma unroll
        for (int b = 0; b < 2; ++b)
#pragma unroll
            for (int m = 0; m < 4; ++m)
#pragma unroll
                for (int n = 0; n < 2; ++n) acc[a][b][m][n] = (f32x4){0.f, 0.f, 0.f, 0.f};
    bf16x8 At[4][2], B0[2][2], B1[2][2];
    i32x8 At8[4], B08[2], B18[2];
    unsigned voffA[2][2], nvoffA[2][2];
    S.arows(cur, voffA, R, C);
    const char* cA = cur.A; const char* cB = cur.B;
    PG8_STAGE(PG8_SB(0, 0), cB, voffB); PG8_STAGE(PG8_SB(0, 1), cB + hstep, voffB); PG8_STAGE(PG8_SA(0, 0), cA, voffA[0]); PG8_STAGE(PG8_SA(0, 1), cA, voffA[1]);
    if (wr == 1) PG8_BAR;
    PG8_WAIT_V(2); PG8_BAR;
    PG8_STAGE(PG8_SB(1, 0), cB + kstep, voffB); PG8_STAGE(PG8_SA(1, 0), cA + kstep, voffA[0]); PG8_STAGE(PG8_SB(1, 1), cB + hstep + kstep, voffB);
    PG8_WAIT_V(6); PG8_BAR;
    for (;;) {
        const bool has_next = S.next(ui + 1, nxt);
        if (has_next && Sched::GATHER) S.arows(nxt, nvoffA, R, C);
        else {
#pragma unroll
            for (int h = 0; h < 2; ++h)
#pragma unroll
                for (int i = 0; i < 2; ++i) nvoffA[h][i] = voffA[h][i]; }
        const char* nA = has_next ? nxt.A : cA; const char* nB = has_next ? nxt.B : cB;
#pragma nounroll
        for (int t = 0; t < nt; t += 2) {
            const bool last = (t == nt - 2);
            const char* a1 = cA + (size_t)(t + 1) * kstep;
            const char* a2 = last ? nA : cA + (size_t)(t + 2) * kstep; const char* b2 = last ? nB : cB + (size_t)(t + 2) * kstep;
            const char* a3 = a2 + kstep; const char* b3 = b2 + kstep;
            unsigned o2[2][2];
#pragma unroll
            for (int h = 0; h < 2; ++h)
#pragma unroll
                for (int i = 0; i < 2; ++i) o2[h][i] = (Sched::GATHER && last) ? nvoffA[h][i] : voffA[h][i];
            PG8_LDB(B0, 0, 0); PG8_LDB(B1, 0, 1); PG8_SCHED; PG8_LDA(At, 0, 0); PG8_STAGE(PG8_SA(1, 1), a1, voffA[1]);
            PG8_WAIT_V(8); PG8_WAIT_L(0); PG8_BAR; PG8_MMA(0, 0, At, B0); PG8_MMA(0, 1, At, B1); PG8_BAR; PG8_SCHED;
            PG8_LDA(At, 0, 1); PG8_STAGE(PG8_SB(0, 0), b2, voffB); PG8_STAGE(PG8_SB(0, 1), b2 + hstep, voffB); PG8_STAGE(PG8_SA(0, 0), a2, o2[0]);
            PG8_WAIT_V(8); PG8_WAIT_L(0); PG8_BAR; PG8_MMA(1, 0, At, B0); PG8_MMA(1, 1, At, B1); PG8_BAR; PG8_SCHED;
            PG8_LDB(B0, 1, 0); PG8_LDB(B1, 1, 1); PG8_SCHED; PG8_LDA(At, 1, 0); PG8_STAGE(PG8_SA(0, 1), a2, o2[1]);
            PG8_WAIT_V(8); PG8_WAIT_L(0); PG8_BAR; PG8_MMA(0, 0, At, B0); PG8_MMA(0, 1, At, B1); PG8_BAR; PG8_SCHED;
            PG8_LDA(At, 1, 1); PG8_STAGE(PG8_SB(1, 0), b3, voffB); PG8_STAGE(PG8_SB(1, 1), b3 + hstep, voffB); PG8_STAGE(PG8_SA(1, 0), a3, o2[0]);
            PG8_WAIT_V(8); PG8_WAIT_L(0); PG8_BAR; PG8_MMA(1, 0, At, B0); PG8_MMA(1, 1, At, B1); PG8_BAR; PG8_SCHED;
        }
        if constexpr (Epi::MODE == 2) asm volatile("s_nop 15\n\ts_nop 15" ::: "memory");
        if (wr == 0) PG8_BAR;
        const int le = fresh_lane();
        const bool keep = E(acc, cur, wr, wc, le & 15, le >> 4);
        if (!has_next) break;
        if (!keep) {
#pragma unroll
            for (int a = 0; a < 2; ++a)
#pragma unroll
                for (int b = 0; b < 2; ++b)
#pragma unroll
                    for (int m = 0; m < 4; ++m)
#pragma unroll
                        for (int n = 0; n < 2; ++n) acc[a][b][m][n] = (f32x4){0.f, 0.f, 0.f, 0.f}; }
        cur = nxt; cA = nA; cB = nB; ++ui;
#pragma unroll
        for (int h = 0; h < 2; ++h)
#pragma unroll
            for (int i = 0; i < 2; ++i) if (Sched::GATHER) voffA[h][i] = nvoffA[h][i];
        if (wr == 1) PG8_BAR;
    }
    PG8_WAIT_V(0);
    PG8_BAR;
#undef PG8_SA
#undef PG8_SB
#undef PG8_STAGE
#undef PG8_LDA
#undef PG8_LDB
#undef PG8_MMA
#undef PG8_WAIT_V
#undef PG8_WAIT_L
#undef PG8_BAR
#undef PG8_SCHED
}

struct SchedGrid {
    static constexpr bool GATHER = false;
    const char* A; const char* B; int lda, K, nM, nN, G, c;
    __device__ __forceinline__ bool next(int i, Unit& u) const { int pm, pn; if (!static_tile(i * G + c, nM, nN, pm, pn)) return false;
        u.A = A + (size_t)pm * 256 * lda * 2; u.B = B + (size_t)pn * 256 * K * 2; u.pm = pm; u.pn = pn; u.aux = 0; u.aux2 = 0; return true; }
    __device__ __forceinline__ void arows(const Unit&, unsigned (&off)[2][2], const int (&R)[2], const int (&C)[2]) const {
#pragma unroll
        for (int h = 0; h < 2; ++h)
#pragma unroll
            for (int i = 0; i < 2; ++i) off[h][i] = (unsigned)((h * 128 + R[i]) * lda + C[i]) * 2u; }
};
struct SchedBranch {
    static constexpr bool GATHER = false;
    const char* A0; const char* B0; const char* A1; const char* B1; int G, c;
    __device__ __forceinline__ bool next(int i, Unit& u) const { int pm, pn; if (!static_tile((i >> 1) * G + c, 64, 8, pm, pn)) return false; const int br = i & 1;
        u.A = (br ? A1 : A0) + (size_t)pm * 256 * 1024; u.B = (br ? B1 : B0) + (size_t)pn * 256 * 1024; u.pm = pm; u.pn = pn; u.aux = br; u.aux2 = 0; return true; }
    __device__ __forceinline__ void arows(const Unit&, unsigned (&off)[2][2], const int (&R)[2], const int (&C)[2]) const {
#pragma unroll
        for (int h = 0; h < 2; ++h)
#pragma unroll
            for (int i = 0; i < 2; ++i) off[h][i] = (unsigned)((h * 128 + R[i]) * 1024) + 2u * (unsigned)C[i]; }
};
struct SchedMoeUp {
    static constexpr bool GATHER = true;
    const char* H2; const char* W13; const LAS int* ltok; MoeTab T; int G, c;
    __device__ __forceinline__ bool next(int i, Unit& u) const { const int L = i * G + c, rt = L >> 2, ct = L & 3; if (rt >= __builtin_amdgcn_readfirstlane(T.tb[NEXP])) return false;
        const int e = __builtin_amdgcn_readfirstlane(T.rte[rt]), r0 = (rt - __builtin_amdgcn_readfirstlane(T.tb[e])) * 256, nv = __builtin_amdgcn_readfirstlane(T.cn[e]) - r0;
        u.A = H2; u.B = W13 + ((size_t)e * 1024 + ct * 256) * D; u.pm = rt; u.pn = ct; u.aux = nv < 256 ? nv : 256; u.aux2 = i; return true; }
    __device__ __forceinline__ void arows(const Unit& u, unsigned (&off)[2][2], const int (&R)[2], const int (&C)[2]) const {
#pragma unroll
        for (int h = 0; h < 2; ++h)
#pragma unroll
            for (int i = 0; i < 2; ++i) { const int tok = ltok[u.aux2 * 256 + h * 128 + R[0] + 64 * i]; off[h][i] = (unsigned)(tok * D) + 2u * (unsigned)C[0]; } }
};
struct SchedMoeDown {
    static constexpr bool GATHER = false;
    const char* ACT; const char* W2; MoeTab T; int G, c;
    __device__ __forceinline__ bool next(int i, Unit& u) const { const int L = i * G + c, rt = L >> 3, ct = L & 7; if (rt >= __builtin_amdgcn_readfirstlane(T.tb[NEXP])) return false;
        const int e = __builtin_amdgcn_readfirstlane(T.rte[rt]), r0 = (rt - __builtin_amdgcn_readfirstlane(T.tb[e])) * 256, nv = __builtin_amdgcn_readfirstlane(T.cn[e]) - r0;
        u.A = ACT + (size_t)rt * 256 * FE; u.B = W2 + ((size_t)e * D + ct * 256) * FE; u.pm = rt; u.pn = ct; u.aux = nv < 256 ? nv : 256; u.aux2 = e * 16384 + r0; return true; }
    __device__ __forceinline__ void arows(const Unit&, unsigned (&off)[2][2], const int (&R)[2], const int (&C)[2]) const {
#pragma unroll
        for (int h = 0; h < 2; ++h)
#pragma unroll
            for (int i = 0; i < 2; ++i) off[h][i] = (unsigned)((h * 128 + R[i]) * FE) + 2u * (unsigned)C[i]; }
};

__device__ __forceinline__ u32x4 pack8(const f32x4& v0, const f32x4& v1) { u32x4 w; w.x = cvt_pk_bf16(v0[0], v0[1]); w.y = cvt_pk_bf16(v0[2], v0[3]); w.z = cvt_pk_bf16(v1[0], v1[1]); w.w = cvt_pk_bf16(v1[2], v1[3]); return w; }
__device__ __forceinline__ void unpack8(const u32x4& w, f32x4& v0, f32x4& v1) {
    v0[0] = __uint_as_float(w.x << 16); v0[1] = __uint_as_float(w.x & 0xffff0000u); v0[2] = __uint_as_float(w.y << 16); v0[3] = __uint_as_float(w.y & 0xffff0000u);
    v1[0] = __uint_as_float(w.z << 16); v1[1] = __uint_as_float(w.z & 0xffff0000u); v1[2] = __uint_as_float(w.w << 16); v1[3] = __uint_as_float(w.w & 0xffff0000u); }
__device__ __forceinline__ f32x4 sig4(const f32x4& v) { f32x4 o;
#pragma unroll
    for (int j = 0; j < 4; ++j) o[j] = __builtin_amdgcn_rcpf(1.0f + __builtin_amdgcn_exp2f(-LOG2E * v[j])); return o; }

struct EpiProj {
    static constexpr bool PERM = true; static constexpr int MODE = 1;
    bf16_t *U, *V, *Q, *Kb, *VT, *G; const float *HSC, *CS;
    __device__ __forceinline__ bool operator()(f32x4 (&acc)[2][2][4][2], const Unit& u, int wr, int wc, int fr, int fq) const {
        const int pn = u.pn, row0 = u.pm * BM + wr * 64 + fr, cl = wc * 32 + 8 * fq;
        {
            const float* hs = HSC + row0; const f32x4* cp = (const f32x4*)(CS + pn * 256 + cl);
            float rs[2][4]; f32x4 cs[2][2];
#pragma unroll
            for (int ai = 0; ai < 2; ++ai)
#pragma unroll
                for (int m = 0; m < 4; ++m) rs[ai][m] = hs[ai * HALF + m * 16];
#pragma unroll
            for (int bj = 0; bj < 2; ++bj) { cs[bj][0] = cp[bj * 32]; cs[bj][1] = cp[bj * 32 + 1]; }
#pragma unroll
            for (int ai = 0; ai < 2; ++ai)
#pragma unroll
                for (int bj = 0; bj < 2; ++bj)
#pragma unroll
                    for (int m = 0; m < 4; ++m)
#pragma unroll
                        for (int n = 0; n < 2; ++n) acc[ai][bj][m][n] = __builtin_convertvector(__builtin_bit_cast(i32x4, acc[ai][bj][m][n]), f32x4) * (cs[bj][n] * rs[ai][m]);
        }
        if (pn < 8) {
            bf16_t* base = (pn < 4 ? U : V) + (pn & 3) * 256 + cl;
#pragma unroll
            for (int ai = 0; ai < 2; ++ai)
#pragma unroll
                for (int m = 0; m < 4; ++m) { bf16_t* rowp = base + (size_t)(row0 + ai * HALF + m * 16) * 1024;
#pragma unroll
                    for (int bj = 0; bj < 2; ++bj) { const f32x4 v0 = acc[ai][bj][m][0], v1 = acc[ai][bj][m][1];
                        const f32x2 a = gelu_pk((f32x2){v0[0], v0[1]}), b = gelu_pk((f32x2){v0[2], v0[3]}), c = gelu_pk((f32x2){v1[0], v1[1]}), d = gelu_pk((f32x2){v1[2], v1[3]});
                        *(u32x4*)(rowp + bj * HALF) = pack8((f32x4){a.x, a.y, b.x, b.y}, (f32x4){c.x, c.y, d.x, d.y}); } }
        } else if (pn < 16) {
            bf16_t* base = (pn < 12 ? Q : Kb) + (pn & 3) * 256 + cl; const float sc = pn < 12 ? QSCALE : 1.0f;
#pragma unroll
            for (int ai = 0; ai < 2; ++ai)
#pragma unroll
                for (int m = 0; m < 4; ++m) { bf16_t* rowp = base + (size_t)(row0 + ai * HALF + m * 16) * 1024;
#pragma unroll
                    for (int bj = 0; bj < 2; ++bj) *(u32x4*)(rowp + bj * HALF) = pack8(acc[ai][bj][m][0] * sc, acc[ai][bj][m][1] * sc); }
        } else if (pn < 20) {
#ifndef DIAG_NOVT
#pragma unroll
            for (int ai = 0; ai < 2; ++ai)
#pragma unroll
                for (int m = 0; m < 4; ++m) { const int row = row0 + ai * HALF + m * 16, b = row >> 13, s = row & 8191;
#pragma unroll
                    for (int bj = 0; bj < 2; ++bj) { const int c5 = (pn - 16) * 256 + bj * HALF + cl, hh = c5 >> 6, d = c5 & 63;
                        bf16_t* bp = VT + ((size_t)((b * 16 + hh) * 64 + d)) * 8192 + s; const u32x4 w = pack8(acc[ai][bj][m][0], acc[ai][bj][m][1]);
                        bp[0 * 8192] = (bf16_t)(w.x & 0xffffu); bp[1 * 8192] = (bf16_t)(w.x >> 16); bp[2 * 8192] = (bf16_t)(w.y & 0xffffu); bp[3 * 8192] = (bf16_t)(w.y >> 16);
                        bp[4 * 8192] = (bf16_t)(w.z & 0xffffu); bp[5 * 8192] = (bf16_t)(w.z >> 16); bp[6 * 8192] = (bf16_t)(w.w & 0xffffu); bp[7 * 8192] = (bf16_t)(w.w >> 16); } }
#endif
        } else {
            unsigned short* base = (unsigned short*)G + (pn - 20) * 128 + cl;
#pragma unroll
            for (int ai = 0; ai < 2; ++ai)
#pragma unroll
                for (int m = 0; m < 4; ++m) { unsigned short* rowp = base + (size_t)(row0 + ai * HALF + m * 16) * D;
                    const f32x4 a0 = sig4(acc[ai][0][m][0]), a1 = sig4(acc[ai][0][m][1]), b0 = sig4(acc[ai][1][m][0]), b1 = sig4(acc[ai][1][m][1]);
                    unsigned q[8];
#pragma unroll
                    for (int j = 0; j < 4; ++j) { unsigned qa = (unsigned)(a0[j] * 255.f + 0.5f), qb = (unsigned)(b0[j] * 255.f + 0.5f); qa = qa < 1u ? 1u : qa; qb = qb < 1u ? 1u : qb; q[j] = qa | (qb << 8);
                        unsigned ra = (unsigned)(a1[j] * 255.f + 0.5f), rb = (unsigned)(b1[j] * 255.f + 0.5f); ra = ra < 1u ? 1u : ra; rb = rb < 1u ? 1u : rb; q[4 + j] = ra | (rb << 8); }
                    u32x4 w; w.x = q[0] | (q[1] << 16); w.y = q[2] | (q[3] << 16); w.z = q[4] | (q[5] << 16); w.w = q[6] | (q[7] << 16);
                    __builtin_nontemporal_store(w, (u32x4*)rowp); }
        }
        return false;
    }
};
struct EpiBranch {
    static constexpr bool PERM = true; static constexpr int MODE = 2;
    const unsigned short* G; bf16_t* MIX;
    mutable unsigned gbk[2][4][2][2];
    __device__ __forceinline__ bool operator()(f32x4 (&acc)[2][2][4][2], const Unit& u, int wr, int wc, int fr, int fq) const {
        const int row0 = u.pm * BM + wr * 64 + fr, col0 = u.pn * BM + wc * 32 + 8 * fq; const bool brb = u.aux != 0;
        if (!brb) {
#pragma unroll
            for (int ai = 0; ai < 2; ++ai) {
                u32x4 g[4][2];
#pragma unroll
                for (int m = 0; m < 4; ++m)
#pragma unroll
                    for (int bj = 0; bj < 2; ++bj) g[m][bj] = __builtin_nontemporal_load((const u32x4*)(G + (size_t)(row0 + ai * HALF + m * 16) * D + col0 + bj * HALF));
#pragma unroll
                for (int m = 0; m < 4; ++m)
#pragma unroll
                    for (int bj = 0; bj < 2; ++bj) {
                        const unsigned w[4] = {g[m][bj].x, g[m][bj].y, g[m][bj].z, g[m][bj].w};
#pragma unroll
                        for (int j = 0; j < 4; ++j) {
                            const float r0 = (float)(w[j] & 0xffu) * __builtin_amdgcn_rcpf((float)((w[j] >> 8) & 0xffu)), r1 = (float)((w[j] >> 16) & 0xffu) * __builtin_amdgcn_rcpf((float)(w[j] >> 24));
                            acc[ai][bj][m][j >> 1][2 * (j & 1)] *= r0; acc[ai][bj][m][j >> 1][2 * (j & 1) + 1] *= r1; }
                        gbk[ai][m][bj][0] = ((w[0] >> 8) & 0xffu) | ((w[0] >> 24) << 8) | (((w[1] >> 8) & 0xffu) << 16) | ((w[1] >> 24) << 24);
                        gbk[ai][m][bj][1] = ((w[2] >> 8) & 0xffu) | ((w[2] >> 24) << 8) | (((w[3] >> 8) & 0xffu) << 16) | ((w[3] >> 24) << 24);
                    }
            }
            return true;
        }
#pragma unroll
        for (int ai = 0; ai < 2; ++ai)
#pragma unroll
            for (int m = 0; m < 4; ++m)
#pragma unroll
                for (int bj = 0; bj < 2; ++bj) {
                    const unsigned k0 = gbk[ai][m][bj][0], k1 = gbk[ai][m][bj][1];
                    const f32x4 b0 = (f32x4){(float)(k0 & 0xffu), (float)((k0 >> 8) & 0xffu), (float)((k0 >> 16) & 0xffu), (float)(k0 >> 24)} * (1.f / (255.f * F8_SY * F8_SW));
                    const f32x4 b1 = (f32x4){(float)(k1 & 0xffu), (float)((k1 >> 8) & 0xffu), (float)((k1 >> 16) & 0xffu), (float)(k1 >> 24)} * (1.f / (255.f * F8_SY * F8_SW));
                    *(u32x4*)(MIX + (size_t)(row0 + ai * HALF + m * 16) * D + col0 + bj * HALF) = pack8(acc[ai][bj][m][0] * b0, acc[ai][bj][m][1] * b1);
                }
        return false;
    }
};
struct EpiOut {
    static constexpr bool PERM = true; static constexpr int MODE = 1;
    const float* x; const float* mod; bf16_t* out; const float *SM, *CSO;
    __device__ __forceinline__ bool operator()(f32x4 (&acc)[2][2][4][2], const Unit& u, int wr, int wc, int fr, int fq) const {
        const int row0 = u.pm * BM + wr * 64 + fr, col0 = u.pn * BM + wc * 32 + 8 * fq; const float* g1 = mod + ((u.pm * BM) >> 13) * NMOD + 2 * D;
        f32x4 gv[2][2];
#pragma unroll
        for (int bj = 0; bj < 2; ++bj)
#pragma unroll
            for (int n = 0; n < 2; ++n) gv[bj][n] = *(const f32x4*)(g1 + col0 + bj * HALF + 4 * n) * *(const f32x4*)(CSO + col0 + bj * HALF + 4 * n);
#pragma unroll
        for (int ai = 0; ai < 2; ++ai)
#pragma unroll
            for (int m = 0; m < 4; ++m) { const float rs = SM[row0 + ai * HALF + m * 16];
#pragma unroll
                for (int bj = 0; bj < 2; ++bj)
#pragma unroll
                    for (int n = 0; n < 2; ++n) acc[ai][bj][m][n] = __builtin_convertvector(__builtin_bit_cast(i32x4, acc[ai][bj][m][n]), f32x4) * rs; }
#pragma unroll
        for (int ai = 0; ai < 2; ++ai)
#pragma unroll
            for (int mh = 0; mh < 2; ++mh) {
                f32x4 xv[2][2][2];
#pragma unroll
                for (int m = 0; m < 2; ++m)
#pragma unroll
                    for (int bj = 0; bj < 2; ++bj)
#pragma unroll
                        for (int n = 0; n < 2; ++n) xv[m][bj][n] = __builtin_nontemporal_load((const f32x4*)(x + (size_t)(row0 + ai * HALF + (2 * mh + m) * 16) * D + col0 + bj * HALF + 4 * n));
#pragma unroll
                for (int m = 0; m < 2; ++m)
#pragma unroll
                    for (int bj = 0; bj < 2; ++bj)
                        *(u32x4*)(out + (size_t)(row0 + ai * HALF + (2 * mh + m) * 16) * D + col0 + bj * HALF) =
                            pack8(xv[m][bj][0] + gv[bj][0] * acc[ai][bj][2 * mh + m][0], xv[m][bj][1] + gv[bj][1] * acc[ai][bj][2 * mh + m][1]);
            }
        return false;
    }
};
struct EpiMoeUp {
    static constexpr bool PERM = true; static constexpr int MODE = 2;
    unsigned char* ACT;
    __device__ __forceinline__ bool operator()(f32x4 (&acc)[2][2][4][2], const Unit& u, int wr, int wc, int fr, int fq) const {
        const int f0 = u.pn * 128 + wc * 32 + 8 * fq;
#pragma unroll
        for (int ai = 0; ai < 2; ++ai)
#pragma unroll
            for (int m = 0; m < 4; ++m) { const int r = ai * HALF + wr * 64 + m * 16 + fr; const bool valid = r < u.aux;
                f32x4 o[2];
#pragma unroll
                for (int n = 0; n < 2; ++n) { const f32x4 a = acc[ai][0][m][n] * (1.f / (F8_SH2 * F8_SW)), b = acc[ai][1][m][n] * (F8_SACT / (F8_SH2 * F8_SW));
#pragma unroll
                    for (int j = 0; j < 4; ++j) o[n][j] = valid ? a[j] * __builtin_amdgcn_rcpf(1.0f + __builtin_amdgcn_exp2f(-LOG2E * a[j])) * b[j] : 0.f; }
                *(u32x2*)(ACT + ((size_t)u.pm * 256 + r) * FE + f0) = (u32x2){pk4_f8(o[0][0], o[0][1], o[0][2], o[0][3]), pk4_f8(o[1][0], o[1][1], o[1][2], o[1][3])}; }
        return false;
    }
};
struct EpiMoeDown {
    static constexpr bool PERM = true; static constexpr int MODE = 2;
    const float* roww; unsigned char* YS;
    __device__ __forceinline__ bool operator()(f32x4 (&acc)[2][2][4][2], const Unit& u, int wr, int wc, int fr, int fq) const {
        const int col0 = u.pn * BM + wc * 32 + 8 * fq;
        float w[2][4];
#pragma unroll
        for (int ai = 0; ai < 2; ++ai)
#pragma unroll
            for (int m = 0; m < 4; ++m) { const int r = ai * HALF + wr * 64 + m * 16 + fr; w[ai][m] = (64.0f / (F8_SACT * F8_SW)) * roww[u.aux2 + (r < u.aux ? r : 0)]; }
#pragma unroll
        for (int ai = 0; ai < 2; ++ai)
#pragma unroll
            for (int m = 0; m < 4; ++m) { const int r = ai * HALF + wr * 64 + m * 16 + fr;
#pragma unroll
                for (int bj = 0; bj < 2; ++bj) { const f32x4 v0 = acc[ai][bj][m][0] * w[ai][m], v1 = acc[ai][bj][m][1] * w[ai][m];
                    unsigned lo = __builtin_amdgcn_cvt_pk_fp8_f32(v0[0], v0[1], 0, false); lo = __builtin_amdgcn_cvt_pk_fp8_f32(v0[2], v0[3], lo, true);
                    unsigned hi = __builtin_amdgcn_cvt_pk_fp8_f32(v1[0], v1[1], 0, false); hi = __builtin_amdgcn_cvt_pk_fp8_f32(v1[2], v1[3], hi, true);
                    *(u32x2*)(YS + ((size_t)u.pm * 256 + r) * D + col0 + bj * HALF) = (u32x2){lo, hi}; } }
        return false;
    }
};
}

#define XB_TMO      128
#define XB_XCNT(j)  (256  + 64 * (j))
#define XB_XSUB(j)  (1280 + 64 * (j))
#define XB_XGEN(j)  (2304 + 64 * (j))
#define XB_TOP      3328
#define XB_TOPGEN   3392
#define XCD_BAR_WORDS 3456
#define XB_SPIN_CAP (1u << 18)

__device__ __forceinline__ unsigned xb_ld(unsigned* p)              { return __hip_atomic_load(p, __ATOMIC_RELAXED, __HIP_MEMORY_SCOPE_AGENT); }
__device__ __forceinline__ unsigned xb_add(unsigned* p, unsigned v) { return __hip_atomic_fetch_add(p, v, __ATOMIC_RELAXED, __HIP_MEMORY_SCOPE_AGENT); }
__device__ __forceinline__ unsigned xb_xcc_id() { return (unsigned)__builtin_amdgcn_s_getreg((3 << 11) | 20) & 0xFu; }
#define XB_SPIN(cond, bar) do { unsigned _sp = 0; while (cond) { __builtin_amdgcn_s_sleep(1); \
    if ((++_sp & 255u) == 0u) { if (xb_ld(&(bar)[XB_TMO])) break; if (_sp > XB_SPIN_CAP) { atomicAdd(&(bar)[XB_TMO], 1u); break; } } } } while (0)

struct XcdBarrier {
    unsigned* bar; unsigned x;
    volatile LAS unsigned* st;
};

__device__ __forceinline__ XcdBarrier xcd_barrier_post(unsigned* bar, volatile LAS unsigned* st) {
    XcdBarrier b; b.bar = bar; b.x = xb_xcc_id(); b.st = st;
    if (threadIdx.x == 0) (void)xb_add(&bar[XB_XCNT(b.x)], 1u);
    return b;
}
__device__ __forceinline__ void xcd_barrier_complete(unsigned* bar, unsigned x, unsigned& nloc, unsigned& nx) {
    const unsigned G = gridDim.x * gridDim.y * gridDim.z;
    unsigned sum, cnt, mine, sp = 0u;
    for (;;) {
        sum = 0u; cnt = 0u; mine = 0u;
#pragma unroll
        for (unsigned j = 0; j < 16; ++j) { const unsigned c = xb_ld(&bar[XB_XCNT(j)]); sum += c; cnt += (c > 0u) ? 1u : 0u; mine = (j == x) ? c : mine; }
        if (sum == G) break;
        __builtin_amdgcn_s_sleep(1);
        if ((++sp & 255u) == 0u) { if (xb_ld(&bar[XB_TMO])) break; if (sp > XB_SPIN_CAP) { atomicAdd(&bar[XB_TMO], 1u); break; } }
    }
    nloc = mine > 0u ? mine : 1u; nx = cnt > 0u ? cnt : 1u;
}

__device__ __forceinline__ void xcd_barrier(const XcdBarrier& b) {
    asm volatile("s_waitcnt vmcnt(0)" ::: "memory");
    __syncthreads();
    if (threadIdx.x == 0) {
        unsigned* bar = b.bar;
        __builtin_amdgcn_s_waitcnt(0);
        unsigned nloc = b.st[0], nx = b.st[1];
        if (nloc == 0u) { xcd_barrier_complete(bar, b.x, nloc, nx); b.st[0] = nloc; b.st[1] = nx; }
        const unsigned old = xb_add(&bar[XB_XSUB(b.x)], 1u);
        const unsigned gen = old / nloc;
        if (old + 1u == (gen + 1u) * nloc) {
            __builtin_amdgcn_fence(__ATOMIC_RELEASE, "agent");
            asm volatile("s_waitcnt vmcnt(0)" ::: "memory");
            const unsigned og = xb_add(&bar[XB_TOP], 1u);
            const unsigned tg = og / nx;
            if (og + 1u == (tg + 1u) * nx) xb_add(&bar[XB_TOPGEN], 1u);
            else XB_SPIN(xb_ld(&bar[XB_TOPGEN]) == tg, bar);
            __builtin_amdgcn_fence(__ATOMIC_ACQUIRE, "agent");
            xb_add(&bar[XB_XGEN(b.x)], 1u);
            asm volatile("s_waitcnt vmcnt(0)" ::: "memory");
        } else {
            XB_SPIN(xb_ld(&bar[XB_XGEN(b.x)]) == gen, bar);
            __builtin_amdgcn_fence(__ATOMIC_ACQUIRE, "agent");
            asm volatile("s_waitcnt vmcnt(0)" ::: "memory");
        }
    }
    __syncthreads();
}

constexpr int NWAVES = 8, NTHREADS = NWAVES * 64;
constexpr int RING_BYTES = 131072, MISC_OFF = 147456, LDS_BYTES = 155648;

__device__ __forceinline__ void p0_mod_unit(const float* c, const float* ada_w, float* modp, int unit, int lane) {
    const int rb = unit >> 6, cc = unit & 63;
    if (lane < 48) {
        f32x4 a0 = {0.f, 0.f, 0.f, 0.f}, a1 = {0.f, 0.f, 0.f, 0.f};
        const float* wp = ada_w + (size_t)(rb * 64) * NMOD + cc * 192 + lane * 4;
#pragma unroll 8
        for (int r = 0; r < 64; ++r) {
            const float c0 = c[rb * 64 + r], c1 = c[D + rb * 64 + r];
            const float s0 = siluf_(c0), s1 = siluf_(c1);
            const f32x4 w = __builtin_nontemporal_load((const f32x4*)(wp + (size_t)r * NMOD));
            a0 += s0 * w; a1 += s1 * w;
        }
        *(f32x4*)(modp + (size_t)(rb * 2 + 0) * NMOD + cc * 192 + lane * 4) = a0;
        *(f32x4*)(modp + (size_t)(rb * 2 + 1) * NMOD + cc * 192 + lane * 4) = a1;
    }
}
__device__ __forceinline__ void p0_amax_item(const float* Wsrc  , int ldw, unsigned* colmax  , int lane) {
    const float* src = Wsrc + (size_t)(lane >> 5) * ldw + (lane & 31);
    float wv[32];
#pragma unroll
    for (int i = 0; i < 32; ++i) wv[i] = src[(size_t)(2 * i) * ldw];
    float am = 0.f;
#pragma unroll
    for (int i = 0; i < 32; ++i) am = fmaxf(am, fabsf(wv[i]));
    am = fmaxf(am, __shfl_xor(am, 32, 64));
    if (lane < 32) __hip_atomic_fetch_max(colmax + lane, __float_as_uint(am), __ATOMIC_RELAXED, __HIP_MEMORY_SCOPE_AGENT);
}
constexpr int ADA_EARLY = 22;
__device__ __forceinline__ void p2_ada_late(const Params& p, int blk, int wave, int lane) {
    const int idx = wave * 256 + blk;
    if (idx < 32 * (64 - ADA_EARLY)) p0_mod_unit(p.in[I_C], p.in[I_ADAW], (float*)(p.ws + WS_MODP), (idx / (64 - ADA_EARLY)) * 64 + ADA_EARLY + idx % (64 - ADA_EARLY), lane);
}
__device__ __forceinline__ void p0_transpose_item(const float* Wsrc  , int ldw, unsigned char* dst  , int ldd, LAS float* scr, int lane) {
#pragma unroll 8
    for (int i = 0; i < 32; ++i) { const int kk = 2 * i + (lane >> 5); scr[kk * 33 + (lane & 31)] = __builtin_nontemporal_load(Wsrc + (size_t)kk * ldw + (lane & 31)); }
    asm volatile("s_waitcnt lgkmcnt(0)" ::: "memory");
    const int cch = lane & 7;
#pragma unroll
    for (int j = 0; j < 4; ++j) { const int n = (lane >> 3) + 8 * j; const LAS float* s = scr + (8 * cch) * 33 + n;
        u32x2 o; o.x = pk4_f8(s[0 * 33] * F8_SW, s[1 * 33] * F8_SW, s[2 * 33] * F8_SW, s[3 * 33] * F8_SW); o.y = pk4_f8(s[4 * 33] * F8_SW, s[5 * 33] * F8_SW, s[6 * 33] * F8_SW, s[7 * 33] * F8_SW);
        *(u32x2*)(dst + (size_t)n * ldd + 8 * cch) = o; }
    asm volatile("s_waitcnt lgkmcnt(0)" ::: "memory");
}
__device__ __forceinline__ void p1_quant_item(const float* Wsrc, int ldw, unsigned char* dst  , int ldd, const unsigned* colmax  , float* cs  , LAS float* scr, int lane) {
    const float amax = __uint_as_float(__hip_atomic_load(colmax + (lane & 31), __ATOMIC_RELAXED, __HIP_MEMORY_SCOPE_AGENT)), inv = amax > 0.f ? 127.f / amax : 0.f;
    if (cs && lane < 32) cs[lane] = amax * (1.f / 127.f);
#pragma unroll 8
    for (int i = 0; i < 32; ++i) { const int kk = 2 * i + (lane >> 5); scr[kk * 33 + (lane & 31)] = __builtin_nontemporal_load(Wsrc + (size_t)kk * ldw + (lane & 31)) * inv + I8MAGIC; }
    asm volatile("s_waitcnt lgkmcnt(0)" ::: "memory");
    const int c4 = lane & 3;
#pragma unroll
    for (int j = 0; j < 2; ++j) { const int n = (lane >> 2) + 16 * j; const LAS unsigned* s = (const LAS unsigned*)scr + (16 * c4) * 33 + n;
        u32x4 o; o.x = pack4_i8(s[0 * 33], s[1 * 33], s[2 * 33], s[3 * 33]); o.y = pack4_i8(s[4 * 33], s[5 * 33], s[6 * 33], s[7 * 33]);
        o.z = pack4_i8(s[8 * 33], s[9 * 33], s[10 * 33], s[11 * 33]); o.w = pack4_i8(s[12 * 33], s[13 * 33], s[14 * 33], s[15 * 33]);
        *(u32x4*)(dst + (size_t)n * ldd + 16 * c4) = o; }
    asm volatile("s_waitcnt lgkmcnt(0)" ::: "memory");
}
struct XpItem { const float* src; unsigned char* dst; int ldw, ldd, f8; };
__device__ __forceinline__ void xp_issue(const XpItem& x, int lane, float (&xr)[32]) {
    const float* q = x.src + (size_t)(lane >> 5) * x.ldw + (lane & 31); const size_t step = (size_t)2 * x.ldw;
#pragma unroll
    for (int i = 0; i < 32; ++i) { xr[i] = __builtin_nontemporal_load(q); q += step; asm volatile("" : "+v"(q)); }
}
__device__ __forceinline__ void xp_finish(const XpItem& x, int lane, const float (&xr)[32], LAS float* scr) {
#pragma unroll
    for (int i = 0; i < 32; ++i) { const int kk = 2 * i + (lane >> 5); scr[kk * 33 + (lane & 31)] = xr[i]; }
    asm volatile("s_waitcnt lgkmcnt(0)" ::: "memory");
    const int cch = lane & 7;
#pragma unroll
    for (int j = 0; j < 4; ++j) { const int n = (lane >> 3) + 8 * j; const LAS float* s = scr + (8 * cch) * 33 + n;
        u32x2 o; o.x = pk4_f8(s[0 * 33] * F8_SW, s[1 * 33] * F8_SW, s[2 * 33] * F8_SW, s[3 * 33] * F8_SW); o.y = pk4_f8(s[4 * 33] * F8_SW, s[5 * 33] * F8_SW, s[6 * 33] * F8_SW, s[7 * 33] * F8_SW);
        *(u32x2*)(x.dst + (size_t)n * x.ldd + 8 * cch) = o; }
    asm volatile("s_waitcnt lgkmcnt(0)" ::: "memory");
}
constexpr int NMOE_ITEMS = 2 * NEXP * 512;
__device__ __forceinline__ void moe_xp_item(const Params& p, int r, XpItem& x) {
    constexpr int I_E = 512; unsigned char* ws = p.ws;
    if (r < 2 * NEXP * I_E) {
        const int which = r / (NEXP * I_E); r -= which * NEXP * I_E; const int e = r / I_E, q = r % I_E, kb = q / 16, nb = q % 16, f0 = 32 * nb;
        x.src = p.in[which ? I_W3 : I_W1] + (size_t)e * D * FE + (size_t)(64 * kb) * FE + f0; x.ldw = FE;
        x.dst = ws + WS_W13_T + ((size_t)e * 1024 + 256 * (f0 >> 7) + 128 * which + (f0 & 127)) * D + 64 * kb; x.ldd = D; x.f8 = 1;
    } else { r -= 2 * NEXP * I_E; const int e = r / I_E, q = r % I_E, kb = q / 64, nb = q % 64;
        x.src = p.in[I_W2] + (size_t)e * FE * D + (size_t)(64 * kb) * D + 32 * nb; x.ldw = D;
        x.dst = ws + WS_W2_T + ((size_t)e * D + 32 * nb) * FE + 64 * kb; x.ldd = FE; x.f8 = 1; }
}
__device__ __forceinline__ void p0_prologue(const Params& p, LAS unsigned char* lds, int gw, int ngw, int wave, int lane) {
    unsigned char* ws = p.ws;
    LAS float* scr = (LAS float*)(lds + wave * 16384);
    const int blk = gw >> 3, nada = blk < (32 * ADA_EARLY - 512) ? 3 : 2;
    if (wave < nada) { const int idx = wave * 256 + blk; p0_mod_unit(p.in[I_C], p.in[I_ADAW], (float*)(ws + WS_MODP), (idx / ADA_EARLY) * 64 + idx % ADA_EARLY, lane); }
    if (gw < 8 * 128) { const int t = gw & 127; const float* wsrc = p.in[I_WS] + (size_t)gw * 128 + 2 * lane; float w0 = wsrc[0], w1 = wsrc[1];
        if (t < 64 && lane >= 32) { w0 = 0.f; w1 = 0.f; }
        ((unsigned*)(ws + WS_WSB))[gw * 64 + lane] = pk2(w0, w1); }
    for (int it = gw; it < 48 * 32; it += ngw) {
        const int col = it >> 5, k = 64 * (it & 31) + lane;
        float w = 0.f;
        if (col < 4) w = p.in[I_WGRP][k * 4 + col];
        else if (col < 36) w = p.in[I_WEXP][(size_t)((col - 4) >> 3) * D * 8 + (size_t)k * 8 + ((col - 4) & 7)];
        const unsigned hi = f2bf(w), lo = f2bf(w - __uint_as_float(hi << 16));
        bf16_t* wrt = (bf16_t*)(ws + WS_WRT);
        wrt[col * D + k] = (bf16_t)hi; wrt[48 * D + col * D + k] = (bf16_t)lo;
    }
    constexpr int I_IN = 32 * 288, I_A = 16 * 64, I_O = 32 * 64, I_E = 512;
    constexpr int NITEMS = I_IN;
    if (wave >= nada) for (int j = wave - nada; j < NITEMS / 256; j += 8 - nada) {
        int r = blk + 256 * j;
        if (r < I_IN) { const int kb = r / 288, nb = r % 288; int drow = 32 * nb;
            if (drow >= 5120) { const int c = drow - 5120, which = c >> 11, cc = c & 2047; drow = 5120 + 256 * (cc >> 7) + 128 * which + (cc & 127); }
            p0_amax_item(p.in[I_WIN] + (size_t)(64 * kb) * NCOLS + 32 * nb, NCOLS, (unsigned*)(ws + WS_COLMAX) + drow, lane); }
    }
    if (wave >= nada) for (int j = wave - nada; j < I_O / 256; j += 8 - nada) { const int it = blk + 256 * j, kb = it >> 6, nb = it & 63;
        p0_amax_item(p.in[I_WOUT] + (size_t)(64 * kb) * D + 32 * nb, D, (unsigned*)(ws + WS_COLMAX_O) + 32 * nb, lane); }
}
__device__ __forceinline__ void p1_norm1(const Params& p, LAS unsigned char* lds, int blk, int tid, int wave, int lane) {
    unsigned char* ws = p.ws; const float* modp = (const float*)(ws + WS_MODP); float* mod = (float*)(ws + WS_MOD);
    LAS float* A1 = (LAS float*)lds; LAS float* S1 = A1 + D;
    const int bb = blk >> 7;
    for (int k = tid; k < D; k += NTHREADS) {
        float sh = p.in[I_ADAB][k], sc = p.in[I_ADAB][D + k];
        for (int q = 0; q < 32; ++q) { sh += modp[(size_t)(q * 2 + bb) * NMOD + k]; sc += modp[(size_t)(q * 2 + bb) * NMOD + D + k]; }
        A1[k] = p.in[I_N1G][k] * (1.f + sc); S1[k] = sh;
    }
    __syncthreads();
    LAS float* scr = (LAS float*)(lds + 16384 + wave * 16384);
    for (int it = blk * NWAVES + wave; it < 32 * 288; it += 256 * NWAVES) {
        const int kb = it / 288, nb = it % 288; int drow = 32 * nb;
        if (drow >= 5120) { const int c = drow - 5120, which = c >> 11, cc = c & 2047; drow = 5120 + 256 * (cc >> 7) + 128 * which + (cc & 127); }
        p1_quant_item(p.in[I_WIN] + (size_t)(64 * kb) * NCOLS + 32 * nb, NCOLS, ws + WS_WIN_T + (size_t)drow * D + 64 * kb, D, (const unsigned*)(ws + WS_COLMAX) + drow,
                      kb == 0 ? (float*)(ws + WS_CS) + drow : (float*)nullptr, scr, lane);
    }
    for (int it = blk * NWAVES + wave; it < 32 * 64; it += 256 * NWAVES) { const int kb = it >> 6, nb = it & 63;
        p1_quant_item(p.in[I_WOUT] + (size_t)(64 * kb) * D + 32 * nb, D, ws + WS_WOUT_T + (size_t)(32 * nb) * D + 64 * kb, D, (const unsigned*)(ws + WS_COLMAX_O) + 32 * nb,
                      kb == 0 ? (float*)(ws + WS_CSO) + 32 * nb : (float*)nullptr, scr, lane);
    }
    const float* x = p.in[I_X]; unsigned char* H = ws + WS_H; float* hsc = (float*)(ws + WS_HSC);
    for (int i = 0; i < 8; i += 2) {
        const int row = blk * 64 + wave * 8 + i;
        const f32x4* xr = (const f32x4*)(x + (size_t)row * D) + lane;
        f32x4 v[2][8]; float ss[2] = {0.f, 0.f};
#pragma unroll
        for (int r = 0; r < 2; ++r)
#pragma unroll
            for (int j = 0; j < 8; ++j) v[r][j] = __builtin_nontemporal_load(xr + (size_t)r * (D / 4) + 64 * j);
#pragma unroll
        for (int r = 0; r < 2; ++r)
#pragma unroll
            for (int j = 0; j < 8; ++j) ss[r] += (v[r][j].x * v[r][j].x + v[r][j].y * v[r][j].y) + (v[r][j].z * v[r][j].z + v[r][j].w * v[r][j].w);
#pragma unroll
        for (int r = 0; r < 2; ++r) {
            const float rstd = rsqrtf(wave_sum(ss[r]) * (1.f / D) + EPS);
            unsigned* o = (unsigned*)(H + (size_t)(row + r) * D) + lane;
            float am = 0.f;
#pragma unroll
            for (int j = 0; j < 8; ++j) { const f32x4 a = *(const LAS f32x4*)(A1 + 256 * j + 4 * lane), s = *(const LAS f32x4*)(S1 + 256 * j + 4 * lane);
                v[r][j] = v[r][j] * rstd * a + s; am = fmaxf(fmaxf(am, fmaxf(fabsf(v[r][j].x), fabsf(v[r][j].y))), fmaxf(fabsf(v[r][j].z), fabsf(v[r][j].w))); }
            am = wave_max(am); const float sq = am > 0.f ? 127.f / am : 0.f;
            if (lane == 0) hsc[row + r] = am * (1.f / 127.f);
#pragma unroll
            for (int j = 0; j < 8; ++j) { const f32x4 h = v[r][j] * sq + I8MAGIC;
                o[64 * j] = pack4_i8(__float_as_uint(h.x), __float_as_uint(h.y), __float_as_uint(h.z), __float_as_uint(h.w)); }
        }
    }
    __syncthreads();
}
typedef short bf16x8_t __attribute__((ext_vector_type(8)));
typedef short bf16x4_t __attribute__((ext_vector_type(4)));
__device__ __forceinline__ void p3_gmlp(const Params& p, LAS unsigned char* lds, int blk, int tid, int wave, int lane, size_t out_off, int gw) {
    unsigned char* ws = p.ws; bf16_t* U = (bf16_t*)(ws + WS_U); const bf16_t* V = (const bf16_t*)(ws + WS_V);
    const int tb0 = (blk >> 1) * 128, gh = blk & 1, l15 = lane & 15, lg = lane >> 4;
    LAS float* st = (LAS float*)lds;
    LAS unsigned char* XT = lds + 1024;
    LAS unsigned char* WL = lds + 1024 + 34816;
    for (int i0 = 0; i0 < 16; i0 += 8) {
        u32x4 raw[8][2];
#pragma unroll
        for (int i = 0; i < 8; ++i) { const u32x4* vp = (const u32x4*)(V + (size_t)(tb0 + 16 * wave + i0 + i) * 1024) + lane * 2; raw[i][0] = vp[0]; raw[i][1] = vp[1]; }
        float s[8], q[8];
#pragma unroll
        for (int i = 0; i < 8; ++i) { f32x4 x[4]; pg8::unpack8(raw[i][0], x[0], x[1]); pg8::unpack8(raw[i][1], x[2], x[3]);
            s[i] = ((x[0].x + x[0].y) + (x[0].z + x[0].w)) + ((x[1].x + x[1].y) + (x[1].z + x[1].w)) + ((x[2].x + x[2].y) + (x[2].z + x[2].w)) + ((x[3].x + x[3].y) + (x[3].z + x[3].w)); }
#pragma unroll
        for (int o = 32; o > 0; o >>= 1)
#pragma unroll
            for (int i = 0; i < 8; ++i) s[i] += __shfl_xor(s[i], o, 64);
#pragma unroll
        for (int i = 0; i < 8; ++i) { f32x4 x[4]; pg8::unpack8(raw[i][0], x[0], x[1]); pg8::unpack8(raw[i][1], x[2], x[3]); const float mean = s[i] * (1.f / 1024.f); s[i] = mean; q[i] = 0.f;
#pragma unroll
            for (int j = 0; j < 4; ++j) { const f32x4 d = x[j] - mean; q[i] += (d.x * d.x + d.y * d.y) + (d.z * d.z + d.w * d.w); } }
#pragma unroll
        for (int o = 32; o > 0; o >>= 1)
#pragma unroll
            for (int i = 0; i < 8; ++i) q[i] += __shfl_xor(q[i], o, 64);
#pragma unroll
        for (int i = 0; i < 8; ++i) if (lane == 0) { st[2 * (16 * wave + i0 + i)] = s[i]; st[2 * (16 * wave + i0 + i) + 1] = rsqrtf(q[i] * (1.f / 1024.f) + EPS); }
    }
    __syncthreads();
    const float* lng = p.in[I_LNG]; const float* lnb = p.in[I_LNB]; const float* w_s = p.in[I_WS]; const float* b_s = p.in[I_BS];
    LAS float* scr = (LAS float*)(lds + 77824 + wave * 8448);
    int xk = 0; bool xpend = false; XpItem xi; xi.src = nullptr; xi.dst = nullptr; xi.ldw = 0; xi.ldd = 0; xi.f8 = 1; float xr[32];
#pragma unroll
    for (int q = 0; q < 32; ++q) xr[q] = 0.f;
    for (int gi = 0; gi < 4; ++gi) {
        const int g = gh * 4 + gi;
#pragma unroll
        for (int i = 0; i < 4; ++i) {
            const int q = tid + 512 * i, s = q & 127, cch = q >> 7;
            const u32x4 raw = *(const u32x4*)(V + (size_t)(tb0 + s) * 1024 + 128 * g + 8 * cch);
            f32x4 x0, x1; pg8::unpack8(raw, x0, x1);
            const float mean = st[2 * s], rstd = st[2 * s + 1];
            const f32x4 g0 = *(const f32x4*)(lng + 128 * g + 8 * cch), g1 = *(const f32x4*)(lng + 128 * g + 8 * cch + 4), b0 = *(const f32x4*)(lnb + 128 * g + 8 * cch), b1 = *(const f32x4*)(lnb + 128 * g + 8 * cch + 4);
            x0 = (x0 - mean) * rstd * g0 + b0; x1 = (x1 - mean) * rstd * g1 + b1;
            LAS bf16_t* xp = (LAS bf16_t*)(XT + (8 * cch) * 272 + 2 * s);
            xp[0 * 136] = (bf16_t)f2bf(x0.x); xp[1 * 136] = (bf16_t)f2bf(x0.y); xp[2 * 136] = (bf16_t)f2bf(x0.z); xp[3 * 136] = (bf16_t)f2bf(x0.w);
            xp[4 * 136] = (bf16_t)f2bf(x1.x); xp[5 * 136] = (bf16_t)f2bf(x1.y); xp[6 * 136] = (bf16_t)f2bf(x1.z); xp[7 * 136] = (bf16_t)f2bf(x1.w);
        }
#pragma unroll
        for (int i = 0; i < 4; ++i) {
            const int q = tid + 512 * i, t = q >> 4, c16 = q & 15;
            *(LAS u32x4*)(WL + t * 272 + 16 * c16) = *(const u32x4*)(ws + WS_WSB + (size_t)(g * 128 + t) * 256 + 16 * c16);
        }
        __syncthreads();
        if (xpend) { xp_finish(xi, lane, xr, scr); xpend = false; }
        if (xk < GMLP_ITEMS) { moe_xp_item(p, gw * GMLP_ITEMS + xk, xi); xp_issue(xi, lane, xr); ++xk; xpend = true; }
        f32x4 acc[8];
#pragma unroll
        for (int cb = 0; cb < 8; ++cb) acc[cb] = (f32x4){0.f, 0.f, 0.f, 0.f};
        const int nks = (wave < 4) ? 2 : 4;
        for (int ks = 0; ks < nks; ++ks) {
            const bf16x8_t bfrag = *(const LAS bf16x8_t*)(WL + (16 * wave + l15) * 272 + (32 * ks + 8 * lg) * 2);
#pragma unroll
            for (int cb = 0; cb < 8; ++cb) { const bf16x8_t afrag = *(const LAS bf16x8_t*)(XT + (16 * cb + l15) * 272 + (32 * ks + 8 * lg) * 2);
                acc[cb] = __builtin_amdgcn_mfma_f32_16x16x32_bf16(afrag, bfrag, acc[cb], 0, 0, 0); }
        }
        const int t = 16 * wave + l15; const float bias = b_s[g * 128 + t];
        bf16_t* up = U + (size_t)(tb0 + t) * 1024 + 128 * g + 4 * lg; unsigned char* ya = ws + WS_YA8 + (size_t)(tb0 + t) * 1024 + 128 * g + 4 * lg;
#pragma unroll
        for (int cb = 0; cb < 8; ++cb) { const u32x2 uu = *(const u32x2*)(up + 16 * cb);
            const float u0 = __uint_as_float(uu.x << 16), u1 = __uint_as_float(uu.x & 0xffff0000u), u2 = __uint_as_float(uu.y << 16), u3 = __uint_as_float(uu.y & 0xffff0000u);
            *(unsigned*)(ya + 16 * cb) = pk4_f8(F8_SY * u0 * (acc[cb].x + bias), F8_SY * u1 * (acc[cb].y + bias), F8_SY * u2 * (acc[cb].z + bias), F8_SY * u3 * (acc[cb].w + bias)); }
        if (xpend) { xp_finish(xi, lane, xr, scr); xpend = false; }
        if (xk < GMLP_ITEMS) { moe_xp_item(p, gw * GMLP_ITEMS + xk, xi); xp_issue(xi, lane, xr); ++xk; xpend = true; }
        __syncthreads();
    }
    if (xpend) xp_finish(xi, lane, xr, scr);
    for (; xk < GMLP_ITEMS; ++xk) { moe_xp_item(p, gw * GMLP_ITEMS + xk, xi); xp_issue(xi, lane, xr); xp_finish(xi, lane, xr, scr); }
}
constexpr int XPG_DONE = 2048 * GMLP_ITEMS;
constexpr int XP3_W13 = 0;
constexpr int NW13_ITEMS = XP3_W13 + 2 * 2048;
__device__ __forceinline__ void lds_dma16(const void* gsrc, unsigned lds_dst) {
    unsigned keep;
    asm volatile("s_mov_b32 %0, m0\n\ts_mov_b32 m0, %2\n\ts_nop 0\n\tglobal_load_lds_dwordx4 %1, off\n\ts_mov_b32 m0, %0" : "=&s"(keep) : "v"(gsrc), "s"(lds_dst) : "memory");
}
__device__ __forceinline__ void p3_attn(const Params& p, LAS unsigned char* lds, int blk, int tid, int wave, int lane, size_t out_off, int gw, int ngw) {
    unsigned char* ws = p.ws; bf16_t* Q = (bf16_t*)(ws + WS_Q); const bf16_t* Kb = (const bf16_t*)(ws + WS_K); const bf16_t* VT = (const bf16_t*)(ws + WS_VT); const float* rel = p.in[I_REL];
    constexpr int TILE = 8192, STEPB = 4 * TILE;
    constexpr int QS_OFF = 2 * STEPB;
    constexpr int XS_OFF = QS_OFF + 16384;
    static_assert(XS_OFF + 8 * 8192 <= MISC_OFF, "attention LDS map");
    LAS float* bt2 = (LAS float*)(lds + MISC_OFF + 2048);
    const int l15 = lane & 15, lg = lane >> 4;
    const unsigned onew = ((l15 & 3) == 0) ? 0x3f803f80u : 0u;
    const bf16x8_t ones = __builtin_bit_cast(bf16x8_t, (u32x4){onew, onew, onew, onew});
    const int bh = (blk * 8) >> 6, cpb = (blk * 8) & 63, b = bh >> 4, h = bh & 15;
    __syncthreads();
    if (tid < 384) { int idx = 575 - tid; idx = idx > 512 ? 512 : idx; bt2[tid] = rel[h * 513 + idx] * LOG2E; }
    const float bfar = rel[h * 513 + 512] * LOG2E;
    const f32x4 farv = {bfar, bfar, bfar, bfar}, negv = {-1e30f, -1e30f, -1e30f, -1e30f};
    const int srow = tid >> 3, spc = (tid & 7) ^ (((tid >> 4) & 7) ^ (((tid >> 7) & 1) << 1));
    const bf16_t* gk = Kb + (size_t)(b * SEQ + srow) * 1024 + h * 64 + 8 * spc;
    const bf16_t* gv = VT + ((size_t)((b * 16 + h) * 64 + srow)) * 8192 + 8 * spc;
    const bf16_t* gq = Q + (size_t)(b * SEQ + cpb * 128 + 16 * wave + (lane >> 3)) * 1024 + h * 64;
    const int qpc0 = (lane & 7) ^ ((lane >> 4) & 7), qpc1 = (lane & 7) ^ ((((lane >> 3) + 8) >> 1) & 7);
    const unsigned wbase = (unsigned)wave * 1024u;
    int T = 0;
    for (int i = 0; i < 8; ++i) { const int j0 = 4 - (cpb + i); T += 5 - (j0 > 0 ? j0 : 0); }
    int li = 0, ljp = (4 - cpb) > 0 ? (4 - cpb) : 0, lbuf = 0;
#define AT_DMA() do { const int _kc = 2 * (cpb + li) - 8 + 2 * ljp; const unsigned _d = (unsigned)(lbuf * STEPB) + wbase; \
        lds_dma16(gk + (size_t)_kc * 64 * 1024, _d); lds_dma16(gk + (size_t)(_kc + 1) * 64 * 1024, _d + TILE); lds_dma16(gv + _kc * 64, _d + 2 * TILE); lds_dma16(gv + (_kc + 1) * 64, _d + 3 * TILE); \
        lbuf ^= 1; if (++ljp == 5) { ++li; const int _j0 = 4 - (cpb + li); ljp = _j0 > 0 ? _j0 : 0; } } while (0)
#define AT_QDMA(unit) do { const unsigned _d = (unsigned)QS_OFF + (unsigned)wave * 2048u; const bf16_t* _g = gq + (size_t)(unit) * 128 * 1024; \
        lds_dma16(_g + 8 * qpc0, _d); lds_dma16(_g + (size_t)8 * 1024 + 8 * qpc1, _d + 1024); } while (0)
    AT_QDMA(0);
    AT_DMA();
    asm volatile("s_waitcnt vmcnt(0)" ::: "memory");
    __builtin_amdgcn_s_barrier();
    asm volatile("" ::: "memory");
    const int xv0 = (l15 >> 1) & 7, rl = 8 * (l15 >> 2) + (l15 & 3);
    const int xk0 = ((4 * ((l15 >> 2) & 1)) + ((l15 >> 1) & 1)) ^ (2 * ((l15 >> 3) & 1));
    int kofs[2][2], vofs[2][2];
#pragma unroll
    for (int e = 0; e < 2; ++e)
#pragma unroll
        for (int ks = 0; ks < 2; ++ks) { kofs[e][ks] = rl * 128 + (((lg + 4 * ks) ^ (xk0 ^ (2 * e))) << 4); vofs[e][ks] = l15 * 128 + (((lg + 4 * ks) ^ (xv0 ^ (2 * e))) << 4); }
    const int ko0 = vofs[0][0], ko1 = vofs[0][1];
    int ci = 0, cjp = (4 - cpb) > 0 ? (4 - cpb) : 0, cbuf = 0;
    bf16_t* qp = Q + (size_t)(b * SEQ + cpb * 128 + 16 * wave + l15) * 1024 + h * 64;
    bf16x8_t qf0, qf1;
    f32x4 o[4], osum = {0.f, 0.f, 0.f, 0.f};
#pragma unroll
    for (int db = 0; db < 4; ++db) o[db] = (f32x4){0.f, 0.f, 0.f, 0.f};
    float m = -1e30f;
    const int iq = 16 * (wave & 3) + l15;
    bool ufirst = true;
    int xit = gw; bool xp0 = false, xp1 = false; XpItem x0, x1; x0.src = nullptr; x0.dst = nullptr; x0.ldw = 0; x0.ldd = 0; x0.f8 = 0; x1 = x0;
    auto xdecode = [&](int r, XpItem& x) {
        if (r < XP3_W13) { const int it64 = XPG_DONE + (r >> 1), hk = r & 1;
            const int which = it64 >> 14, rr = it64 & 16383, e = rr >> 9, q = rr & 511, kb = 2 * (q >> 4) + hk, nb = q & 15, f0 = 32 * nb;
            x.src = p.in[which ? I_W3 : I_W1] + (size_t)e * D * FE + (size_t)(32 * kb) * FE + f0; x.ldw = FE;
            x.dst = ws + WS_W13_T + ((size_t)e * 1024 + 256 * (f0 >> 7) + 128 * which + (f0 & 127)) * D + 32 * kb; x.ldd = D; x.f8 = 1; }
        else { const int r2 = r - XP3_W13;
            { const int which = r2 >> 11, q = r2 & 2047, kb = q >> 6, nb = q & 63;
                x.src = p.in[which ? I_WB : I_WA] + (size_t)(32 * kb) * D + 32 * nb; x.ldw = D;
                x.dst = ws + (which ? WS_WB_T : WS_WA_T) + (size_t)(32 * nb) * 1024 + 32 * kb; x.ldd = 1024; x.f8 = 1; } } };
    auto xissue = [&](const XpItem& x, int slot) {
        const unsigned d = (unsigned)XS_OFF + (unsigned)wave * 8192u + (unsigned)slot * 4096u; const float* g = x.src + (size_t)(lane >> 3) * x.ldw + 4 * (lane & 7);
#pragma unroll
        for (int i2 = 0; i2 < 4; ++i2) lds_dma16(g + (size_t)(8 * i2) * x.ldw, d + 1024u * i2); };
    auto xfinish = [&](const XpItem& x, int slot) {
        const LAS float* s = (const LAS float*)(lds + XS_OFF + wave * 8192 + slot * 4096) + (lane & 31);
#pragma unroll
        for (int r = 0; r < 2; ++r) { const int cch = 2 * r + (lane >> 5); const LAS float* sp = s + (8 * cch) * 32;
            if (x.f8) { u32x2 ov; ov.x = pk4_f8(sp[0 * 32] * F8_SW, sp[1 * 32] * F8_SW, sp[2 * 32] * F8_SW, sp[3 * 32] * F8_SW); ov.y = pk4_f8(sp[4 * 32] * F8_SW, sp[5 * 32] * F8_SW, sp[6 * 32] * F8_SW, sp[7 * 32] * F8_SW);
                *(u32x2*)(x.dst + (size_t)(lane & 31) * x.ldd + 8 * cch) = ov; }
            else { u32x4 ov; ov.x = pk2(sp[0 * 32], sp[1 * 32]); ov.y = pk2(sp[2 * 32], sp[3 * 32]); ov.z = pk2(sp[4 * 32], sp[5 * 32]); ov.w = pk2(sp[6 * 32], sp[7 * 32]);
                *(u32x4*)(x.dst + (size_t)(lane & 31) * x.ldd + 16 * cch) = ov; } }
        asm volatile("s_waitcnt lgkmcnt(0)" ::: "memory"); };
    for (int t = 0; t < T; ++t) {
        if (ufirst) {
            const LAS unsigned char* qs = lds + QS_OFF + wave * 2048; qf0 = *(const LAS bf16x8_t*)(qs + ko0); qf1 = *(const LAS bf16x8_t*)(qs + ko1);
            asm volatile("s_waitcnt lgkmcnt(0)" ::: "memory");
            if (ci + 1 < 8) AT_QDMA(ci + 1);
            ufirst = false; }
        const bool tile = li < 8;
        if (tile) AT_DMA();
        bool conv = false;
        if (t & 1) { if (xp1) { xfinish(x1, 1); xp1 = false; } if (xit < NW13_ITEMS) { xdecode(xit, x1); xissue(x1, 1); xp1 = true; xit += ngw; conv = true; } }
        else       { if (xp0) { xfinish(x0, 0); xp0 = false; } if (xit < NW13_ITEMS) { xdecode(xit, x0); xissue(x0, 0); xp0 = true; xit += ngw; conv = true; } }
        const int cp = cpb + ci, kc = 2 * cp - 8 + 2 * cjp, cw = 2 * cp + (wave >> 2);
        const LAS unsigned char* kb_ = lds + cbuf * STEPB; const LAS unsigned char* vb_ = kb_ + 2 * TILE;
        f32x4 s[8];
#pragma unroll
        for (int hf = 0; hf < 2; ++hf) {
            const int dc = cw - kc - hf;
            const LAS unsigned char* kt_ = kb_ + hf * TILE;
            if (dc >= 0 && dc <= 4) {
                const LAS float* bp = bt2 + (319 - dc * 64 - iq + 8 * lg);
#pragma unroll
                for (int kb = 0; kb < 4; ++kb) { const int ko = 32 * (kb >> 1) + 4 * (kb & 1); const f32x4 cin = {bp[ko], bp[ko + 1], bp[ko + 2], bp[ko + 3]};
                    const LAS unsigned char* kr = kt_ + (32 * (kb >> 1) + 4 * (kb & 1)) * 128;
                    const bf16x8_t a0 = *(const LAS bf16x8_t*)(kr + kofs[kb & 1][0]), a1 = *(const LAS bf16x8_t*)(kr + kofs[kb & 1][1]);
                    s[4 * hf + kb] = __builtin_amdgcn_mfma_f32_16x16x32_bf16(a0, qf0, cin, 0, 0, 0);
                    s[4 * hf + kb] = __builtin_amdgcn_mfma_f32_16x16x32_bf16(a1, qf1, s[4 * hf + kb], 0, 0, 0); }
            } else {
                const f32x4 cin = (dc >= 5 && dc <= 8) ? farv : negv;
#pragma unroll
                for (int kb = 0; kb < 4; ++kb) { const LAS unsigned char* kr = kt_ + (32 * (kb >> 1) + 4 * (kb & 1)) * 128;
                    const bf16x8_t a0 = *(const LAS bf16x8_t*)(kr + kofs[kb & 1][0]), a1 = *(const LAS bf16x8_t*)(kr + kofs[kb & 1][1]);
                    s[4 * hf + kb] = __builtin_amdgcn_mfma_f32_16x16x32_bf16(a0, qf0, cin, 0, 0, 0);
                    s[4 * hf + kb] = __builtin_amdgcn_mfma_f32_16x16x32_bf16(a1, qf1, s[4 * hf + kb], 0, 0, 0); }
            }
        }
        float lm = s[0].x;
#pragma unroll
        for (int kb = 0; kb < 8; ++kb) lm = fmaxf(lm, fmaxf(fmaxf(s[kb].x, s[kb].y), fmaxf(s[kb].z, s[kb].w)));
        if (__any(lm > m + 64.0f)) {
            float mx = fmaxf(lm, __shfl_xor(lm, 16)); mx = fmaxf(mx, __shfl_xor(mx, 32));
            const float mn = fmaxf(m, mx), alpha = __builtin_amdgcn_exp2f(m - mn); m = mn;
#pragma unroll
            for (int db = 0; db < 4; ++db) o[db] *= alpha;
            osum *= alpha;
        }
#pragma unroll
        for (int kb = 0; kb < 8; ++kb)
#pragma unroll
            for (int r = 0; r < 4; ++r) s[kb][r] = __builtin_amdgcn_exp2f(s[kb][r] - m);
#pragma unroll
        for (int hf = 0; hf < 2; ++hf) {
            const u32x4 pw0 = pg8::pack8(s[4 * hf + 0], s[4 * hf + 1]), pw1 = pg8::pack8(s[4 * hf + 2], s[4 * hf + 3]);
            const bf16x8_t pb0 = __builtin_bit_cast(bf16x8_t, pw0), pb1 = __builtin_bit_cast(bf16x8_t, pw1);
#pragma unroll
            for (int db = 0; db < 4; ++db) {
                const LAS unsigned char* vr = vb_ + hf * TILE + db * 2048;
                const bf16x8_t v0 = *(const LAS bf16x8_t*)(vr + vofs[db & 1][0]), v1 = *(const LAS bf16x8_t*)(vr + vofs[db & 1][1]);
                o[db] = __builtin_amdgcn_mfma_f32_16x16x32_bf16(v0, pb0, o[db], 0, 0, 0);
                o[db] = __builtin_amdgcn_mfma_f32_16x16x32_bf16(v1, pb1, o[db], 0, 0, 0);
            }
            osum = __builtin_amdgcn_mfma_f32_16x16x32_bf16(ones, pb0, osum, 0, 0, 0);
            osum = __builtin_amdgcn_mfma_f32_16x16x32_bf16(ones, pb1, osum, 0, 0, 0);
        }
        cbuf ^= 1;
        if (++cjp == 5) {
            const float inv = F8_SY / osum.x;
#pragma unroll
            for (int db = 0; db < 4; ++db) *(unsigned*)(ws + WS_YB8 + (size_t)(qp - Q) + 16 * db + 4 * lg) = pk4_f8(o[db].x * inv, o[db].y * inv, o[db].z * inv, o[db].w * inv);
            ++ci; const int j0 = 4 - (cpb + ci); cjp = j0 > 0 ? j0 : 0; ufirst = true;
            if (ci < 8) {
                qp += (size_t)128 * 1024;
#pragma unroll
                for (int db = 0; db < 4; ++db) o[db] = (f32x4){0.f, 0.f, 0.f, 0.f};
                osum = (f32x4){0.f, 0.f, 0.f, 0.f}; m = -1e30f;
            }
        }
        if (conv) asm volatile("s_waitcnt vmcnt(4) lgkmcnt(0)" ::: "memory"); else asm volatile("s_waitcnt vmcnt(0) lgkmcnt(0)" ::: "memory");
        __builtin_amdgcn_s_barrier();
        asm volatile("" ::: "memory");
        (void)tile;
    }
#undef AT_DMA
#undef AT_QDMA
    asm volatile("s_waitcnt vmcnt(0)" ::: "memory");
    if (xp0) xfinish(x0, 0);
    if (xp1) xfinish(x1, 1);
    for (; xit < NW13_ITEMS; xit += ngw) { xdecode(xit, x0); xissue(x0, 0); asm volatile("s_waitcnt vmcnt(0)" ::: "memory"); xfinish(x0, 0); }
}
__device__ __forceinline__ void p6_norm2_route(const Params& p, LAS unsigned char* lds, int blk, int tid, int wave, int lane, bool dry) {
    unsigned char* ws = p.ws; const float* mod = (const float*)(ws + WS_MOD);
    LAS float* A2 = (LAS float*)lds; LAS float* S2 = A2 + D; LAS float* rs = (LAS float*)(lds + 16384);
    LAS int* hist = (LAS int*)(lds + 16640); LAS int* base = hist + 32; LAS int* ent_e = base + 32; LAS int* ent_r = ent_e + 128; LAS float* ent_w = (LAS float*)(ent_r + 128);
    LAS float* part = (LAS float*)(lds + 32768);
    const int bb = blk >> 7, l15 = lane & 15, kg = lane >> 4;
    for (int k = tid; k < D; k += NTHREADS) { A2[k] = p.in[I_N2G][k] * (1.f + mod[bb * NMOD + 4 * D + k]); S2[k] = mod[bb * NMOD + 3 * D + k]; }
    if (tid < 32) hist[tid] = 0;
    const bf16_t* x1 = (const bf16_t*)(ws + WS_X1B); unsigned char* H2 = ws + WS_H;
    for (int i = 0; i < 8; i += 4) {
        const int r = wave * 8 + i; const u32x4* xr = (const u32x4*)(x1 + (size_t)(blk * 64 + r) * D) + lane; u32x4 raw[4][4];
#pragma unroll
        for (int q = 0; q < 4; ++q)
#pragma unroll
            for (int j = 0; j < 4; ++j) raw[q][j] = xr[(size_t)q * (D / 8) + 64 * j];
#pragma unroll
        for (int q = 0; q < 4; ++q) { float ss = 0.f;
#pragma unroll
            for (int j = 0; j < 4; ++j) { f32x4 v, w; pg8::unpack8(raw[q][j], v, w); ss += ((v.x * v.x + v.y * v.y) + (v.z * v.z + v.w * v.w)) + ((w.x * w.x + w.y * w.y) + (w.z * w.z + w.w * w.w)); }
            ss = wave_sum(ss);
            if (lane == 0) rs[r + q] = rsqrtf(ss * (1.f / D) + EPS); }
    }
    __syncthreads();
    {
        float rs4[4];
#pragma unroll
        for (int rb = 0; rb < 4; ++rb) rs4[rb] = rs[16 * rb + l15];
        f32x4 acc[4][3];
#pragma unroll
        for (int rb = 0; rb < 4; ++rb)
#pragma unroll
            for (int cb = 0; cb < 3; ++cb) acc[rb][cb] = (f32x4){0.f, 0.f, 0.f, 0.f};
        const bf16_t* wrt = (const bf16_t*)(ws + WS_WRT);
        for (int kh = 0; kh < 2; ++kh) {
            const int k0 = 256 * wave + 128 * kh + 32 * kg;
            u32x4 xr[4][4];
#pragma unroll
            for (int rb = 0; rb < 4; ++rb)
#pragma unroll
                for (int j = 0; j < 4; ++j) xr[rb][j] = *(const u32x4*)(x1 + (size_t)(blk * 64 + 16 * rb + l15) * D + k0 + 8 * j);
            unsigned f8w[4][8];
#pragma unroll
            for (int j = 0; j < 4; ++j) {
                const f32x4 a0 = *(const LAS f32x4*)(A2 + k0 + 8 * j), a1 = *(const LAS f32x4*)(A2 + k0 + 8 * j + 4), s0 = *(const LAS f32x4*)(S2 + k0 + 8 * j), s1 = *(const LAS f32x4*)(S2 + k0 + 8 * j + 4);
                bf16x8_t bh[3], bl[3];
#pragma unroll
                for (int cb = 0; cb < 3; ++cb) { bh[cb] = *(const bf16x8_t*)(wrt + (size_t)(16 * cb + l15) * D + k0 + 8 * j); bl[cb] = *(const bf16x8_t*)(wrt + (size_t)(48 + 16 * cb + l15) * D + k0 + 8 * j); }
#pragma unroll
                for (int rb = 0; rb < 4; ++rb) {
                    f32x4 x0, x1v; pg8::unpack8(xr[rb][j], x0, x1v);
                    const f32x4 h0 = x0 * rs4[rb] * a0 + s0, h1 = x1v * rs4[rb] * a1 + s1;
                    const u32x4 hw = pg8::pack8(h0, h1);
                    f8w[rb][2 * j] = pk4_f8(h0.x * F8_SH2, h0.y * F8_SH2, h0.z * F8_SH2, h0.w * F8_SH2); f8w[rb][2 * j + 1] = pk4_f8(h1.x * F8_SH2, h1.y * F8_SH2, h1.z * F8_SH2, h1.w * F8_SH2);
                    f32x4 c0, c1; pg8::unpack8(hw, c0, c1);
                    const u32x4 lw = pg8::pack8(h0 - c0, h1 - c1);
                    const bf16x8_t hi = __builtin_bit_cast(bf16x8_t, hw), lo = __builtin_bit_cast(bf16x8_t, lw);
#pragma unroll
                    for (int cb = 0; cb < 3; ++cb) {
                        acc[rb][cb] = __builtin_amdgcn_mfma_f32_16x16x32_bf16(hi, bh[cb], acc[rb][cb], 0, 0, 0);
                        acc[rb][cb] = __builtin_amdgcn_mfma_f32_16x16x32_bf16(lo, bh[cb], acc[rb][cb], 0, 0, 0);
                        acc[rb][cb] = __builtin_amdgcn_mfma_f32_16x16x32_bf16(hi, bl[cb], acc[rb][cb], 0, 0, 0);
                    }
                }
            }
#pragma unroll
            for (int rb = 0; rb < 4; ++rb) { unsigned char* hp = H2 + (size_t)(blk * 64 + 16 * rb + l15) * D + k0;
                *(u32x4*)hp = (u32x4){f8w[rb][0], f8w[rb][1], f8w[rb][2], f8w[rb][3]}; *(u32x4*)(hp + 16) = (u32x4){f8w[rb][4], f8w[rb][5], f8w[rb][6], f8w[rb][7]}; }
        }
#pragma unroll
        for (int rb = 0; rb < 4; ++rb)
#pragma unroll
            for (int cb = 0; cb < 3; ++cb)
#pragma unroll
                for (int rr = 0; rr < 4; ++rr) part[(wave * 64 + 16 * rb + 4 * kg + rr) * 48 + 16 * cb + l15] = acc[rb][cb][rr];
    }
    __syncthreads();
    for (int q = tid; q < 64 * 48; q += NTHREADS) { float s = 0.f;
#pragma unroll
        for (int w = 0; w < 8; ++w) s += part[w * 64 * 48 + q];
        part[q] = s; }
    __syncthreads();
    if (tid < 64) {
        const LAS float* lg = part + tid * 48;
        const float g0 = lg[0], g1 = lg[1], g2 = lg[2], g3 = lg[3];
        int g = 0; float gm = g0;
        if (g1 > gm) { gm = g1; g = 1; } if (g2 > gm) { gm = g2; g = 2; } if (g3 > gm) { gm = g3; g = 3; }
        const float gweight = 1.f / (expf(g0 - gm) + expf(g1 - gm) + expf(g2 - gm) + expf(g3 - gm));
        const LAS float* el = lg + 4 + 8 * g;
        int i1 = 0; float m1 = el[0];
        for (int q = 1; q < 8; ++q) { const float v = el[q]; if (v > m1) { m1 = v; i1 = q; } }
        int i2 = -1; float m2 = -3.0e38f;
        for (int q = 0; q < 8; ++q) { const float v = el[q]; if (q != i1 && v > m2) { m2 = v; i2 = q; } }
        const float t = expf(m2 - m1), p1 = 1.f / (1.f + t), p2 = t / (1.f + t);
        const int e1 = g * 8 + i1, e2 = g * 8 + i2;
        ent_e[2 * tid] = e1; ent_r[2 * tid] = __hip_atomic_fetch_add(hist + e1, 1, __ATOMIC_RELAXED, __HIP_MEMORY_SCOPE_WORKGROUP); ent_w[2 * tid] = gweight * p1;
        ent_e[2 * tid + 1] = e2; ent_r[2 * tid + 1] = __hip_atomic_fetch_add(hist + e2, 1, __ATOMIC_RELAXED, __HIP_MEMORY_SCOPE_WORKGROUP); ent_w[2 * tid + 1] = gweight * p2;
    }
    __syncthreads();
    unsigned* ctl = (unsigned*)(ws + WS_CTL);
    if (tid < 32) base[tid] = (hist[tid] && !dry) ? (int)__hip_atomic_fetch_add(ctl + CW_CNT + 64 * tid, (unsigned)hist[tid], __ATOMIC_RELAXED, __HIP_MEMORY_SCOPE_AGENT) : 0;
    __syncthreads();
    if (tid < 128 && !dry) {
        const int e = ent_e[tid], idx = base[e] + ent_r[tid], slot = (blk * 64 + (tid >> 1)) * 2 + (tid & 1);
        ((int*)(ws + WS_TOKLIST))[e * 16384 + idx] = slot; ((int*)(ws + WS_SLOTE))[slot] = e * 16384 + idx; ((float*)(ws + WS_ROWW))[e * 16384 + idx] = ent_w[tid];
    }
    __syncthreads();
}
__device__ __forceinline__ void p9_final(const Params& p, LAS unsigned char* lds, const MoeTab& T, int blk, int tid, int wave, int lane, bool build, size_t dry_off, unsigned char* dry_base) {
    unsigned char* ws = p.ws; const float* mod = (const float*)(ws + WS_MOD);
    if (build) build_tables((const unsigned*)(ws + WS_CTL), T, tid);
    const int bb = blk >> 7; const float* g2 = mod + bb * NMOD + 5 * D; const float* fg = p.in[I_FING];
    const unsigned char* YS = (const unsigned char*)(ws + WS_YS); const int* slote = (const int*)(ws + WS_SLOTE);
    for (int i = 0; i < 8; ++i) {
        const int row = blk * 64 + wave * 8 + i;
        const int se0 = slote[2 * row], se1 = slote[2 * row + 1];
        const size_t p0 = (size_t)T.tb[se0 >> 14] * 256 + (se0 & 16383), p1 = (size_t)T.tb[se1 >> 14] * 256 + (se1 & 16383);
        f32x4* xr = (f32x4*)(p.out + (size_t)row * D) + lane; const u32x2* x1r = (const u32x2*)((const bf16_t*)(ws + WS_X1B) + (size_t)row * D) + lane;
        const unsigned* y0 = (const unsigned*)(YS + p0 * D) + lane; const unsigned* y1 = (const unsigned*)(YS + p1 * D) + lane;
        f32x4 v[8]; float ss = 0.f;
#pragma unroll
        for (int j = 0; j < 8; ++j) { const u32x2 xw = __builtin_nontemporal_load(x1r + 64 * j); const f32x4 xv = {__uint_as_float(xw.x << 16), __uint_as_float(xw.x & 0xffff0000u), __uint_as_float(xw.y << 16), __uint_as_float(xw.y & 0xffff0000u)}; const unsigned a = __builtin_nontemporal_load(y0 + 64 * j), b = __builtin_nontemporal_load(y1 + 64 * j); const f32x4 gg = *(const f32x4*)(g2 + 256 * j + 4 * lane) * (1.0f / 64.0f);
            f32x4 ys; ys.x = __builtin_amdgcn_cvt_f32_fp8(a, 0) + __builtin_amdgcn_cvt_f32_fp8(b, 0); ys.y = __builtin_amdgcn_cvt_f32_fp8(a, 1) + __builtin_amdgcn_cvt_f32_fp8(b, 1);
            ys.z = __builtin_amdgcn_cvt_f32_fp8(a, 2) + __builtin_amdgcn_cvt_f32_fp8(b, 2); ys.w = __builtin_amdgcn_cvt_f32_fp8(a, 3) + __builtin_amdgcn_cvt_f32_fp8(b, 3);
            v[j] = xv + gg * ys; ss += (v[j].x * v[j].x + v[j].y * v[j].y) + (v[j].z * v[j].z + v[j].w * v[j].w); }
        const float rstd = rsqrtf(wave_sum(ss) * (1.f / D) + EPS);
        f32x4* xo = dry_base ? (f32x4*)(dry_base + dry_off + (size_t)row * D * 4) + lane : xr;
#pragma unroll
        for (int j = 0; j < 8; ++j) { const f32x4 f = *(const f32x4*)(fg + 256 * j + 4 * lane); xo[64 * j] = v[j] * rstd * f; }
    }
}

__device__ __forceinline__ void rowquant2048(const bf16_t* src, unsigned char* dst, float* step, int gw, int lane) {
    for (int i = 0; i < 8; i += 4) {
        const int row = gw * 8 + i; u32x4 raw[4][4];
#pragma unroll
        for (int r = 0; r < 4; ++r)
#pragma unroll
            for (int j = 0; j < 4; ++j) raw[r][j] = *((const u32x4*)(src + (size_t)(row + r) * D) + lane + 64 * j);
#pragma unroll
        for (int r = 0; r < 4; ++r) {
            f32x4 v[4][2]; float am = 0.f;
#pragma unroll
            for (int j = 0; j < 4; ++j) { pg8::unpack8(raw[r][j], v[j][0], v[j][1]);
#pragma unroll
                for (int h = 0; h < 2; ++h) am = fmaxf(fmaxf(am, fmaxf(fabsf(v[j][h].x), fabsf(v[j][h].y))), fmaxf(fabsf(v[j][h].z), fabsf(v[j][h].w))); }
            am = wave_max(am); const float sq = am > 0.f ? 127.f / am : 0.f;
            if (lane == 0) step[row + r] = am * (1.f / 127.f);
#pragma unroll
            for (int j = 0; j < 4; ++j) { const f32x4 a = v[j][0] * sq + I8MAGIC, b = v[j][1] * sq + I8MAGIC;
                u32x2 o; o.x = pack4_i8(__float_as_uint(a.x), __float_as_uint(a.y), __float_as_uint(a.z), __float_as_uint(a.w)); o.y = pack4_i8(__float_as_uint(b.x), __float_as_uint(b.y), __float_as_uint(b.z), __float_as_uint(b.w));
                *((u32x2*)(dst + (size_t)(row + r) * D) + lane + 64 * j) = o; }
        }
    }
}

__device__ __forceinline__ void xq_issue(const XpItem& x, int lane, f32x4 (&v)[8]) {
    const float* q = x.src + (size_t)(lane >> 3) * x.ldw + 4 * (lane & 7); const size_t step = (size_t)8 * x.ldw;
#pragma unroll
    for (int i = 0; i < 8; ++i) { v[i] = __builtin_nontemporal_load((const f32x4*)q); q += step; asm volatile("" : "+v"(q)); }
}
__device__ __forceinline__ void xq_finish(const XpItem& x, int lane, const f32x4 (&v)[8], LAS float* scr) {
#pragma unroll
    for (int i = 0; i < 8; ++i) { LAS float* d = scr + (8 * i + (lane >> 3)) * 33 + 4 * (lane & 7); d[0] = v[i].x; d[1] = v[i].y; d[2] = v[i].z; d[3] = v[i].w; }
    asm volatile("s_waitcnt lgkmcnt(0)" ::: "memory");
    const int cch = lane & 7;
#pragma unroll
    for (int j = 0; j < 4; ++j) { const int n = (lane >> 3) + 8 * j; const LAS float* s = scr + (8 * cch) * 33 + n;
        u32x2 o; o.x = pk4_f8(s[0 * 33] * F8_SW, s[1 * 33] * F8_SW, s[2 * 33] * F8_SW, s[3 * 33] * F8_SW); o.y = pk4_f8(s[4 * 33] * F8_SW, s[5 * 33] * F8_SW, s[6 * 33] * F8_SW, s[7 * 33] * F8_SW);
        *(u32x2*)(x.dst + (size_t)n * x.ldd + 8 * cch) = o; }
    asm volatile("s_waitcnt lgkmcnt(0)" ::: "memory");
}
__device__ __forceinline__ void xh_decode(const Params& p, int R, XpItem& x) {
    const int which = R >> 13, r = R & 8191, e = r >> 8, q = r & 255, kb = q >> 4, nb = q & 15, f0 = 32 * nb;
    x.src = p.in[which ? I_W3 : I_W1] + (size_t)e * D * FE + (size_t)(128 * kb) * FE + f0; x.ldw = FE;
    x.dst = p.ws + WS_W13_T + ((size_t)e * 1024 + 256 * (f0 >> 7) + 128 * which + (f0 & 127)) * D + 128 * kb; x.ldd = D; x.f8 = 1;
}
__device__ __forceinline__ void xh_issue(const XpItem& x, int lane, f32x4 (&v)[16]) {
    const float* q = x.src + (size_t)(lane >> 3) * x.ldw + 4 * (lane & 7); const size_t step = (size_t)8 * x.ldw;
#pragma unroll
    for (int i = 0; i < 16; ++i) { v[i] = __builtin_nontemporal_load((const f32x4*)q); q += step; asm volatile("" : "+v"(q)); }
}
__device__ __forceinline__ void xh_finish(const XpItem& x, int lane, const f32x4 (&v)[16], LAS float* scr) {
#pragma unroll
    for (int i = 0; i < 16; ++i) { LAS float* d = scr + (8 * i + (lane >> 3)) * 33 + 4 * (lane & 7); d[0] = v[i].x; d[1] = v[i].y; d[2] = v[i].z; d[3] = v[i].w; }
    asm volatile("s_waitcnt lgkmcnt(0)" ::: "memory");
    const int cch = lane & 15;
#pragma unroll
    for (int j = 0; j < 8; ++j) { const int n = (lane >> 4) + 4 * j; const LAS float* s = scr + (8 * cch) * 33 + n;
        u32x2 o; o.x = pk4_f8(s[0 * 33] * F8_SW, s[1 * 33] * F8_SW, s[2 * 33] * F8_SW, s[3 * 33] * F8_SW); o.y = pk4_f8(s[4 * 33] * F8_SW, s[5 * 33] * F8_SW, s[6 * 33] * F8_SW, s[7 * 33] * F8_SW);
        __builtin_nontemporal_store(o, (u32x2*)(x.dst + (size_t)n * x.ldd + 8 * cch)); }
    asm volatile("s_waitcnt lgkmcnt(0)" ::: "memory");
}
__device__ __forceinline__ void p2_w13_convert(const Params& p, LAS unsigned char* lds, int gw, int ngw, int wave, int lane) {
    LAS float* scr = (LAS float*)(lds + wave * 17408);
    XpItem x0, x1; x0.src = nullptr; x0.dst = nullptr; x0.ldw = 0; x0.ldd = 0; x0.f8 = 1; x1 = x0; f32x4 r0[16], r1[16];
    int it = gw; bool p0 = false, p1 = false;
#define P2C_ISSUE(X, R, P) do { if (it < NEXP * 512) { xh_decode(p, it, X); xh_issue(X, lane, R); P = true; it += ngw; } } while (0)
#define P2C_STEP(X, R, P) do { if (P) { xh_finish(X, lane, R, scr); P = false; P2C_ISSUE(X, R, P); } } while (0)
    P2C_ISSUE(x0, r0, p0); P2C_ISSUE(x1, r1, p1);
    while (p0 || p1) { P2C_STEP(x0, r0, p0); P2C_STEP(x1, r1, p1); }
#undef P2C_ISSUE
#undef P2C_STEP
}

__global__ void __launch_bounds__(NTHREADS, 2) mk_fwd(Params p) {
    extern __shared__ __attribute__((aligned(16))) unsigned char lds_raw[];
    LAS unsigned char* lds = (LAS unsigned char*)lds_raw;
    const int wave = __builtin_amdgcn_readfirstlane(threadIdx.x >> 6);
    const int G = gridDim.x, blk = blockIdx.x, gw = blk * NWAVES + wave, ngw = G * NWAVES;
#define FRESH_IDS const int lane = fresh_lane(), tid = wave * 64 + lane; (void)tid; (void)lane
    MoeTab T{(LAS int*)(lds + MISC_OFF + 64), (LAS int*)(lds + MISC_OFF + 256), (LAS int*)(lds + MISC_OFF + 512)};
    const int lo = p.ph_lo, hi = p.ph_hi;
    if (threadIdx.x < 4) ((LAS unsigned*)(lds + MISC_OFF))[threadIdx.x] = 0u;
    __syncthreads();
    XcdBarrier bar = xcd_barrier_post((unsigned*)(p.ws + WS_CTL) + CW_BAR, (volatile LAS unsigned*)(lds + MISC_OFF));
#define IN(k) (lo <= (k) && (k) < hi)
#define SEAM(k) do { if (IN(k) && IN((k) + 1)) xcd_barrier(bar); } while (0)
    if (IN(0)) { FRESH_IDS; p0_prologue(p, lds, gw, ngw, wave, lane); }
    SEAM(0);
    if (IN(1)) { FRESH_IDS; p1_norm1(p, lds, blk, tid, wave, lane); }
    SEAM(1);
    unsigned char* ws = p.ws;
    if (IN(2)) {
        pg8::SchedGrid S{(const char*)(ws + WS_H), (const char*)(ws + WS_WIN_T), D / 2, D / 2, 64, 36, G, blk};
        pg8::EpiProj E{(bf16_t*)(p.alt), (bf16_t*)(p.alt + (WS_V - WS_U)), (bf16_t*)(p.alt + (WS_Q - WS_U)), (bf16_t*)(p.alt + (WS_K - WS_U)), (bf16_t*)(p.alt + (WS_VT - WS_U)), (bf16_t*)p.altg,
                       (const float*)(ws + WS_HSC), (const float*)(ws + WS_CS)};
        const bool early = (blk >> 3) & 1;
        if (early) { FRESH_IDS; p2_ada_late(p, blk, wave, lane); p2_w13_convert(p, lds, gw, ngw, wave, lane); __syncthreads(); }
        pg8::gemm_phase(lds, D / 2, S, E, wave);
        if (!early) { FRESH_IDS; p2_ada_late(p, blk, wave, lane); p2_w13_convert(p, lds, gw, ngw, wave, lane); }
    }
    SEAM(2);
    if (IN(3)) { FRESH_IDS;
        if (blk < 96 && tid < 256) {
            const float* modp = (const float*)(ws + WS_MODP); const int j = blk * 256 + tid, b2 = j / NMOD, col = j % NMOD; float v = p.in[I_ADAB][col];
            for (int q = 0; q < 32; ++q) v += modp[(size_t)(q * 2 + b2) * NMOD + col];
            ((float*)(ws + WS_MOD))[j] = v; }
        p3_gmlp(p, lds, blk, tid, wave, lane, 0, gw); p3_attn(p, lds, blk, tid, wave, lane, 0, gw, ngw); }
    SEAM(3);
    if (IN(4)) {
        pg8::SchedBranch S{(const char*)(ws + WS_YA8), (const char*)(ws + WS_WA_T), (const char*)(ws + WS_YB8), (const char*)(ws + WS_WB_T), G, blk};
        pg8::EpiBranch E{(const unsigned short*)(ws + WS_G), (bf16_t*)(ws + WS_MIX), {}};
        pg8::gemm_phase(lds, 512, S, E, wave);
    }
    SEAM(4);
    if (IN(5)) {
        { FRESH_IDS; rowquant2048((const bf16_t*)(ws + WS_MIX), ws + WS_V, (float*)(ws + WS_SM), gw, lane); }
        xcd_barrier(bar);
        pg8::SchedGrid S{(const char*)(ws + WS_V), (const char*)(ws + WS_WOUT_T), D / 2, D / 2, 64, 8, G, blk};
        pg8::EpiOut E{p.in[I_X], (const float*)(ws + WS_MOD), (bf16_t*)(ws + WS_X1B), (const float*)(ws + WS_SM), (const float*)(ws + WS_CSO)};
        pg8::gemm_phase(lds, D / 2, S, E, wave);
    }
    SEAM(5);
    if (IN(6)) { FRESH_IDS; p6_norm2_route(p, lds, blk, tid, wave, lane, false); }
    SEAM(6);
    if (IN(7)) {
        { FRESH_IDS; build_tables((const unsigned*)(ws + WS_CTL), T, tid); }
        LAS int* ltok = (LAS int*)(lds + MISC_OFF + 4096);
        { FRESH_IDS; const int* toklist = (const int*)(ws + WS_TOKLIST);
          if (tid < 256) for (int i = 0; i < 3; ++i) { const int L = i * G + blk, rt = L >> 2; if (rt < T.tb[NEXP]) { const int e = T.rte[rt], r0 = (rt - T.tb[e]) * 256, nv = T.cn[e] - r0; ltok[i * 256 + tid] = toklist[e * 16384 + r0 + (tid < nv ? tid : 0)] >> 1; } }
          __syncthreads(); }
        pg8::SchedMoeUp S{(const char*)(ws + WS_H), (const char*)(ws + WS_W13_T), (const LAS int*)ltok, T, G, blk};
        pg8::EpiMoeUp E{ws + WS_ACT};
        pg8::gemm_phase(lds, D / 2, S, E, wave);
        {
            FRESH_IDS; const int U = 4 * T.tb[NEXP], fi = (U - 2 * G) > 0 ? (U - 2 * G) : 0;
            if (blk >= fi) { const int nidle = G - fi; LAS float* scr = (LAS float*)(lds + wave * 16384); XpItem xi;
                for (int it = (blk - fi) * NWAVES + wave; it < NEXP * 512; it += nidle * NWAVES) { moe_xp_item(p, 2 * NEXP * 512 + it, xi); p0_transpose_item(xi.src, xi.ldw, xi.dst, xi.ldd, scr, lane); } }
        }
    }
    SEAM(7);
    if (IN(8)) {
        if (lo == 8) { FRESH_IDS; build_tables((const unsigned*)(ws + WS_CTL), T, tid); }
        pg8::SchedMoeDown S{(const char*)(ws + WS_ACT), (const char*)(ws + WS_W2_T), T, G, blk};
        pg8::EpiMoeDown E{(const float*)(ws + WS_ROWW), (unsigned char*)(ws + WS_YS)};
        pg8::gemm_phase(lds, FE / 2, S, E, wave);
    }
    SEAM(8);
    if (IN(9)) { FRESH_IDS; p9_final(p, lds, T, blk, tid, wave, lane, lo == 9, 0, nullptr); }
#undef IN
#undef SEAM
}

extern "C" void kernel_launch(void* const* d_in, const int* in_sizes, int n_in, void* d_out, int out_size, void* d_ws, size_t ws_size, hipStream_t stream) {
    static int grid = 0;
    if (grid == 0) {
        if (n_in != 21 || out_size != M * D || ws_size < WS_END) { fprintf(stderr, "kernel_launch: unexpected problem (n_in %d out %d ws %zu)\n", n_in, out_size, ws_size); grid = -1; return; }
        if (hipFuncSetAttribute((const void*)mk_fwd, hipFuncAttributeMaxDynamicSharedMemorySize, LDS_BYTES) != hipSuccess) { fprintf(stderr, "kernel_launch: hipFuncSetAttribute failed\n"); grid = -1; return; }
        int dev = 0, cus = 0, per_cu = 0;
        if (hipGetDevice(&dev) != hipSuccess || hipDeviceGetAttribute(&cus, hipDeviceAttributeMultiprocessorCount, dev) != hipSuccess) { fprintf(stderr, "kernel_launch: device query failed\n"); grid = -1; return; }
        if (hipOccupancyMaxActiveBlocksPerMultiprocessor(&per_cu, (const void*)mk_fwd, NTHREADS, LDS_BYTES) != hipSuccess) per_cu = 0;
        (void)hipGetLastError();
        if (cus != 256 || per_cu < 1) { fprintf(stderr, "kernel_launch: built for 256 CUs with one resident workgroup each (got %d CUs, %d per CU)\n", cus, per_cu); grid = -1; return; }
        grid = 256;
    }
    if (grid < 0) return;
    unsigned char* ws = (unsigned char*)d_ws;
    (void)hipMemsetAsync(ws + WS_CTL, 0, CTL_BYTES, stream);
    Params p{};
    for (int i = 0; i < 21; ++i) p.in[i] = (const float*)d_in[i];
    p.out = (float*)d_out; p.ws = ws; p.alt = ws + WS_U; p.altg = (float*)(ws + WS_G);
    auto frame = [&](int lo, int hi) { p.ph_lo = lo; p.ph_hi = hi; hipLaunchKernelGGL(mk_fwd, dim3(grid), dim3(NTHREADS), LDS_BYTES, stream, p); };
    frame(0, 10);
}
```

```cpp
#include <hip/hip_runtime.h>
#include <cstdio>
#include <cstdint>

#ifndef GMLP_ITEMS
#define GMLP_ITEMS 0
#endif
constexpr int D = 2048, NB = 2, SEQ = 8192, M = NB * SEQ;
constexpr int NCOLS = 9216, GW = 1024, AW = 1024, NH = 16, HD = 64;
constexpr int NEXP = 32, FE = 512, NMOD = 6 * D;
constexpr int MAXRT = 160, MPAD = MAXRT * 256;
constexpr float EPS = 1e-6f;
constexpr float LOG2E = 1.4426950408889634f;
constexpr float QSCALE = 0.125f * LOG2E;

constexpr size_t MiB = 1u << 20;
constexpr size_t WS_CTL = 0, CTL_BYTES = 1 * MiB;
constexpr size_t WS_MODP = 1 * MiB;
constexpr size_t WS_MOD = 4 * MiB;
constexpr size_t WS_HSC = 4 * MiB + 512 * 1024;
constexpr size_t WS_CS = WS_HSC + 64 * 1024;
constexpr size_t WS_WSB = WS_HSC + 128 * 1024;
constexpr size_t WS_COLMAX_O = WS_CTL + 576 * 1024;
constexpr size_t WS_CSO = WS_HSC + 112 * 1024;
constexpr size_t WS_SM = WS_HSC;
constexpr size_t WS_COLMAX = WS_CTL + 512 * 1024;
constexpr size_t WS_TOKLIST = 5 * MiB;
constexpr size_t WS_SLOTE = 7 * MiB;
constexpr size_t WS_SLOTW = 7 * MiB + 256 * 1024;
constexpr size_t WS_WRT = 7 * MiB + 512 * 1024;
constexpr size_t WS_WIN_T = 8 * MiB;
constexpr size_t WS_WA_T = 44 * MiB;
constexpr size_t WS_WB_T = 48 * MiB;
constexpr size_t WS_WOUT_T = 52 * MiB;
constexpr size_t WS_W13_T = 60 * MiB;
constexpr size_t WS_W2_T = 188 * MiB;
constexpr size_t WS_H = 252 * MiB;
constexpr size_t WS_YA8 = WS_H, WS_YB8 = WS_H + 16 * MiB;
constexpr size_t WS_U = 316 * MiB;
constexpr size_t WS_V = 348 * MiB;
constexpr size_t WS_Q = 380 * MiB;
constexpr size_t WS_K = 412 * MiB;
constexpr size_t WS_VT = 444 * MiB;
constexpr size_t WS_G = 476 * MiB;
constexpr size_t WS_MIX = 604 * MiB;
constexpr size_t WS_END = 668 * MiB;
constexpr size_t WS_X1B = 540 * MiB;
constexpr size_t WS_ROWW = WS_MIX;
constexpr size_t WS_ACT = WS_U;
constexpr size_t WS_YS = WS_U + 40 * MiB;
static_assert(WS_YS + (size_t)MPAD * D * 2 <= WS_X1B && WS_X1B + (size_t)M * D * 2 <= WS_MIX && WS_X1B >= WS_G, "MoE buffers overlay the dead mixer buffers");
constexpr int CW_TMO = 0, CW_CODE = 1, CW_CNT = 1024  , CW_BAR = 4096;

typedef unsigned short bf16_t;
typedef float f32x4 __attribute__((ext_vector_type(4)));
typedef float f32x2 __attribute__((ext_vector_type(2)));
typedef unsigned u32x4 __attribute__((ext_vector_type(4)));
typedef unsigned u32x2 __attribute__((ext_vector_type(2)));
#define LAS __attribute__((address_space(3)))

__device__ __forceinline__ int fresh_lane() { int l; asm volatile("v_mbcnt_lo_u32_b32 %0, -1, 0\n\tv_mbcnt_hi_u32_b32 %0, -1, %0" : "=v"(l)); return l; }
__device__ __forceinline__ float bf2f(bf16_t v) { return __uint_as_float(((unsigned)v) << 16); }
__device__ __forceinline__ unsigned f2bf(float f) { unsigned u = __float_as_uint(f); return (u + 0x7fffu + ((u >> 16) & 1u)) >> 16; }
typedef __bf16 bf16x2v_t __attribute__((ext_vector_type(2)));
__device__ __forceinline__ unsigned pk2(float lo, float hi) { f32x2 v = {lo, hi}; bf16x2v_t b = __builtin_convertvector(v, bf16x2v_t); return __builtin_bit_cast(unsigned, b); }
__device__ __forceinline__ float clamp448(float x) { return __builtin_fminf(__builtin_fmaxf(x, -448.f), 448.f); }
__device__ __forceinline__ unsigned pk4_f8(float a, float b, float c, float d) {
    const unsigned w = __builtin_amdgcn_cvt_pk_fp8_f32(clamp448(a), clamp448(b), 0, false); return __builtin_amdgcn_cvt_pk_fp8_f32(clamp448(c), clamp448(d), w, true); }
constexpr float F8_SW = 256.f, F8_SH2 = 16.f, F8_SACT = 8.f, F8_SY = 16.f;
__device__ __forceinline__ float wave_max(float v) {
#pragma unroll
    for (int o = 32; o > 0; o >>= 1) v = fmaxf(v, __shfl_xor(v, o, 64));
    return v; }
constexpr float I8MAGIC = 12582912.f;
__device__ __forceinline__ unsigned pack4_i8(unsigned a, unsigned b, unsigned c, unsigned d) { return (a & 0xffu) | ((b & 0xffu) << 8) | ((c & 0xffu) << 16) | (d << 24); }
__device__ __forceinline__ float wave_sum(float v) {
#pragma unroll
    for (int o = 1; o < 64; o <<= 1) v += __shfl_xor(v, o);
    return v;
}
__device__ __forceinline__ float gelu_erf(float x) { return 0.5f * x * (1.0f + erff(x * 0.70710678118654752f)); }
__device__ __forceinline__ float sigmoidf_(float x) { return 1.0f / (1.0f + __expf(-x)); }
__device__ __forceinline__ float siluf_(float x) { return x / (1.0f + __expf(-x)); }

struct Params {
    const float* in[21];
    float* out;
    unsigned char* ws;
    int ph_lo, ph_hi;
    unsigned char* alt;
    float* altg;
};
enum { I_X = 0, I_C, I_ADAW, I_ADAB, I_N1G, I_WIN, I_LNG, I_LNB, I_WS, I_BS, I_REL, I_WA, I_WB, I_WOUT, I_N2G, I_WGRP, I_WEXP, I_W1, I_W3, I_W2, I_FING };

struct MoeTab { LAS int* tb; LAS int* cn; LAS int* rte; };
__device__ __forceinline__ void build_tables(const unsigned* ctl, const MoeTab& T, int tid) {
    if (tid == 0) {
        int acc = 0;
        for (int e = 0; e < NEXP; ++e) {
            const int c = (int)__hip_atomic_load(ctl + CW_CNT + 64 * e, __ATOMIC_RELAXED, __HIP_MEMORY_SCOPE_AGENT);
            T.cn[e] = c; T.tb[e] = acc; const int nt = (c + 255) >> 8;
            for (int t = 0; t < nt; ++t) T.rte[acc + t] = e;
            acc += nt;
        }
        T.tb[NEXP] = acc;
    }
    __syncthreads();
}

namespace pg8 {
typedef short bf16x8 __attribute__((ext_vector_type(8)));
typedef int i32x4 __attribute__((ext_vector_type(4)));
typedef int i32x8 __attribute__((ext_vector_type(8)));
constexpr int BM = 256, BK = 64, HALF = 128, HTB = HALF * BK * 2, STAGE_BYTES = 8 * HTB;
__device__ __forceinline__ int lds_byte(int r, int c) { const int st = (r >> 4) * 2 + (c >> 5), rr = r & 15, cc = c & 31, ob = rr * 64 + cc * 2; return st * 1024 + (ob ^ (((ob >> 9) & 1) << 5)); }
__device__ __forceinline__ void stage_rc(int b, int& R, int& C) { const int st = b / 1024, sb = b % 1024, swz = sb ^ (((sb >> 9) & 1) << 5); R = (st >> 1) * 16 + swz / 64; C = (st & 1) * 32 + (swz % 64) / 2; }
__device__ __forceinline__ int perm32(int rho) { const int n = rho >> 4, i = rho & 15; return 8 * (i >> 2) + 4 * n + (i & 3); }
struct Unit { const char* A; const char* B; int pm, pn, aux, aux2; };
typedef __bf16 bf16x2_t __attribute__((ext_vector_type(2)));
__device__ __forceinline__ unsigned cvt_pk_bf16(float lo, float hi) { f32x2 v = {lo, hi}; bf16x2_t b = __builtin_convertvector(v, bf16x2_t); return __builtin_bit_cast(unsigned, b); }
__device__ __forceinline__ f32x2 gelu_pk(f32x2 v) {
    const f32x2 av = __builtin_elementwise_abs(v), d = av * 0.2316418882f + 1.0f;
    f32x2 t; t.x = __builtin_amdgcn_rcpf(d.x); t.y = __builtin_amdgcn_rcpf(d.y);
    f32x2 q = t * 0.5307027145f + (-0.7265760135f); q = q * t + 0.7107068705f; q = q * t + (-0.142248368f); q = q * t + 0.127414796f; q = q * t;
    const f32x2 s = (v * v) * (-0.72134752044f);
    f32x2 e; e.x = __builtin_amdgcn_exp2f(s.x); e.y = __builtin_amdgcn_exp2f(s.y);
    const f32x2 m = v * (q * e), r = v - m;
    f32x2 o; o.x = v.x < 0.f ? m.x : r.x; o.y = v.y < 0.f ? m.y : r.y; return o;
}
__device__ __forceinline__ bool static_tile(int L, int nM, int nN, int& pm, int& pn) {
    const int nwg = nM * nN; if (L >= nwg) return false;
    int wgid = L; { const int q = nwg / 8, r = nwg % 8, xcd = wgid % 8, off = wgid / 8; wgid = (xcd < r ? xcd * (q + 1) : r * (q + 1) + (xcd - r) * q) + off; }
    const int nig = 8 * nN, gid = wgid / nig, fm = gid * 8, gsz = (nM - fm) < 8 ? (nM - fm) : 8;
    pm = fm + ((wgid % nig) % gsz); pn = (wgid % nig) / gsz; return true;
}

template <class Epi, class Sched>
__device__ __forceinline__ void gemm_phase(LAS unsigned char* lds, const int K, const Sched& S, const Epi& E, const int wid) {
    const int lane = fresh_lane(), tid = wid * 64 + lane, wr = wid >> 2, wc = wid & 3, fr = lane & 15, fq = lane >> 4;
    const int nt = K / BK;
    int R[2], C[2]; unsigned voffB[2];
#pragma unroll
    for (int i = 0; i < 2; ++i) { stage_rc(tid * 16 + i * 8192, R[i], C[i]); const int Rb = Epi::PERM ? ((R[i] & ~31) + perm32(R[i] & 31)) : R[i]; voffB[i] = (unsigned)(Rb * K + C[i]) * 2u; }
    const size_t kstep = (size_t)(BK * 2);
    const size_t hstep = (size_t)HALF * K * 2;
    const unsigned ldsw = (unsigned)wid * 1024u;
    const int aoff = lds_byte(wr * 64 + fr, fq * 8), boff = lds_byte(wc * 32 + fr, fq * 8);
#define PG8_SA(b, h) (((b) * 2 + (h)) * HTB)
#define PG8_SB(b, h) ((4 + (b) * 2 + (h)) * HTB)
#define PG8_STAGE(bufoff, gbase, voff) do { _Pragma("unroll") for (int _i = 0; _i < 2; ++_i) \
        __builtin_amdgcn_global_load_lds((const unsigned*)((const char*)(gbase) + (voff)[_i]), (LAS unsigned*)(lds + (bufoff) + ldsw + _i * 8192), 16, 0, 0); } while (0)
#define PG8_LDA(dst, b, h) do { if constexpr (Epi::MODE == 2) { _Pragma("unroll") for (int m = 0; m < 4; ++m) dst##8[m] = __builtin_shufflevector(*(const LAS i32x4*)(lds + PG8_SA(b, h) + aoff + m * 2048), *(const LAS i32x4*)(lds + PG8_SA(b, h) + aoff + m * 2048 + 1024), 0, 1, 2, 3, 4, 5, 6, 7); } \
        else { _Pragma("unroll") for (int m = 0; m < 4; ++m) _Pragma("unroll") for (int k = 0; k < 2; ++k) dst[m][k] = *(const LAS bf16x8*)(lds + PG8_SA(b, h) + aoff + m * 2048 + k * 1024); } } while (0)
#define PG8_LDB(dst, b, h) do { if constexpr (Epi::MODE == 2) { _Pragma("unroll") for (int n = 0; n < 2; ++n) dst##8[n] = __builtin_shufflevector(*(const LAS i32x4*)(lds + PG8_SB(b, h) + boff + n * 2048), *(const LAS i32x4*)(lds + PG8_SB(b, h) + boff + n * 2048 + 1024), 0, 1, 2, 3, 4, 5, 6, 7); } \
        else { _Pragma("unroll") for (int n = 0; n < 2; ++n) _Pragma("unroll") for (int k = 0; k < 2; ++k) dst[n][k] = *(const LAS bf16x8*)(lds + PG8_SB(b, h) + boff + n * 2048 + k * 1024); } } while (0)
#define PG8_MMA(ai, bj, At, Bt) do { __builtin_amdgcn_s_setprio(1); _Pragma("unroll") for (int m = 0; m < 4; ++m) _Pragma("unroll") for (int n = 0; n < 2; ++n) _Pragma("unroll") for (int k = 0; k < 2; ++k) \
        { if constexpr (Epi::MODE == 1) acc[ai][bj][m][n] = __builtin_bit_cast(f32x4, __builtin_amdgcn_mfma_i32_16x16x64_i8(__builtin_bit_cast(i32x4, Bt[n][k]), __builtin_bit_cast(i32x4, At[m][k]), __builtin_bit_cast(i32x4, acc[ai][bj][m][n]), 0, 0, 0)); \
          else if constexpr (Epi::MODE == 2) { if (k == 0) asm volatile("v_mfma_f32_16x16x128_f8f6f4 %0, %1, %2, %0" : "+v"(acc[ai][bj][m][n]) : "v"(Bt##8[n]), "v"(At##8[m])); } \
          else acc[ai][bj][m][n] = __builtin_amdgcn_mfma_f32_16x16x32_bf16(Bt[n][k], At[m][k], acc[ai][bj][m][n], 0, 0, 0); } __builtin_amdgcn_s_setprio(0); } while (0)
#define PG8_WAIT_V(n) asm volatile("s_waitcnt vmcnt(" #n ")" ::: "memory")
#define PG8_WAIT_L(n) asm volatile("s_waitcnt lgkmcnt(" #n ")" ::: "memory")
#define PG8_BAR __builtin_amdgcn_s_barrier()
#define PG8_SCHED __builtin_amdgcn_sched_barrier(0)
    Unit cur, nxt; int ui = 0;
    if (!S.next(0, cur)) return;
    f32x4 acc[2][2][4][2];
#pragma unroll
    for (int a = 0; a < 2; ++a)
#pragma unroll
        for (int b = 0; b < 2; ++b)
#pragma unroll
            for (int m = 0; m < 4; ++m)
#pragma unroll
                for (int n = 0; n < 2; ++n) acc[a][b][m][n] = (f32x4){0.f, 0.f, 0.f, 0.f};
    bf16x8 At[4][2], B0[2][2], B1[2][2];
    i32x8 At8[4], B08[2], B18[2];
    unsigned voffA[2][2], nvoffA[2][2];
    S.arows(cur, voffA, R, C);
    const char* cA = cur.A; const char* cB = cur.B;
    PG8_STAGE(PG8_SB(0, 0), cB, voffB); PG8_STAGE(PG8_SB(0, 1), cB + hstep, voffB); PG8_STAGE(PG8_SA(0, 0), cA, voffA[0]); PG8_STAGE(PG8_SA(0, 1), cA, voffA[1]);
    if (wr == 1) PG8_BAR;
    PG8_WAIT_V(2); PG8_BAR;
    PG8_STAGE(PG8_SB(1, 0), cB + kstep, voffB); PG8_STAGE(PG8_SA(1, 0), cA + kstep, voffA[0]); PG8_STAGE(PG8_SB(1, 1), cB + hstep + kstep, voffB);
    PG8_WAIT_V(6); PG8_BAR;
    for (;;) {
        const bool has_next = S.next(ui + 1, nxt);
        if (has_next && Sched::GATHER) S.arows(nxt, nvoffA, R, C);
        else {
#pragma unroll
            for (int h = 0; h < 2; ++h)
#pragma unroll
                for (int i = 0; i < 2; ++i) nvoffA[h][i] = voffA[h][i]; }
        const char* nA = has_next ? nxt.A : cA; const char* nB = has_next ? nxt.B : cB;
#pragma nounroll
        for (int t = 0; t < nt; t += 2) {
            const bool last = (t == nt - 2);
            const char* a1 = cA + (size_t)(t + 1) * kstep;
            const char* a2 = last ? nA : cA + (size_t)(t + 2) * kstep; const char* b2 = last ? nB : cB + (size_t)(t + 2) * kstep;
            const char* a3 = a2 + kstep; const char* b3 = b2 + kstep;
            unsigned o2[2][2];
#pragma unroll
            for (int h = 0; h < 2; ++h)
#pragma unroll
                for (int i = 0; i < 2; ++i) o2[h][i] = (Sched::GATHER && last) ? nvoffA[h][i] : voffA[h][i];
            PG8_LDB(B0, 0, 0); PG8_LDB(B1, 0, 1); PG8_SCHED; PG8_LDA(At, 0, 0); PG8_STAGE(PG8_SA(1, 1), a1, voffA[1]);
            PG8_WAIT_V(8); PG8_WAIT_L(0); PG8_BAR; PG8_MMA(0, 0, At, B0); PG8_MMA(0, 1, At, B1); PG8_BAR; PG8_SCHED;
            PG8_LDA(At, 0, 1); PG8_STAGE(PG8_SB(0, 0), b2, voffB); PG8_STAGE(PG8_SB(0, 1), b2 + hstep, voffB); PG8_STAGE(PG8_SA(0, 0), a2, o2[0]);
            PG8_WAIT_V(8); PG8_WAIT_L(0); PG8_BAR; PG8_MMA(1, 0, At, B0); PG8_MMA(1, 1, At, B1); PG8_BAR; PG8_SCHED;
            PG8_LDB(B0, 1, 0); PG8_LDB(B1, 1, 1); PG8_SCHED; PG8_LDA(At, 1, 0); PG8_STAGE(PG8_SA(0, 1), a2, o2[1]);
            PG8_WAIT_V(8); PG8_WAIT_L(0); PG8_BAR; PG8_MMA(0, 0, At, B0); PG8_MMA(0, 1, At, B1); PG8_BAR; PG8_SCHED;
            PG8_LDA(At, 1, 1); PG8_STAGE(PG8_SB(1, 0), b3, voffB); PG8_STAGE(PG8_SB(1, 1), b3 + hstep, voffB); PG8_STAGE(PG8_SA(1, 0), a3, o2[0]);
            PG8_WAIT_V(8); PG8_WAIT_L(0); PG8_BAR; PG8_MMA(1, 0, At, B0); PG8_MMA(1, 1, At, B1); PG8_BAR; PG8_SCHED;
        }
        if constexpr (Epi::MODE == 2) asm volatile("s_nop 15\n\ts_nop 15" ::: "memory");
        if (wr == 0) PG8_BAR;
        const int le = fresh_lane();
        const bool keep = E(acc, cur, wr, wc, le & 15, le >> 4);
        if (!has_next) break;
        if (!keep) {
#pragma unroll
            for (int a = 0; a < 2; ++a)
#pragma unroll
                for (int b = 0; b < 2; ++b)
#pragma unroll
                    for (int m = 0; m < 4; ++m)
#pragma unroll
                        for (int n = 0; n < 2; ++n) acc[a][b][m][n] = (f32x4){0.f, 0.f, 0.f, 0.f}; }
        cur = nxt; cA = nA; cB = nB; ++ui;
#pragma unroll
        for (int h = 0; h < 2; ++h)
#pragma unroll
            for (int i = 0; i < 2; ++i) if (Sched::GATHER) voffA[h][i] = nvoffA[h][i];
        if (wr == 1) PG8_BAR;
    }
    PG8_WAIT_V(0);
    PG8_BAR;
#undef PG8_SA
#undef PG8_SB
#undef PG8_STAGE
#undef PG8_LDA
#undef PG8_LDB
#undef PG8_MMA
#undef PG8_WAIT_V
#undef PG8_WAIT_L
#undef PG8_BAR
#undef PG8_SCHED
}

struct SchedGrid {
    static constexpr bool GATHER = false;
    const char* A; const char* B; int lda, K, nM, nN, G, c;
    __device__ __forceinline__ bool next(int i, Unit& u) const { int pm, pn; if (!static_tile(i * G + c, nM, nN, pm, pn)) return false;
        u.A = A + (size_t)pm * 256 * lda * 2; u.B = B + (size_t)pn * 256 * K * 2; u.pm = pm; u.pn = pn; u.aux = 0; u.aux2 = 0; return true; }
    __device__ __forceinline__ void arows(const Unit&, unsigned (&off)[2][2], const int (&R)[2], const int (&C)[2]) const {
#pragma unroll
        for (int h = 0; h < 2; ++h)
#pragma unroll
            for (int i = 0; i < 2; ++i) off[h][i] = (unsigned)((h * 128 + R[i]) * lda + C[i]) * 2u; }
};
struct SchedBranch {
    static constexpr bool GATHER = false;
    const char* A0; const char* B0; const char* A1; const char* B1; int G, c;
    __device__ __forceinline__ bool next(int i, Unit& u) const { int pm, pn; if (!static_tile((i >> 1) * G + c, 64, 8, pm, pn)) return false; const int br = i & 1;
        u.A = (br ? A1 : A0) + (size_t)pm * 256 * 1024; u.B = (br ? B1 : B0) + (size_t)pn * 256 * 1024; u.pm = pm; u.pn = pn; u.aux = br; u.aux2 = 0; return true; }
    __device__ __forceinline__ void arows(const Unit&, unsigned (&off)[2][2], const int (&R)[2], const int (&C)[2]) const {
#pragma unroll
        for (int h = 0; h < 2; ++h)
#pragma unroll
            for (int i = 0; i < 2; ++i) off[h][i] = (unsigned)((h * 128 + R[i]) * 1024) + 2u * (unsigned)C[i]; }
};
struct SchedMoeUp {
    static constexpr bool GATHER = true;
    const char* H2; const char* W13; const LAS int* ltok; MoeTab T; int G, c;
    __device__ __forceinline__ bool next(int i, Unit& u) const { const int L = i * G + c, rt = L >> 2, ct = L & 3; if (rt >= __builtin_amdgcn_readfirstlane(T.tb[NEXP])) return false;
        const int e = __builtin_amdgcn_readfirstlane(T.rte[rt]), r0 = (rt - __builtin_amdgcn_readfirstlane(T.tb[e])) * 256, nv = __builtin_amdgcn_readfirstlane(T.cn[e]) - r0;
        u.A = H2; u.B = W13 + ((size_t)e * 1024 + ct * 256) * D; u.pm = rt; u.pn = ct; u.aux = nv < 256 ? nv : 256; u.aux2 = i; return true; }
    __device__ __forceinline__ void arows(const Unit& u, unsigned (&off)[2][2], const int (&R)[2], const int (&C)[2]) const {
#pragma unroll
        for (int h = 0; h < 2; ++h)
#pragma unroll
            for (int i = 0; i < 2; ++i) { const int tok = ltok[u.aux2 * 256 + h * 128 + R[0] + 64 * i]; off[h][i] = (unsigned)(tok * D) + 2u * (unsigned)C[0]; } }
};
struct SchedMoeDown {
    static constexpr bool GATHER = false;
    const char* ACT; const char* W2; MoeTab T; int G, c;
    __device__ __forceinline__ bool next(int i, Unit& u) const { const int L = i * G + c, rt = L >> 3, ct = L & 7; if (rt >= __builtin_amdgcn_readfirstlane(T.tb[NEXP])) return false;
        const int e = __builtin_amdgcn_readfirstlane(T.rte[rt]), r0 = (rt - __builtin_amdgcn_readfirstlane(T.tb[e])) * 256, nv = __builtin_amdgcn_readfirstlane(T.cn[e]) - r0;
        u.A = ACT + (size_t)rt * 256 * FE; u.B = W2 + ((size_t)e * D + ct * 256) * FE; u.pm = rt; u.pn = ct; u.aux = nv < 256 ? nv : 256; u.aux2 = e * 16384 + r0; return true; }
    __device__ __forceinline__ void arows(const Unit&, unsigned (&off)[2][2], const int (&R)[2], const int (&C)[2]) const {
#pragma unroll
        for (int h = 0; h < 2; ++h)
#pragma unroll
            for (int i = 0; i < 2; ++i) off[h][i] = (unsigned)((h * 128 + R[i]) * FE) + 2u * (unsigned)C[i]; }
};

__device__ __forceinline__ u32x4 pack8(const f32x4& v0, const f32x4& v1) { u32x4 w; w.x = cvt_pk_bf16(v0[0], v0[1]); w.y = cvt_pk_bf16(v0[2], v0[3]); w.z = cvt_pk_bf16(v1[0], v1[1]); w.w = cvt_pk_bf16(v1[2], v1[3]); return w; }
__device__ __forceinline__ void unpack8(const u32x4& w, f32x4& v0, f32x4& v1) {
    v0[0] = __uint_as_float(w.x << 16); v0[1] = __uint_as_float(w.x & 0xffff0000u); v0[2] = __uint_as_float(w.y << 16); v0[3] = __uint_as_float(w.y & 0xffff0000u);
    v1[0] = __uint_as_float(w.z << 16); v1[1] = __uint_as_float(w.z & 0xffff0000u); v1[2] = __uint_as_float(w.w << 16); v1[3] = __uint_as_float(w.w & 0xffff0000u); }
__device__ __forceinline__ f32x4 sig4(const f32x4& v) { f32x4 o;
#pragma unroll
    for (int j = 0; j < 4; ++j) o[j] = __builtin_amdgcn_rcpf(1.0f + __builtin_amdgcn_exp2f(-LOG2E * v[j])); return o; }

struct EpiProj {
    static constexpr bool PERM = true; static constexpr int MODE = 1;
    bf16_t *U, *V, *Q, *Kb, *VT, *G; const float *HSC, *CS;
    __device__ __forceinline__ bool operator()(f32x4 (&acc)[2][2][4][2], const Unit& u, int wr, int wc, int fr, int fq) const {
        const int pn = u.pn, row0 = u.pm * BM + wr * 64 + fr, cl = wc * 32 + 8 * fq;
        {
            const float* hs = HSC + row0; const f32x4* cp = (const f32x4*)(CS + pn * 256 + cl);
            float rs[2][4]; f32x4 cs[2][2];
#pragma unroll
            for (int ai = 0; ai < 2; ++ai)
#pragma unroll
                for (int m = 0; m < 4; ++m) rs[ai][m] = hs[ai * HALF + m * 16];
#pragma unroll
            for (int bj = 0; bj < 2; ++bj) { cs[bj][0] = cp[bj * 32]; cs[bj][1] = cp[bj * 32 + 1]; }
#pragma unroll
            for (int ai = 0; ai < 2; ++ai)
#pragma unroll
                for (int bj = 0; bj < 2; ++bj)
#pragma unroll
                    for (int m = 0; m < 4; ++m)
#pragma unroll
                        for (int n = 0; n < 2; ++n) acc[ai][bj][m][n] = __builtin_convertvector(__builtin_bit_cast(i32x4, acc[ai][bj][m][n]), f32x4) * (cs[bj][n] * rs[ai][m]);
        }
        if (pn < 8) {
            bf16_t* base = (pn < 4 ? U : V) + (pn & 3) * 256 + cl;
#pragma unroll
            for (int ai = 0; ai < 2; ++ai)
#pragma unroll
                for (int m = 0; m < 4; ++m) { bf16_t* rowp = base + (size_t)(row0 + ai * HALF + m * 16) * 1024;
#pragma unroll
                    for (int bj = 0; bj < 2; ++bj) { const f32x4 v0 = acc[ai][bj][m][0], v1 = acc[ai][bj][m][1];
                        const f32x2 a = gelu_pk((f32x2){v0[0], v0[1]}), b = gelu_pk((f32x2){v0[2], v0[3]}), c = gelu_pk((f32x2){v1[0], v1[1]}), d = gelu_pk((f32x2){v1[2], v1[3]});
                        *(u32x4*)(rowp + bj * HALF) = pack8((f32x4){a.x, a.y, b.x, b.y}, (f32x4){c.x, c.y, d.x, d.y}); } }
        } else if (pn < 16) {
            bf16_t* base = (pn < 12 ? Q : Kb) + (pn & 3) * 256 + cl; const float sc = pn < 12 ? QSCALE : 1.0f;
#pragma unroll
            for (int ai = 0; ai < 2; ++ai)
#pragma unroll
                for (int m = 0; m < 4; ++m) { bf16_t* rowp = base + (size_t)(row0 + ai * HALF + m * 16) * 1024;
#pragma unroll
                    for (int bj = 0; bj < 2; ++bj) *(u32x4*)(rowp + bj * HALF) = pack8(acc[ai][bj][m][0] * sc, acc[ai][bj][m][1] * sc); }
        } else if (pn < 20) {
#ifndef DIAG_NOVT
#pragma unroll
            for (int ai = 0; ai < 2; ++ai)
#pragma unroll
                for (int m = 0; m < 4; ++m) { const int row = row0 + ai * HALF + m * 16, b = row >> 13, s = row & 8191;
#pragma unroll
                    for (int bj = 0; bj < 2; ++bj) { const int c5 = (pn - 16) * 256 + bj * HALF + cl, hh = c5 >> 6, d = c5 & 63;
                        bf16_t* bp = VT + ((size_t)((b * 16 + hh) * 64 + d)) * 8192 + s; const u32x4 w = pack8(acc[ai][bj][m][0], acc[ai][bj][m][1]);
                        bp[0 * 8192] = (bf16_t)(w.x & 0xffffu); bp[1 * 8192] = (bf16_t)(w.x >> 16); bp[2 * 8192] = (bf16_t)(w.y & 0xffffu); bp[3 * 8192] = (bf16_t)(w.y >> 16);
                        bp[4 * 8192] = (bf16_t)(w.z & 0xffffu); bp[5 * 8192] = (bf16_t)(w.z >> 16); bp[6 * 8192] = (bf16_t)(w.w & 0xffffu); bp[7 * 8192] = (bf16_t)(w.w >> 16); } }
#endif
        } else {
            unsigned short* base = (unsigned short*)G + (pn - 20) * 128 + cl;
#pragma unroll
            for (int ai = 0; ai < 2; ++ai)
#pragma unroll
                for (int m = 0; m < 4; ++m) { unsigned short* rowp = base + (size_t)(row0 + ai * HALF + m * 16) * D;
                    const f32x4 a0 = sig4(acc[ai][0][m][0]), a1 = sig4(acc[ai][0][m][1]), b0 = sig4(acc[ai][1][m][0]), b1 = sig4(acc[ai][1][m][1]);
                    unsigned q[8];
#pragma unroll
                    for (int j = 0; j < 4; ++j) { unsigned qa = (unsigned)(a0[j] * 255.f + 0.5f), qb = (unsigned)(b0[j] * 255.f + 0.5f); qa = qa < 1u ? 1u : qa; qb = qb < 1u ? 1u : qb; q[j] = qa | (qb << 8);
                        unsigned ra = (unsigned)(a1[j] * 255.f + 0.5f), rb = (unsigned)(b1[j] * 255.f + 0.5f); ra = ra < 1u ? 1u : ra; rb = rb < 1u ? 1u : rb; q[4 + j] = ra | (rb << 8); }
                    u32x4 w; w.x = q[0] | (q[1] << 16); w.y = q[2] | (q[3] << 16); w.z = q[4] | (q[5] << 16); w.w = q[6] | (q[7] << 16);
                    __builtin_nontemporal_store(w, (u32x4*)rowp); }
        }
        return false;
    }
};
struct EpiBranch {
    static constexpr bool PERM = true; static constexpr int MODE = 2;
    const unsigned short* G; bf16_t* MIX;
    mutable unsigned gbk[2][4][2][2];
    __device__ __forceinline__ bool operator()(f32x4 (&acc)[2][2][4][2], const Unit& u, int wr, int wc, int fr, int fq) const {
        const int row0 = u.pm * BM + wr * 64 + fr, col0 = u.pn * BM + wc * 32 + 8 * fq; const bool brb = u.aux != 0;
        if (!brb) {
#pragma unroll
            for (int ai = 0; ai < 2; ++ai) {
                u32x4 g[4][2];
#pragma unroll
                for (int m = 0; m < 4; ++m)
#pragma unroll
                    for (int bj = 0; bj < 2; ++bj) g[m][bj] = __builtin_nontemporal_load((const u32x4*)(G + (size_t)(row0 + ai * HALF + m * 16) * D + col0 + bj * HALF));
#pragma unroll
                for (int m = 0; m < 4; ++m)
#pragma unroll
                    for (int bj = 0; bj < 2; ++bj) {
                        const unsigned w[4] = {g[m][bj].x, g[m][bj].y, g[m][bj].z, g[m][bj].w};
#pragma unroll
                        for (int j = 0; j < 4; ++j) {
                            const float r0 = (float)(w[j] & 0xffu) * __builtin_amdgcn_rcpf((float)((w[j] >> 8) & 0xffu)), r1 = (float)((w[j] >> 16) & 0xffu) * __builtin_amdgcn_rcpf((float)(w[j] >> 24));
                            acc[ai][bj][m][j >> 1][2 * (j & 1)] *= r0; acc[ai][bj][m][j >> 1][2 * (j & 1) + 1] *= r1; }
                        gbk[ai][m][bj][0] = ((w[0] >> 8) & 0xffu) | ((w[0] >> 24) << 8) | (((w[1] >> 8) & 0xffu) << 16) | ((w[1] >> 24) << 24);
                        gbk[ai][m][bj][1] = ((w[2] >> 8) & 0xffu) | ((w[2] >> 24) << 8) | (((w[3] >> 8) & 0xffu) << 16) | ((w[3] >> 24) << 24);
                    }
            }
            return true;
        }
#pragma unroll
        for (int ai = 0; ai < 2; ++ai)
#pragma unroll
            for (int m = 0; m < 4; ++m)
#pragma unroll
                for (int bj = 0; bj < 2; ++bj) {
                    const unsigned k0 = gbk[ai][m][bj][0], k1 = gbk[ai][m][bj][1];
                    const f32x4 b0 = (f32x4){(float)(k0 & 0xffu), (float)((k0 >> 8) & 0xffu), (float)((k0 >> 16) & 0xffu), (float)(k0 >> 24)} * (1.f / (255.f * F8_SY * F8_SW));
                    const f32x4 b1 = (f32x4){(float)(k1 & 0xffu), (float)((k1 >> 8) & 0xffu), (float)((k1 >> 16) & 0xffu), (float)(k1 >> 24)} * (1.f / (255.f * F8_SY * F8_SW));
                    *(u32x4*)(MIX + (size_t)(row0 + ai * HALF + m * 16) * D + col0 + bj * HALF) = pack8(acc[ai][bj][m][0] * b0, acc[ai][bj][m][1] * b1);
                }
        return false;
    }
};
struct EpiOut {
    static constexpr bool PERM = true; static constexpr int MODE = 1;
    const float* x; const float* mod; bf16_t* out; const float *SM, *CSO;
    __device__ __forceinline__ bool operator()(f32x4 (&acc)[2][2][4][2], const Unit& u, int wr, int wc, int fr, int fq) const {
        const int row0 = u.pm * BM + wr * 64 + fr, col0 = u.pn * BM + wc * 32 + 8 * fq; const float* g1 = mod + ((u.pm * BM) >> 13) * NMOD + 2 * D;
        f32x4 gv[2][2];
#pragma unroll
        for (int bj = 0; bj < 2; ++bj)
#pragma unroll
            for (int n = 0; n < 2; ++n) gv[bj][n] = *(const f32x4*)(g1 + col0 + bj * HALF + 4 * n) * *(const f32x4*)(CSO + col0 + bj * HALF + 4 * n);
#pragma unroll
        for (int ai = 0; ai < 2; ++ai)
#pragma unroll
            for (int m = 0; m < 4; ++m) { const float rs = SM[row0 + ai * HALF + m * 16];
#pragma unroll
                for (int bj = 0; bj < 2; ++bj)
#pragma unroll
                    for (int n = 0; n < 2; ++n) acc[ai][bj][m][n] = __builtin_convertvector(__builtin_bit_cast(i32x4, acc[ai][bj][m][n]), f32x4) * rs; }
#pragma unroll
        for (int ai = 0; ai < 2; ++ai)
#pragma unroll
            for (int mh = 0; mh < 2; ++mh) {
                f32x4 xv[2][2][2];
#pragma unroll
                for (int m = 0; m < 2; ++m)
#pragma unroll
                    for (int bj = 0; bj < 2; ++bj)
#pragma unroll
                        for (int n = 0; n < 2; ++n) xv[m][bj][n] = __builtin_nontemporal_load((const f32x4*)(x + (size_t)(row0 + ai * HALF + (2 * mh + m) * 16) * D + col0 + bj * HALF + 4 * n));
#pragma unroll
                for (int m = 0; m < 2; ++m)
#pragma unroll
                    for (int bj = 0; bj < 2; ++bj)
                        *(u32x4*)(out + (size_t)(row0 + ai * HALF + (2 * mh + m) * 16) * D + col0 + bj * HALF) =
                            pack8(xv[m][bj][0] + gv[bj][0] * acc[ai][bj][2 * mh + m][0], xv[m][bj][1] + gv[bj][1] * acc[ai][bj][2 * mh + m][1]);
            }
        return false;
    }
};
struct EpiMoeUp {
    static constexpr bool PERM = true; static constexpr int MODE = 2;
    unsigned char* ACT;
    __device__ __forceinline__ bool operator()(f32x4 (&acc)[2][2][4][2], const Unit& u, int wr, int wc, int fr, int fq) const {
        const int f0 = u.pn * 128 + wc * 32 + 8 * fq;
#pragma unroll
        for (int ai = 0; ai < 2; ++ai)
#pragma unroll
            for (int m = 0; m < 4; ++m) { const int r = ai * HALF + wr * 64 + m * 16 + fr; const bool valid = r < u.aux;
                f32x4 o[2];
#pragma unroll
                for (int n = 0; n < 2; ++n) { const f32x4 a = acc[ai][0][m][n] * (1.f / (F8_SH2 * F8_SW)), b = acc[ai][1][m][n] * (F8_SACT / (F8_SH2 * F8_SW));
#pragma unroll
                    for (int j = 0; j < 4; ++j) o[n][j] = valid ? a[j] * __builtin_amdgcn_rcpf(1.0f + __builtin_amdgcn_exp2f(-LOG2E * a[j])) * b[j] : 0.f; }
                *(u32x2*)(ACT + ((size_t)u.pm * 256 + r) * FE + f0) = (u32x2){pk4_f8(o[0][0], o[0][1], o[0][2], o[0][3]), pk4_f8(o[1][0], o[1][1], o[1][2], o[1][3])}; }
        return false;
    }
};
struct EpiMoeDown {
    static constexpr bool PERM = true; static constexpr int MODE = 2;
    const float* roww; unsigned char* YS;
    __device__ __forceinline__ bool operator()(f32x4 (&acc)[2][2][4][2], const Unit& u, int wr, int wc, int fr, int fq) const {
        const int col0 = u.pn * BM + wc * 32 + 8 * fq;
        float w[2][4];
#pragma unroll
        for (int ai = 0; ai < 2; ++ai)
#pragma unroll
            for (int m = 0; m < 4; ++m) { const int r = ai * HALF + wr * 64 + m * 16 + fr; w[ai][m] = (64.0f / (F8_SACT * F8_SW)) * roww[u.aux2 + (r < u.aux ? r : 0)]; }
#pragma unroll
        for (int ai = 0; ai < 2; ++ai)
#pragma unroll
            for (int m = 0; m < 4; ++m) { const int r = ai * HALF + wr * 64 + m * 16 + fr;
#pragma unroll
                for (int bj = 0; bj < 2; ++bj) { const f32x4 v0 = acc[ai][bj][m][0] * w[ai][m], v1 = acc[ai][bj][m][1] * w[ai][m];
                    unsigned lo = __builtin_amdgcn_cvt_pk_fp8_f32(v0[0], v0[1], 0, false); lo = __builtin_amdgcn_cvt_pk_fp8_f32(v0[2], v0[3], lo, true);
                    unsigned hi = __builtin_amdgcn_cvt_pk_fp8_f32(v1[0], v1[1], 0, false); hi = __builtin_amdgcn_cvt_pk_fp8_f32(v1[2], v1[3], hi, true);
                    *(u32x2*)(YS + ((size_t)u.pm * 256 + r) * D + col0 + bj * HALF) = (u32x2){lo, hi}; } }
        return false;
    }
};
}

#define XB_TMO      128
#define XB_XCNT(j)  (256  + 64 * (j))
#define XB_XSUB(j)  (1280 + 64 * (j))
#define XB_XGEN(j)  (2304 + 64 * (j))
#define XB_TOP      3328
#define XB_TOPGEN   3392
#define XCD_BAR_WORDS 3456
#define XB_SPIN_CAP (1u << 18)

__device__ __forceinline__ unsigned xb_ld(unsigned* p)              { return __hip_atomic_load(p, __ATOMIC_RELAXED, __HIP_MEMORY_SCOPE_AGENT); }
__device__ __forceinline__ unsigned xb_add(unsigned* p, unsigned v) { return __hip_atomic_fetch_add(p, v, __ATOMIC_RELAXED, __HIP_MEMORY_SCOPE_AGENT); }
__device__ __forceinline__ unsigned xb_xcc_id() { return (unsigned)__builtin_amdgcn_s_getreg((3 << 11) | 20) & 0xFu; }
#define XB_SPIN(cond, bar) do { unsigned _sp = 0; while (cond) { __builtin_amdgcn_s_sleep(1); \
    if ((++_sp & 255u) == 0u) { if (xb_ld(&(bar)[XB_TMO])) break; if (_sp > XB_SPIN_CAP) { atomicAdd(&(bar)[XB_TMO], 1u); break; } } } } while (0)

struct XcdBarrier {
    unsigned* bar; unsigned x;
    volatile LAS unsigned* st;
};

__device__ __forceinline__ XcdBarrier xcd_barrier_post(unsigned* bar, volatile LAS unsigned* st) {
    XcdBarrier b; b.bar = bar; b.x = xb_xcc_id(); b.st = st;
    if (threadIdx.x == 0) (void)xb_add(&bar[XB_XCNT(b.x)], 1u);
    return b;
}
__device__ __forceinline__ void xcd_barrier_complete(unsigned* bar, unsigned x, unsigned& nloc, unsigned& nx) {
    const unsigned G = gridDim.x * gridDim.y * gridDim.z;
    unsigned sum, cnt, mine, sp = 0u;
    for (;;) {
        sum = 0u; cnt = 0u; mine = 0u;
#pragma unroll
        for (unsigned j = 0; j < 16; ++j) { const unsigned c = xb_ld(&bar[XB_XCNT(j)]); sum += c; cnt += (c > 0u) ? 1u : 0u; mine = (j == x) ? c : mine; }
        if (sum == G) break;
        __builtin_amdgcn_s_sleep(1);
        if ((++sp & 255u) == 0u) { if (xb_ld(&bar[XB_TMO])) break; if (sp > XB_SPIN_CAP) { atomicAdd(&bar[XB_TMO], 1u); break; } }
    }
    nloc = mine > 0u ? mine : 1u; nx = cnt > 0u ? cnt : 1u;
}

__device__ __forceinline__ void xcd_barrier(const XcdBarrier& b) {
    asm volatile("s_waitcnt vmcnt(0)" ::: "memory");
    __syncthreads();
    if (threadIdx.x == 0) {
        unsigned* bar = b.bar;
        __builtin_amdgcn_s_waitcnt(0);
        unsigned nloc = b.st[0], nx = b.st[1];
        if (nloc == 0u) { xcd_barrier_complete(bar, b.x, nloc, nx); b.st[0] = nloc; b.st[1] = nx; }
        const unsigned old = xb_add(&bar[XB_XSUB(b.x)], 1u);
        const unsigned gen = old / nloc;
        if (old + 1u == (gen + 1u) * nloc) {
            __builtin_amdgcn_fence(__ATOMIC_RELEASE, "agent");
            asm volatile("s_waitcnt vmcnt(0)" ::: "memory");
            const unsigned og = xb_add(&bar[XB_TOP], 1u);
            const unsigned tg = og / nx;
            if (og + 1u == (tg + 1u) * nx) xb_add(&bar[XB_TOPGEN], 1u);
            else XB_SPIN(xb_ld(&bar[XB_TOPGEN]) == tg, bar);
            __builtin_amdgcn_fence(__ATOMIC_ACQUIRE, "agent");
            xb_add(&bar[XB_XGEN(b.x)], 1u);
            asm volatile("s_waitcnt vmcnt(0)" ::: "memory");
        } else {
            XB_SPIN(xb_ld(&bar[XB_XGEN(b.x)]) == gen, bar);
            __builtin_amdgcn_fence(__ATOMIC_ACQUIRE, "agent");
            asm volatile("s_waitcnt vmcnt(0)" ::: "memory");
        }
    }
    __syncthreads();
}

constexpr int NWAVES = 8, NTHREADS = NWAVES * 64;
constexpr int RING_BYTES = 131072, MISC_OFF = 147456, LDS_BYTES = 155648;

__device__ __forceinline__ void p0_mod_unit(const float* c, const float* ada_w, float* modp, int unit, int lane) {
    const int rb = unit >> 6, cc = unit & 63;
    if (lane < 48) {
        f32x4 a0 = {0.f, 0.f, 0.f, 0.f}, a1 = {0.f, 0.f, 0.f, 0.f};
        const float* wp = ada_w + (size_t)(rb * 64) * NMOD + cc * 192 + lane * 4;
#pragma unroll 8
        for (int r = 0; r < 64; ++r) {
            const float c0 = c[rb * 64 + r], c1 = c[D + rb * 64 + r];
            const float s0 = siluf_(c0), s1 = siluf_(c1);
            const f32x4 w = __builtin_nontemporal_load((const f32x4*)(wp + (size_t)r * NMOD));
            a0 += s0 * w; a1 += s1 * w;
        }
        *(f32x4*)(modp + (size_t)(rb * 2 + 0) * NMOD + cc * 192 + lane * 4) = a0;
        *(f32x4*)(modp + (size_t)(rb * 2 + 1) * NMOD + cc * 192 + lane * 4) = a1;
    }
}
__device__ __forceinline__ void p0_amax_item(const float* Wsrc  , int ldw, unsigned* colmax  , int lane) {
    const float* src = Wsrc + (size_t)(lane >> 5) * ldw + (lane & 31);
    float wv[32];
#pragma unroll
    for (int i = 0; i < 32; ++i) wv[i] = src[(size_t)(2 * i) * ldw];
    float am = 0.f;
#pragma unroll
    for (int i = 0; i < 32; ++i) am = fmaxf(am, fabsf(wv[i]));
    am = fmaxf(am, __shfl_xor(am, 32, 64));
    if (lane < 32) __hip_atomic_fetch_max(colmax + lane, __float_as_uint(am), __ATOMIC_RELAXED, __HIP_MEMORY_SCOPE_AGENT);
}
constexpr int ADA_EARLY = 22;
__device__ __forceinline__ void p2_ada_late(const Params& p, int blk, int wave, int lane) {
    const int idx = wave * 256 + blk;
    if (idx < 32 * (64 - ADA_EARLY)) p0_mod_unit(p.in[I_C], p.in[I_ADAW], (float*)(p.ws + WS_MODP), (idx / (64 - ADA_EARLY)) * 64 + ADA_EARLY + idx % (64 - ADA_EARLY), lane);
}
__device__ __forceinline__ void p0_transpose_item(const float* Wsrc  , int ldw, unsigned char* dst  , int ldd, LAS float* scr, int lane) {
#pragma unroll 8
    for (int i = 0; i < 32; ++i) { const int kk = 2 * i + (lane >> 5); scr[kk * 33 + (lane & 31)] = __builtin_nontemporal_load(Wsrc + (size_t)kk * ldw + (lane & 31)); }
    asm volatile("s_waitcnt lgkmcnt(0)" ::: "memory");
    const int cch = lane & 7;
#pragma unroll
    for (int j = 0; j < 4; ++j) { const int n = (lane >> 3) + 8 * j; const LAS float* s = scr + (8 * cch) * 33 + n;
        u32x2 o; o.x = pk4_f8(s[0 * 33] * F8_SW, s[1 * 33] * F8_SW, s[2 * 33] * F8_SW, s[3 * 33] * F8_SW); o.y = pk4_f8(s[4 * 33] * F8_SW, s[5 * 33] * F8_SW, s[6 * 33] * F8_SW, s[7 * 33] * F8_SW);
        *(u32x2*)(dst + (size_t)n * ldd + 8 * cch) = o; }
    asm volatile("s_waitcnt lgkmcnt(0)" ::: "memory");
}
__device__ __forceinline__ void p1_quant_item(const float* Wsrc, int ldw, unsigned char* dst  , int ldd, const unsigned* colmax  , float* cs  , LAS float* scr, int lane) {
    const float amax = __uint_as_float(__hip_atomic_load(colmax + (lane & 31), __ATOMIC_RELAXED, __HIP_MEMORY_SCOPE_AGENT)), inv = amax > 0.f ? 127.f / amax : 0.f;
    if (cs && lane < 32) cs[lane] = amax * (1.f / 127.f);
#pragma unroll 8
    for (int i = 0; i < 32; ++i) { const int kk = 2 * i + (lane >> 5); scr[kk * 33 + (lane & 31)] = __builtin_nontemporal_load(Wsrc + (size_t)kk * ldw + (lane & 31)) * inv + I8MAGIC; }
    asm volatile("s_waitcnt lgkmcnt(0)" ::: "memory");
    const int c4 = lane & 3;
#pragma unroll
    for (int j = 0; j < 2; ++j) { const int n = (lane >> 2) + 16 * j; const LAS unsigned* s = (const LAS unsigned*)scr + (16 * c4) * 33 + n;
        u32x4 o; o.x = pack4_i8(s[0 * 33], s[1 * 33], s[2 * 33], s[3 * 33]); o.y = pack4_i8(s[4 * 33], s[5 * 33], s[6 * 33], s[7 * 33]);
        o.z = pack4_i8(s[8 * 33], s[9 * 33], s[10 * 33], s[11 * 33]); o.w = pack4_i8(s[12 * 33], s[13 * 33], s[14 * 33], s[15 * 33]);
        *(u32x4*)(dst + (size_t)n * ldd + 16 * c4) = o; }
    asm volatile("s_waitcnt lgkmcnt(0)" ::: "memory");
}
struct XpItem { const float* src; unsigned char* dst; int ldw, ldd, f8; };
__device__ __forceinline__ void xp_issue(const XpItem& x, int lane, float (&xr)[32]) {
    const float* q = x.src + (size_t)(lane >> 5) * x.ldw + (lane & 31); const size_t step = (size_t)2 * x.ldw;
#pragma unroll
    for (int i = 0; i < 32; ++i) { xr[i] = __builtin_nontemporal_load(q); q += step; asm volatile("" : "+v"(q)); }
}
__device__ __forceinline__ void xp_finish(const XpItem& x, int lane, const float (&xr)[32], LAS float* scr) {
#pragma unroll
    for (int i = 0; i < 32; ++i) { const int kk = 2 * i + (lane >> 5); scr[kk * 33 + (lane & 31)] = xr[i]; }
    asm volatile("s_waitcnt lgkmcnt(0)" ::: "memory");
    const int cch = lane & 7;
#pragma unroll
    for (int j = 0; j < 4; ++j) { const int n = (lane >> 3) + 8 * j; const LAS float* s = scr + (8 * cch) * 33 + n;
        u32x2 o; o.x = pk4_f8(s[0 * 33] * F8_SW, s[1 * 33] * F8_SW, s[2 * 33] * F8_SW, s[3 * 33] * F8_SW); o.y = pk4_f8(s[4 * 33] * F8_SW, s[5 * 33] * F8_SW, s[6 * 33] * F8_SW, s[7 * 33] * F8_SW);
        *(u32x2*)(x.dst + (size_t)n * x.ldd + 8 * cch) = o; }
    asm volatile("s_waitcnt lgkmcnt(0)" ::: "memory");
}
constexpr int NMOE_ITEMS = 2 * NEXP * 512;
__device__ __forceinline__ void moe_xp_item(const Params& p, int r, XpItem& x) {
    constexpr int I_E = 512; unsigned char* ws = p.ws;
    if (r < 2 * NEXP * I_E) {
        const int which = r / (NEXP * I_E); r -= which * NEXP * I_E; const int e = r / I_E, q = r % I_E, kb = q / 16, nb = q % 16, f0 = 32 * nb;
        x.src = p.in[which ? I_W3 : I_W1] + (size_t)e * D * FE + (size_t)(64 * kb) * FE + f0; x.ldw = FE;
        x.dst = ws + WS_W13_T + ((size_t)e * 1024 + 256 * (f0 >> 7) + 128 * which + (f0 & 127)) * D + 64 * kb; x.ldd = D; x.f8 = 1;
    } else { r -= 2 * NEXP * I_E; const int e = r / I_E, q = r % I_E, kb = q / 64, nb = q % 64;
        x.src = p.in[I_W2] + (size_t)e * FE * D + (size_t)(64 * kb) * D + 32 * nb; x.ldw = D;
        x.dst = ws + WS_W2_T + ((size_t)e * D + 32 * nb) * FE + 64 * kb; x.ldd = FE; x.f8 = 1; }
}
__device__ __forceinline__ void p0_prologue(const Params& p, LAS unsigned char* lds, int gw, int ngw, int wave, int lane) {
    unsigned char* ws = p.ws;
    LAS float* scr = (LAS float*)(lds + wave * 16384);
    const int blk = gw >> 3, nada = blk < (32 * ADA_EARLY - 512) ? 3 : 2;
    if (wave < nada) { const int idx = wave * 256 + blk; p0_mod_unit(p.in[I_C], p.in[I_ADAW], (float*)(ws + WS_MODP), (idx / ADA_EARLY) * 64 + idx % ADA_EARLY, lane); }
    if (gw < 8 * 128) { const int t = gw & 127; const float* wsrc = p.in[I_WS] + (size_t)gw * 128 + 2 * lane; float w0 = wsrc[0], w1 = wsrc[1];
        if (t < 64 && lane >= 32) { w0 = 0.f; w1 = 0.f; }
        ((unsigned*)(ws + WS_WSB))[gw * 64 + lane] = pk2(w0, w1); }
    for (int it = gw; it < 48 * 32; it += ngw) {
        const int col = it >> 5, k = 64 * (it & 31) + lane;
        float w = 0.f;
        if (col < 4) w = p.in[I_WGRP][k * 4 + col];
        else if (col < 36) w = p.in[I_WEXP][(size_t)((col - 4) >> 3) * D * 8 + (size_t)k * 8 + ((col - 4) & 7)];
        const unsigned hi = f2bf(w), lo = f2bf(w - __uint_as_float(hi << 16));
        bf16_t* wrt = (bf16_t*)(ws + WS_WRT);
        wrt[col * D + k] = (bf16_t)hi; wrt[48 * D + col * D + k] = (bf16_t)lo;
    }
    constexpr int I_IN = 32 * 288, I_A = 16 * 64, I_O = 32 * 64, I_E = 512;
    constexpr int NITEMS = I_IN;
    if (wave >= nada) for (int j = wave - nada; j < NITEMS / 256; j += 8 - nada) {
        int r = blk + 256 * j;
        if (r < I_IN) { const int kb = r / 288, nb = r % 288; int drow = 32 * nb;
            if (drow >= 5120) { const int c = drow - 5120, which = c >> 11, cc = c & 2047; drow = 5120 + 256 * (cc >> 7) + 128 * which + (cc & 127); }
            p0_amax_item(p.in[I_WIN] + (size_t)(64 * kb) * NCOLS + 32 * nb, NCOLS, (unsigned*)(ws + WS_COLMAX) + drow, lane); }
    }
    if (wave >= nada) for (int j = wave - nada; j < I_O / 256; j += 8 - nada) { const int it = blk + 256 * j, kb = it >> 6, nb = it & 63;
        p0_amax_item(p.in[I_WOUT] + (size_t)(64 * kb) * D + 32 * nb, D, (unsigned*)(ws + WS_COLMAX_O) + 32 * nb, lane); }
}
__device__ __forceinline__ void p1_norm1(const Params& p, LAS unsigned char* lds, int blk, int tid, int wave, int lane) {
    unsigned char* ws = p.ws; const float* modp = (const float*)(ws + WS_MODP); float* mod = (float*)(ws + WS_MOD);
    LAS float* A1 = (LAS float*)lds; LAS float* S1 = A1 + D;
    const int bb = blk >> 7;
    for (int k = tid; k < D; k += NTHREADS) {
        float sh = p.in[I_ADAB][k], sc = p.in[I_ADAB][D + k];
        for (int q = 0; q < 32; ++q) { sh += modp[(size_t)(q * 2 + bb) * NMOD + k]; sc += modp[(size_t)(q * 2 + bb) * NMOD + D + k]; }
        A1[k] = p.in[I_N1G][k] * (1.f + sc); S1[k] = sh;
    }
    __syncthreads();
    LAS float* scr = (LAS float*)(lds + 16384 + wave * 16384);
    for (int it = blk * NWAVES + wave; it < 32 * 288; it += 256 * NWAVES) {
        const int kb = it / 288, nb = it % 288; int drow = 32 * nb;
        if (drow >= 5120) { const int c = drow - 5120, which = c >> 11, cc = c & 2047; drow = 5120 + 256 * (cc >> 7) + 128 * which + (cc & 127); }
        p1_quant_item(p.in[I_WIN] + (size_t)(64 * kb) * NCOLS + 32 * nb, NCOLS, ws + WS_WIN_T + (size_t)drow * D + 64 * kb, D, (const unsigned*)(ws + WS_COLMAX) + drow,
                      kb == 0 ? (float*)(ws + WS_CS) + drow : (float*)nullptr, scr, lane);
    }
    for (int it = blk * NWAVES + wave; it < 32 * 64; it += 256 * NWAVES) { const int kb = it >> 6, nb = it & 63;
        p1_quant_item(p.in[I_WOUT] + (size_t)(64 * kb) * D + 32 * nb, D, ws + WS_WOUT_T + (size_t)(32 * nb) * D + 64 * kb, D, (const unsigned*)(ws + WS_COLMAX_O) + 32 * nb,
                      kb == 0 ? (float*)(ws + WS_CSO) + 32 * nb : (float*)nullptr, scr, lane);
    }
    const float* x = p.in[I_X]; unsigned char* H = ws + WS_H; float* hsc = (float*)(ws + WS_HSC);
    for (int i = 0; i < 8; i += 2) {
        const int row = blk * 64 + wave * 8 + i;
        const f32x4* xr = (const f32x4*)(x + (size_t)row * D) + lane;
        f32x4 v[2][8]; float ss[2] = {0.f, 0.f};
#pragma unroll
        for (int r = 0; r < 2; ++r)
#pragma unroll
            for (int j = 0; j < 8; ++j) v[r][j] = __builtin_nontemporal_load(xr + (size_t)r * (D / 4) + 64 * j);
#pragma unroll
        for (int r = 0; r < 2; ++r)
#pragma unroll
            for (int j = 0; j < 8; ++j) ss[r] += (v[r][j].x * v[r][j].x + v[r][j].y * v[r][j].y) + (v[r][j].z * v[r][j].z + v[r][j].w * v[r][j].w);
#pragma unroll
        for (int r = 0; r < 2; ++r) {
            const float rstd = rsqrtf(wave_sum(ss[r]) * (1.f / D) + EPS);
            unsigned* o = (unsigned*)(H + (size_t)(row + r) * D) + lane;
            float am = 0.f;
#pragma unroll
            for (int j = 0; j < 8; ++j) { const f32x4 a = *(const LAS f32x4*)(A1 + 256 * j + 4 * lane), s = *(const LAS f32x4*)(S1 + 256 * j + 4 * lane);
                v[r][j] = v[r][j] * rstd * a + s; am = fmaxf(fmaxf(am, fmaxf(fabsf(v[r][j].x), fabsf(v[r][j].y))), fmaxf(fabsf(v[r][j].z), fabsf(v[r][j].w))); }
            am = wave_max(am); const float sq = am > 0.f ? 127.f / am : 0.f;
            if (lane == 0) hsc[row + r] = am * (1.f / 127.f);
#pragma unroll
            for (int j = 0; j < 8; ++j) { const f32x4 h = v[r][j] * sq + I8MAGIC;
                o[64 * j] = pack4_i8(__float_as_uint(h.x), __float_as_uint(h.y), __float_as_uint(h.z), __float_as_uint(h.w)); }
        }
    }
    __syncthreads();
}
typedef short bf16x8_t __attribute__((ext_vector_type(8)));
typedef short bf16x4_t __attribute__((ext_vector_type(4)));
__device__ __forceinline__ void p3_gmlp(const Params& p, LAS unsigned char* lds, int blk, int tid, int wave, int lane, size_t out_off, int gw) {
    unsigned char* ws = p.ws; bf16_t* U = (bf16_t*)(ws + WS_U); const bf16_t* V = (const bf16_t*)(ws + WS_V);
    const int tb0 = (blk >> 1) * 128, gh = blk & 1, l15 = lane & 15, lg = lane >> 4;
    LAS float* st = (LAS float*)lds;
    LAS unsigned char* XT = lds + 1024;
    LAS unsigned char* WL = lds + 1024 + 34816;
    for (int i0 = 0; i0 < 16; i0 += 8) {
        u32x4 raw[8][2];
#pragma unroll
        for (int i = 0; i < 8; ++i) { const u32x4* vp = (const u32x4*)(V + (size_t)(tb0 + 16 * wave + i0 + i) * 1024) + lane * 2; raw[i][0] = vp[0]; raw[i][1] = vp[1]; }
        float s[8], q[8];
#pragma unroll
        for (int i = 0; i < 8; ++i) { f32x4 x[4]; pg8::unpack8(raw[i][0], x[0], x[1]); pg8::unpack8(raw[i][1], x[2], x[3]);
            s[i] = ((x[0].x + x[0].y) + (x[0].z + x[0].w)) + ((x[1].x + x[1].y) + (x[1].z + x[1].w)) + ((x[2].x + x[2].y) + (x[2].z + x[2].w)) + ((x[3].x + x[3].y) + (x[3].z + x[3].w)); }
#pragma unroll
        for (int o = 32; o > 0; o >>= 1)
#pragma unroll
            for (int i = 0; i < 8; ++i) s[i] += __shfl_xor(s[i], o, 64);
#pragma unroll
        for (int i = 0; i < 8; ++i) { f32x4 x[4]; pg8::unpack8(raw[i][0], x[0], x[1]); pg8::unpack8(raw[i][1], x[2], x[3]); const float mean = s[i] * (1.f / 1024.f); s[i] = mean; q[i] = 0.f;
#pragma unroll
            for (int j = 0; j < 4; ++j) { const f32x4 d = x[j] - mean; q[i] += (d.x * d.x + d.y * d.y) + (d.z * d.z + d.w * d.w); } }
#pragma unroll
        for (int o = 32; o > 0; o >>= 1)
#pragma unroll
            for (int i = 0; i < 8; ++i) q[i] += __shfl_xor(q[i], o, 64);
#pragma unroll
        for (int i = 0; i < 8; ++i) if (lane == 0) { st[2 * (16 * wave + i0 + i)] = s[i]; st[2 * (16 * wave + i0 + i) + 1] = rsqrtf(q[i] * (1.f / 1024.f) + EPS); }
    }
    __syncthreads();
    const float* lng = p.in[I_LNG]; const float* lnb = p.in[I_LNB]; const float* w_s = p.in[I_WS]; const float* b_s = p.in[I_BS];
    LAS float* scr = (LAS float*)(lds + 77824 + wave * 8448);
    int xk = 0; bool xpend = false; XpItem xi; xi.src = nullptr; xi.dst = nullptr; xi.ldw = 0; xi.ldd = 0; xi.f8 = 1; float xr[32];
#pragma unroll
    for (int q = 0; q < 32; ++q) xr[q] = 0.f;
    for (int gi = 0; gi < 4; ++gi) {
        const int g = gh * 4 + gi;
#pragma unroll
        for (int i = 0; i < 4; ++i) {
            const int q = tid + 512 * i, s = q & 127, cch = q >> 7;
            const u32x4 raw = *(const u32x4*)(V + (size_t)(tb0 + s) * 1024 + 128 * g + 8 * cch);
            f32x4 x0, x1; pg8::unpack8(raw, x0, x1);
            const float mean = st[2 * s], rstd = st[2 * s + 1];
            const f32x4 g0 = *(const f32x4*)(lng + 128 * g + 8 * cch), g1 = *(const f32x4*)(lng + 128 * g + 8 * cch + 4), b0 = *(const f32x4*)(lnb + 128 * g + 8 * cch), b1 = *(const f32x4*)(lnb + 128 * g + 8 * cch + 4);
            x0 = (x0 - mean) * rstd * g0 + b0; x1 = (x1 - mean) * rstd * g1 + b1;
            LAS bf16_t* xp = (LAS bf16_t*)(XT + (8 * cch) * 272 + 2 * s);
            xp[0 * 136] = (bf16_t)f2bf(x0.x); xp[1 * 136] = (bf16_t)f2bf(x0.y); xp[2 * 136] = (bf16_t)f2bf(x0.z); xp[3 * 136] = (bf16_t)f2bf(x0.w);
            xp[4 * 136] = (bf16_t)f2bf(x1.x); xp[5 * 136] = (bf16_t)f2bf(x1.y); xp[6 * 136] = (bf16_t)f2bf(x1.z); xp[7 * 136] = (bf16_t)f2bf(x1.w);
        }
#pragma unroll
        for (int i = 0; i < 4; ++i) {
            const int q = tid + 512 * i, t = q >> 4, c16 = q & 15;
            *(LAS u32x4*)(WL + t * 272 + 16 * c16) = *(const u32x4*)(ws + WS_WSB + (size_t)(g * 128 + t) * 256 + 16 * c16);
        }
        __syncthreads();
        if (xpend) { xp_finish(xi, lane, xr, scr); xpend = false; }
        if (xk < GMLP_ITEMS) { moe_xp_item(p, gw * GMLP_ITEMS + xk, xi); xp_issue(xi, lane, xr); ++xk; xpend = true; }
        f32x4 acc[8];
#pragma unroll
        for (int cb = 0; cb < 8; ++cb) acc[cb] = (f32x4){0.f, 0.f, 0.f, 0.f};
        const int nks = (wave < 4) ? 2 : 4;
        for (int ks = 0; ks < nks; ++ks) {
            const bf16x8_t bfrag = *(const LAS bf16x8_t*)(WL + (16 * wave + l15) * 272 + (32 * ks + 8 * lg) * 2);
#pragma unroll
            for (int cb = 0; cb < 8; ++cb) { const bf16x8_t afrag = *(const LAS bf16x8_t*)(XT + (16 * cb + l15) * 272 + (32 * ks + 8 * lg) * 2);
                acc[cb] = __builtin_amdgcn_mfma_f32_16x16x32_bf16(afrag, bfrag, acc[cb], 0, 0, 0); }
        }
        const int t = 16 * wave + l15; const float bias = b_s[g * 128 + t];
        bf16_t* up = U + (size_t)(tb0 + t) * 1024 + 128 * g + 4 * lg; unsigned char* ya = ws + WS_YA8 + (size_t)(tb0 + t) * 1024 + 128 * g + 4 * lg;
#pragma unroll
        for (int cb = 0; cb < 8; ++cb) { const u32x2 uu = *(const u32x2*)(up + 16 * cb);
            const float u0 = __uint_as_float(uu.x << 16), u1 = __uint_as_float(uu.x & 0xffff0000u), u2 = __uint_as_float(uu.y << 16), u3 = __uint_as_float(uu.y & 0xffff0000u);
            *(unsigned*)(ya + 16 * cb) = pk4_f8(F8_SY * u0 * (acc[cb].x + bias), F8_SY * u1 * (acc[cb].y + bias), F8_SY * u2 * (acc[cb].z + bias), F8_SY * u3 * (acc[cb].w + bias)); }
        if (xpend) { xp_finish(xi, lane, xr, scr); xpend = false; }
        if (xk < GMLP_ITEMS) { moe_xp_item(p, gw * GMLP_ITEMS + xk, xi); xp_issue(xi, lane, xr); ++xk; xpend = true; }
        __syncthreads();
    }
    if (xpend) xp_finish(xi, lane, xr, scr);
    for (; xk < GMLP_ITEMS; ++xk) { moe_xp_item(p, gw * GMLP_ITEMS + xk, xi); xp_issue(xi, lane, xr); xp_finish(xi, lane, xr, scr); }
}
constexpr int XPG_DONE = 2048 * GMLP_ITEMS;
constexpr int XP3_W13 = 0;
constexpr int NW13_ITEMS = XP3_W13 + 2 * 2048;
__device__ __forceinline__ void lds_dma16(const void* gsrc, unsigned lds_dst) {
    unsigned keep;
    asm volatile("s_mov_b32 %0, m0\n\ts_mov_b32 m0, %2\n\ts_nop 0\n\tglobal_load_lds_dwordx4 %1, off\n\ts_mov_b32 m0, %0" : "=&s"(keep) : "v"(gsrc), "s"(lds_dst) : "memory");
}
__device__ __forceinline__ void p3_attn(const Params& p, LAS unsigned char* lds, int blk, int tid, int wave, int lane, size_t out_off, int gw, int ngw) {
    unsigned char* ws = p.ws; bf16_t* Q = (bf16_t*)(ws + WS_Q); const bf16_t* Kb = (const bf16_t*)(ws + WS_K); const bf16_t* VT = (const bf16_t*)(ws + WS_VT); const float* rel = p.in[I_REL];
    constexpr int TILE = 8192, STEPB = 4 * TILE;
    constexpr int QS_OFF = 2 * STEPB;
    constexpr int XS_OFF = QS_OFF + 16384;
    static_assert(XS_OFF + 8 * 8192 <= MISC_OFF, "attention LDS map");
    LAS float* bt2 = (LAS float*)(lds + MISC_OFF + 2048);
    const int l15 = lane & 15, lg = lane >> 4;
    const unsigned onew = ((l15 & 3) == 0) ? 0x3f803f80u : 0u;
    const bf16x8_t ones = __builtin_bit_cast(bf16x8_t, (u32x4){onew, onew, onew, onew});
    const int bh = (blk * 8) >> 6, cpb = (blk * 8) & 63, b = bh >> 4, h = bh & 15;
    __syncthreads();
    if (tid < 384) { int idx = 575 - tid; idx = idx > 512 ? 512 : idx; bt2[tid] = rel[h * 513 + idx] * LOG2E; }
    const float bfar = rel[h * 513 + 512] * LOG2E;
    const f32x4 farv = {bfar, bfar, bfar, bfar}, negv = {-1e30f, -1e30f, -1e30f, -1e30f};
    const int srow = tid >> 3, spc = (tid & 7) ^ (((tid >> 4) & 7) ^ (((tid >> 7) & 1) << 1));
    const bf16_t* gk = Kb + (size_t)(b * SEQ + srow) * 1024 + h * 64 + 8 * spc;
    const bf16_t* gv = VT + ((size_t)((b * 16 + h) * 64 + srow)) * 8192 + 8 * spc;
    const bf16_t* gq = Q + (size_t)(b * SEQ + cpb * 128 + 16 * wave + (lane >> 3)) * 1024 + h * 64;
    const int qpc0 = (lane & 7) ^ ((lane >> 4) & 7), qpc1 = (lane & 7) ^ ((((lane >> 3) + 8) >> 1) & 7);
    const unsigned wbase = (unsigned)wave * 1024u;
    int T = 0;
    for (int i = 0; i < 8; ++i) { const int j0 = 4 - (cpb + i); T += 5 - (j0 > 0 ? j0 : 0); }
    int li = 0, ljp = (4 - cpb) > 0 ? (4 - cpb) : 0, lbuf = 0;
#define AT_DMA() do { const int _kc = 2 * (cpb + li) - 8 + 2 * ljp; const unsigned _d = (unsigned)(lbuf * STEPB) + wbase; \
        lds_dma16(gk + (size_t)_kc * 64 * 1024, _d); lds_dma16(gk + (size_t)(_kc + 1) * 64 * 1024, _d + TILE); lds_dma16(gv + _kc * 64, _d + 2 * TILE); lds_dma16(gv + (_kc + 1) * 64, _d + 3 * TILE); \
        lbuf ^= 1; if (++ljp == 5) { ++li; const int _j0 = 4 - (cpb + li); ljp = _j0 > 0 ? _j0 : 0; } } while (0)
#define AT_QDMA(unit) do { const unsigned _d = (unsigned)QS_OFF + (unsigned)wave * 2048u; const bf16_t* _g = gq + (size_t)(unit) * 128 * 1024; \
        lds_dma16(_g + 8 * qpc0, _d); lds_dma16(_g + (size_t)8 * 1024 + 8 * qpc1, _d + 1024); } while (0)
    AT_QDMA(0);
    AT_DMA();
    asm volatile("s_waitcnt vmcnt(0)" ::: "memory");
    __builtin_amdgcn_s_barrier();
    asm volatile("" ::: "memory");
    const int xv0 = (l15 >> 1) & 7, rl = 8 * (l15 >> 2) + (l15 & 3);
    const int xk0 = ((4 * ((l15 >> 2) & 1)) + ((l15 >> 1) & 1)) ^ (2 * ((l15 >> 3) & 1));
    int kofs[2][2], vofs[2][2];
#pragma unroll
    for (int e = 0; e < 2; ++e)
#pragma unroll
        for (int ks = 0; ks < 2; ++ks) { kofs[e][ks] = rl * 128 + (((lg + 4 * ks) ^ (xk0 ^ (2 * e))) << 4); vofs[e][ks] = l15 * 128 + (((lg + 4 * ks) ^ (xv0 ^ (2 * e))) << 4); }
    const int ko0 = vofs[0][0], ko1 = vofs[0][1];
    int ci = 0, cjp = (4 - cpb) > 0 ? (4 - cpb) : 0, cbuf = 0;
    bf16_t* qp = Q + (size_t)(b * SEQ + cpb * 128 + 16 * wave + l15) * 1024 + h * 64;
    bf16x8_t qf0, qf1;
    f32x4 o[4], osum = {0.f, 0.f, 0.f, 0.f};
#pragma unroll
    for (int db = 0; db < 4; ++db) o[db] = (f32x4){0.f, 0.f, 0.f, 0.f};
    float m = -1e30f;
    const int iq = 16 * (wave & 3) + l15;
    bool ufirst = true;
    int xit = gw; bool xp0 = false, xp1 = false; XpItem x0, x1; x0.src = nullptr; x0.dst = nullptr; x0.ldw = 0; x0.ldd = 0; x0.f8 = 0; x1 = x0;
    auto xdecode = [&](int r, XpItem& x) {
        if (r < XP3_W13) { const int it64 = XPG_DONE + (r >> 1), hk = r & 1;
            const int which = it64 >> 14, rr = it64 & 16383, e = rr >> 9, q = rr & 511, kb = 2 * (q >> 4) + hk, nb = q & 15, f0 = 32 * nb;
            x.src = p.in[which ? I_W3 : I_W1] + (size_t)e * D * FE + (size_t)(32 * kb) * FE + f0; x.ldw = FE;
            x.dst = ws + WS_W13_T + ((size_t)e * 1024 + 256 * (f0 >> 7) + 128 * which + (f0 & 127)) * D + 32 * kb; x.ldd = D; x.f8 = 1; }
        else { const int r2 = r - XP3_W13;
            { const int which = r2 >> 11, q = r2 & 2047, kb = q >> 6, nb = q & 63;
                x.src = p.in[which ? I_WB : I_WA] + (size_t)(32 * kb) * D + 32 * nb; x.ldw = D;
                x.dst = ws + (which ? WS_WB_T : WS_WA_T) + (size_t)(32 * nb) * 1024 + 32 * kb; x.ldd = 1024; x.f8 = 1; } } };
    auto xissue = [&](const XpItem& x, int slot) {
        const unsigned d = (unsigned)XS_OFF + (unsigned)wave * 8192u + (unsigned)slot * 4096u; const float* g = x.src + (size_t)(lane >> 3) * x.ldw + 4 * (lane & 7);
#pragma unroll
        for (int i2 = 0; i2 < 4; ++i2) lds_dma16(g + (size_t)(8 * i2) * x.ldw, d + 1024u * i2); };
    auto xfinish = [&](const XpItem& x, int slot) {
        const LAS float* s = (const LAS float*)(lds + XS_OFF + wave * 8192 + slot * 4096) + (lane & 31);
#pragma unroll
        for (int r = 0; r < 2; ++r) { const int cch = 2 * r + (lane >> 5); const LAS float* sp = s + (8 * cch) * 32;
            if (x.f8) { u32x2 ov; ov.x = pk4_f8(sp[0 * 32] * F8_SW, sp[1 * 32] * F8_SW, sp[2 * 32] * F8_SW, sp[3 * 32] * F8_SW); ov.y = pk4_f8(sp[4 * 32] * F8_SW, sp[5 * 32] * F8_SW, sp[6 * 32] * F8_SW, sp[7 * 32] * F8_SW);
                *(u32x2*)(x.dst + (size_t)(lane & 31) * x.ldd + 8 * cch) = ov; }
            else { u32x4 ov; ov.x = pk2(sp[0 * 32], sp[1 * 32]); ov.y = pk2(sp[2 * 32], sp[3 * 32]); ov.z = pk2(sp[4 * 32], sp[5 * 32]); ov.w = pk2(sp[6 * 32], sp[7 * 32]);
                *(u32x4*)(x.dst + (size_t)(lane & 31) * x.ldd + 16 * cch) = ov; } }
        asm volatile("s_waitcnt lgkmcnt(0)" ::: "memory"); };
    for (int t = 0; t < T; ++t) {
        if (ufirst) {
            const LAS unsigned char* qs = lds + QS_OFF + wave * 2048; qf0 = *(const LAS bf16x8_t*)(qs + ko0); qf1 = *(const LAS bf16x8_t*)(qs + ko1);
            asm volatile("s_waitcnt lgkmcnt(0)" ::: "memory");
            if (ci + 1 < 8) AT_QDMA(ci + 1);
            ufirst = false; }
        const bool tile = li < 8;
        if (tile) AT_DMA();
        bool conv = false;
        if (t & 1) { if (xp1) { xfinish(x1, 1); xp1 = false; } if (xit < NW13_ITEMS) { xdecode(xit, x1); xissue(x1, 1); xp1 = true; xit += ngw; conv = true; } }
        else       { if (xp0) { xfinish(x0, 0); xp0 = false; } if (xit < NW13_ITEMS) { xdecode(xit, x0); xissue(x0, 0); xp0 = true; xit += ngw; conv = true; } }
        const int cp = cpb + ci, kc = 2 * cp - 8 + 2 * cjp, cw = 2 * cp + (wave >> 2);
        const LAS unsigned char* kb_ = lds + cbuf * STEPB; const LAS unsigned char* vb_ = kb_ + 2 * TILE;
        f32x4 s[8];
#pragma unroll
        for (int hf = 0; hf < 2; ++hf) {
            const int dc = cw - kc - hf;
            const LAS unsigned char* kt_ = kb_ + hf * TILE;
            if (dc >= 0 && dc <= 4) {
                const LAS float* bp = bt2 + (319 - dc * 64 - iq + 8 * lg);
#pragma unroll
                for (int kb = 0; kb < 4; ++kb) { const int ko = 32 * (kb >> 1) + 4 * (kb & 1); const f32x4 cin = {bp[ko], bp[ko + 1], bp[ko + 2], bp[ko + 3]};
                    const LAS unsigned char* kr = kt_ + (32 * (kb >> 1) + 4 * (kb & 1)) * 128;
                    const bf16x8_t a0 = *(const LAS bf16x8_t*)(kr + kofs[kb & 1][0]), a1 = *(const LAS bf16x8_t*)(kr + kofs[kb & 1][1]);
                    s[4 * hf + kb] = __builtin_amdgcn_mfma_f32_16x16x32_bf16(a0, qf0, cin, 0, 0, 0);
                    s[4 * hf + kb] = __builtin_amdgcn_mfma_f32_16x16x32_bf16(a1, qf1, s[4 * hf + kb], 0, 0, 0); }
            } else {
                const f32x4 cin = (dc >= 5 && dc <= 8) ? farv : negv;
#pragma unroll
                for (int kb = 0; kb < 4; ++kb) { const LAS unsigned char* kr = kt_ + (32 * (kb >> 1) + 4 * (kb & 1)) * 128;
                    const bf16x8_t a0 = *(const LAS bf16x8_t*)(kr + kofs[kb & 1][0]), a1 = *(const LAS bf16x8_t*)(kr + kofs[kb & 1][1]);
                    s[4 * hf + kb] = __builtin_amdgcn_mfma_f32_16x16x32_bf16(a0, qf0, cin, 0, 0, 0);
                    s[4 * hf + kb] = __builtin_amdgcn_mfma_f32_16x16x32_bf16(a1, qf1, s[4 * hf + kb], 0, 0, 0); }
            }
        }
        float lm = s[0].x;
#pragma unroll
        for (int kb = 0; kb < 8; ++kb) lm = fmaxf(lm, fmaxf(fmaxf(s[kb].x, s[kb].y), fmaxf(s[kb].z, s[kb].w)));
        if (__any(lm > m + 64.0f)) {
            float mx = fmaxf(lm, __shfl_xor(lm, 16)); mx = fmaxf(mx, __shfl_xor(mx, 32));
            const float mn = fmaxf(m, mx), alpha = __builtin_amdgcn_exp2f(m - mn); m = mn;
#pragma unroll
            for (int db = 0; db < 4; ++db) o[db] *= alpha;
            osum *= alpha;
        }
#pragma unroll
        for (int kb = 0; kb < 8; ++kb)
#pragma unroll
            for (int r = 0; r < 4; ++r) s[kb][r] = __builtin_amdgcn_exp2f(s[kb][r] - m);
#pragma unroll
        for (int hf = 0; hf < 2; ++hf) {
            const u32x4 pw0 = pg8::pack8(s[4 * hf + 0], s[4 * hf + 1]), pw1 = pg8::pack8(s[4 * hf + 2], s[4 * hf + 3]);
            const bf16x8_t pb0 = __builtin_bit_cast(bf16x8_t, pw0), pb1 = __builtin_bit_cast(bf16x8_t, pw1);
#pragma unroll
            for (int db = 0; db < 4; ++db) {
                const LAS unsigned char* vr = vb_ + hf * TILE + db * 2048;
                const bf16x8_t v0 = *(const LAS bf16x8_t*)(vr + vofs[db & 1][0]), v1 = *(const LAS bf16x8_t*)(vr + vofs[db & 1][1]);
                o[db] = __builtin_amdgcn_mfma_f32_16x16x32_bf16(v0, pb0, o[db], 0, 0, 0);
                o[db] = __builtin_amdgcn_mfma_f32_16x16x32_bf16(v1, pb1, o[db], 0, 0, 0);
            }
            osum = __builtin_amdgcn_mfma_f32_16x16x32_bf16(ones, pb0, osum, 0, 0, 0);
            osum = __builtin_amdgcn_mfma_f32_16x16x32_bf16(ones, pb1, osum, 0, 0, 0);
        }
        cbuf ^= 1;
        if (++cjp == 5) {
            const float inv = F8_SY / osum.x;
#pragma unroll
            for (int db = 0; db < 4; ++db) *(unsigned*)(ws + WS_YB8 + (size_t)(qp - Q) + 16 * db + 4 * lg) = pk4_f8(o[db].x * inv, o[db].y * inv, o[db].z * inv, o[db].w * inv);
            ++ci; const int j0 = 4 - (cpb + ci); cjp = j0 > 0 ? j0 : 0; ufirst = true;
            if (ci < 8) {
                qp += (size_t)128 * 1024;
#pragma unroll
                for (int db = 0; db < 4; ++db) o[db] = (f32x4){0.f, 0.f, 0.f, 0.f};
                osum = (f32x4){0.f, 0.f, 0.f, 0.f}; m = -1e30f;
            }
        }
        if (conv) asm volatile("s_waitcnt vmcnt(4) lgkmcnt(0)" ::: "memory"); else asm volatile("s_waitcnt vmcnt(0) lgkmcnt(0)" ::: "memory");
        __builtin_amdgcn_s_barrier();
        asm volatile("" ::: "memory");
        (void)tile;
    }
#undef AT_DMA
#undef AT_QDMA
    asm volatile("s_waitcnt vmcnt(0)" ::: "memory");
    if (xp0) xfinish(x0, 0);
    if (xp1) xfinish(x1, 1);
    for (; xit < NW13_ITEMS; xit += ngw) { xdecode(xit, x0); xissue(x0, 0); asm volatile("s_waitcnt vmcnt(0)" ::: "memory"); xfinish(x0, 0); }
}
__device__ __forceinline__ void p6_norm2_route(const Params& p, LAS unsigned char* lds, int blk, int tid, int wave, int lane, bool dry) {
    unsigned char* ws = p.ws; const float* mod = (const float*)(ws + WS_MOD);
    LAS float* A2 = (LAS float*)lds; LAS float* S2 = A2 + D; LAS float* rs = (LAS float*)(lds + 16384);
    LAS int* hist = (LAS int*)(lds + 16640); LAS int* base = hist + 32; LAS int* ent_e = base + 32; LAS int* ent_r = ent_e + 128; LAS float* ent_w = (LAS float*)(ent_r + 128);
    LAS float* part = (LAS float*)(lds + 32768);
    const int bb = blk >> 7, l15 = lane & 15, kg = lane >> 4;
    for (int k = tid; k < D; k += NTHREADS) { A2[k] = p.in[I_N2G][k] * (1.f + mod[bb * NMOD + 4 * D + k]); S2[k] = mod[bb * NMOD + 3 * D + k]; }
    if (tid < 32) hist[tid] = 0;
    const bf16_t* x1 = (const bf16_t*)(ws + WS_X1B); unsigned char* H2 = ws + WS_H;
    for (int i = 0; i < 8; i += 4) {
        const int r = wave * 8 + i; const u32x4* xr = (const u32x4*)(x1 + (size_t)(blk * 64 + r) * D) + lane; u32x4 raw[4][4];
#pragma unroll
        for (int q = 0; q < 4; ++q)
#pragma unroll
            for (int j = 0; j < 4; ++j) raw[q][j] = xr[(size_t)q * (D / 8) + 64 * j];
#pragma unroll
        for (int q = 0; q < 4; ++q) { float ss = 0.f;
#pragma unroll
            for (int j = 0; j < 4; ++j) { f32x4 v, w; pg8::unpack8(raw[q][j], v, w); ss += ((v.x * v.x + v.y * v.y) + (v.z * v.z + v.w * v.w)) + ((w.x * w.x + w.y * w.y) + (w.z * w.z + w.w * w.w)); }
            ss = wave_sum(ss);
            if (lane == 0) rs[r + q] = rsqrtf(ss * (1.f / D) + EPS); }
    }
    __syncthreads();
    {
        float rs4[4];
#pragma unroll
        for (int rb = 0; rb < 4; ++rb) rs4[rb] = rs[16 * rb + l15];
        f32x4 acc[4][3];
#pragma unroll
        for (int rb = 0; rb < 4; ++rb)
#pragma unroll
            for (int cb = 0; cb < 3; ++cb) acc[rb][cb] = (f32x4){0.f, 0.f, 0.f, 0.f};
        const bf16_t* wrt = (const bf16_t*)(ws + WS_WRT);
        for (int kh = 0; kh < 2; ++kh) {
            const int k0 = 256 * wave + 128 * kh + 32 * kg;
            u32x4 xr[4][4];
#pragma unroll
            for (int rb = 0; rb < 4; ++rb)
#pragma unroll
                for (int j = 0; j < 4; ++j) xr[rb][j] = *(const u32x4*)(x1 + (size_t)(blk * 64 + 16 * rb + l15) * D + k0 + 8 * j);
            unsigned f8w[4][8];
#pragma unroll
            for (int j = 0; j < 4; ++j) {
                const f32x4 a0 = *(const LAS f32x4*)(A2 + k0 + 8 * j), a1 = *(const LAS f32x4*)(A2 + k0 + 8 * j + 4), s0 = *(const LAS f32x4*)(S2 + k0 + 8 * j), s1 = *(const LAS f32x4*)(S2 + k0 + 8 * j + 4);
                bf16x8_t bh[3], bl[3];
#pragma unroll
                for (int cb = 0; cb < 3; ++cb) { bh[cb] = *(const bf16x8_t*)(wrt + (size_t)(16 * cb + l15) * D + k0 + 8 * j); bl[cb] = *(const bf16x8_t*)(wrt + (size_t)(48 + 16 * cb + l15) * D + k0 + 8 * j); }
#pragma unroll
                for (int rb = 0; rb < 4; ++rb) {
                    f32x4 x0, x1v; pg8::unpack8(xr[rb][j], x0, x1v);
                    const f32x4 h0 = x0 * rs4[rb] * a0 + s0, h1 = x1v * rs4[rb] * a1 + s1;
                    const u32x4 hw = pg8::pack8(h0, h1);
                    f8w[rb][2 * j] = pk4_f8(h0.x * F8_SH2, h0.y * F8_SH2, h0.z * F8_SH2, h0.w * F8_SH2); f8w[rb][2 * j + 1] = pk4_f8(h1.x * F8_SH2, h1.y * F8_SH2, h1.z * F8_SH2, h1.w * F8_SH2);
                    f32x4 c0, c1; pg8::unpack8(hw, c0, c1);
                    const u32x4 lw = pg8::pack8(h0 - c0, h1 - c1);
                    const bf16x8_t hi = __builtin_bit_cast(bf16x8_t, hw), lo = __builtin_bit_cast(bf16x8_t, lw);
#pragma unroll
                    for (int cb = 0; cb < 3; ++cb) {
                        acc[rb][cb] = __builtin_amdgcn_mfma_f32_16x16x32_bf16(hi, bh[cb], acc[rb][cb], 0, 0, 0);
                        acc[rb][cb] = __builtin_amdgcn_mfma_f32_16x16x32_bf16(lo, bh[cb], acc[rb][cb], 0, 0, 0);
                        acc[rb][cb] = __builtin_amdgcn_mfma_f32_16x16x32_bf16(hi, bl[cb], acc[rb][cb], 0, 0, 0);
                    }
                }
            }
#pragma unroll
            for (int rb = 0; rb < 4; ++rb) { unsigned char* hp = H2 + (size_t)(blk * 64 + 16 * rb + l15) * D + k0;
                *(u32x4*)hp = (u32x4){f8w[rb][0], f8w[rb][1], f8w[rb][2], f8w[rb][3]}; *(u32x4*)(hp + 16) = (u32x4){f8w[rb][4], f8w[rb][5], f8w[rb][6], f8w[rb][7]}; }
        }
#pragma unroll
        for (int rb = 0; rb < 4; ++rb)
#pragma unroll
            for (int cb = 0; cb < 3; ++cb)
#pragma unroll
                for (int rr = 0; rr < 4; ++rr) part[(wave * 64 + 16 * rb + 4 * kg + rr) * 48 + 16 * cb + l15] = acc[rb][cb][rr];
    }
    __syncthreads();
    for (int q = tid; q < 64 * 48; q += NTHREADS) { float s = 0.f;
#pragma unroll
        for (int w = 0; w < 8; ++w) s += part[w * 64 * 48 + q];
        part[q] = s; }
    __syncthreads();
    if (tid < 64) {
        const LAS float* lg = part + tid * 48;
        const float g0 = lg[0], g1 = lg[1], g2 = lg[2], g3 = lg[3];
        int g = 0; float gm = g0;
        if (g1 > gm) { gm = g1; g = 1; } if (g2 > gm) { gm = g2; g = 2; } if (g3 > gm) { gm = g3; g = 3; }
        const float gweight = 1.f / (expf(g0 - gm) + expf(g1 - gm) + expf(g2 - gm) + expf(g3 - gm));
        const LAS float* el = lg + 4 + 8 * g;
        int i1 = 0; float m1 = el[0];
        for (int q = 1; q < 8; ++q) { const float v = el[q]; if (v > m1) { m1 = v; i1 = q; } }
        int i2 = -1; float m2 = -3.0e38f;
        for (int q = 0; q < 8; ++q) { const float v = el[q]; if (q != i1 && v > m2) { m2 = v; i2 = q; } }
        const float t = expf(m2 - m1), p1 = 1.f / (1.f + t), p2 = t / (1.f + t);
        const int e1 = g * 8 + i1, e2 = g * 8 + i2;
        ent_e[2 * tid] = e1; ent_r[2 * tid] = __hip_atomic_fetch_add(hist + e1, 1, __ATOMIC_RELAXED, __HIP_MEMORY_SCOPE_WORKGROUP); ent_w[2 * tid] = gweight * p1;
        ent_e[2 * tid + 1] = e2; ent_r[2 * tid + 1] = __hip_atomic_fetch_add(hist + e2, 1, __ATOMIC_RELAXED, __HIP_MEMORY_SCOPE_WORKGROUP); ent_w[2 * tid + 1] = gweight * p2;
    }
    __syncthreads();
    unsigned* ctl = (unsigned*)(ws + WS_CTL);
    if (tid < 32) base[tid] = (hist[tid] && !dry) ? (int)__hip_atomic_fetch_add(ctl + CW_CNT + 64 * tid, (unsigned)hist[tid], __ATOMIC_RELAXED, __HIP_MEMORY_SCOPE_AGENT) : 0;
    __syncthreads();
    if (tid < 128 && !dry) {
        const int e = ent_e[tid], idx = base[e] + ent_r[tid], slot = (blk * 64 + (tid >> 1)) * 2 + (tid & 1);
        ((int*)(ws + WS_TOKLIST))[e * 16384 + idx] = slot; ((int*)(ws + WS_SLOTE))[slot] = e * 16384 + idx; ((float*)(ws + WS_ROWW))[e * 16384 + idx] = ent_w[tid];
    }
    __syncthreads();
}
__device__ __forceinline__ void p9_final(const Params& p, LAS unsigned char* lds, const MoeTab& T, int blk, int tid, int wave, int lane, bool build, size_t dry_off, unsigned char* dry_base) {
    unsigned char* ws = p.ws; const float* mod = (const float*)(ws + WS_MOD);
    if (build) build_tables((const unsigned*)(ws + WS_CTL), T, tid);
    const int bb = blk >> 7; const float* g2 = mod + bb * NMOD + 5 * D; const float* fg = p.in[I_FING];
    const unsigned char* YS = (const unsigned char*)(ws + WS_YS); const int* slote = (const int*)(ws + WS_SLOTE);
    for (int i = 0; i < 8; ++i) {
        const int row = blk * 64 + wave * 8 + i;
        const int se0 = slote[2 * row], se1 = slote[2 * row + 1];
        const size_t p0 = (size_t)T.tb[se0 >> 14] * 256 + (se0 & 16383), p1 = (size_t)T.tb[se1 >> 14] * 256 + (se1 & 16383);
        f32x4* xr = (f32x4*)(p.out + (size_t)row * D) + lane; const u32x2* x1r = (const u32x2*)((const bf16_t*)(ws + WS_X1B) + (size_t)row * D) + lane;
        const unsigned* y0 = (const unsigned*)(YS + p0 * D) + lane; const unsigned* y1 = (const unsigned*)(YS + p1 * D) + lane;
        f32x4 v[8]; float ss = 0.f;
#pragma unroll
        for (int j = 0; j < 8; ++j) { const u32x2 xw = __builtin_nontemporal_load(x1r + 64 * j); const f32x4 xv = {__uint_as_float(xw.x << 16), __uint_as_float(xw.x & 0xffff0000u), __uint_as_float(xw.y << 16), __uint_as_float(xw.y & 0xffff0000u)}; const unsigned a = __builtin_nontemporal_load(y0 + 64 * j), b = __builtin_nontemporal_load(y1 + 64 * j); const f32x4 gg = *(const f32x4*)(g2 + 256 * j + 4 * lane) * (1.0f / 64.0f);
            f32x4 ys; ys.x = __builtin_amdgcn_cvt_f32_fp8(a, 0) + __builtin_amdgcn_cvt_f32_fp8(b, 0); ys.y = __builtin_amdgcn_cvt_f32_fp8(a, 1) + __builtin_amdgcn_cvt_f32_fp8(b, 1);
            ys.z = __builtin_amdgcn_cvt_f32_fp8(a, 2) + __builtin_amdgcn_cvt_f32_fp8(b, 2); ys.w = __builtin_amdgcn_cvt_f32_fp8(a, 3) + __builtin_amdgcn_cvt_f32_fp8(b, 3);
            v[j] = xv + gg * ys; ss += (v[j].x * v[j].x + v[j].y * v[j].y) + (v[j].z * v[j].z + v[j].w * v[j].w); }
        const float rstd = rsqrtf(wave_sum(ss) * (1.f / D) + EPS);
        f32x4* xo = dry_base ? (f32x4*)(dry_base + dry_off + (size_t)row * D * 4) + lane : xr;
#pragma unroll
        for (int j = 0; j < 8; ++j) { const f32x4 f = *(const f32x4*)(fg + 256 * j + 4 * lane); xo[64 * j] = v[j] * rstd * f; }
    }
}

__device__ __forceinline__ void rowquant2048(const bf16_t* src, unsigned char* dst, float* step, int gw, int lane) {
    for (int i = 0; i < 8; i += 4) {
        const int row = gw * 8 + i; u32x4 raw[4][4];
#pragma unroll
        for (int r = 0; r < 4; ++r)
#pragma unroll
            for (int j = 0; j < 4; ++j) raw[r][j] = *((const u32x4*)(src + (size_t)(row + r) * D) + lane + 64 * j);
#pragma unroll
        for (int r = 0; r < 4; ++r) {
            f32x4 v[4][2]; float am = 0.f;
#pragma unroll
            for (int j = 0; j < 4; ++j) { pg8::unpack8(raw[r][j], v[j][0], v[j][1]);
#pragma unroll
                for (int h = 0; h < 2; ++h) am = fmaxf(fmaxf(am, fmaxf(fabsf(v[j][h].x), fabsf(v[j][h].y))), fmaxf(fabsf(v[j][h].z), fabsf(v[j][h].w))); }
            am = wave_max(am); const float sq = am > 0.f ? 127.f / am : 0.f;
            if (lane == 0) step[row + r] = am * (1.f / 127.f);
#pragma unroll
            for (int j = 0; j < 4; ++j) { const f32x4 a = v[j][0] * sq + I8MAGIC, b = v[j][1] * sq + I8MAGIC;
                u32x2 o; o.x = pack4_i8(__float_as_uint(a.x), __float_as_uint(a.y), __float_as_uint(a.z), __float_as_uint(a.w)); o.y = pack4_i8(__float_as_uint(b.x), __float_as_uint(b.y), __float_as_uint(b.z), __float_as_uint(b.w));
                *((u32x2*)(dst + (size_t)(row + r) * D) + lane + 64 * j) = o; }
        }
    }
}

__device__ __forceinline__ void xq_issue(const XpItem& x, int lane, f32x4 (&v)[8]) {
    const float* q = x.src + (size_t)(lane >> 3) * x.ldw + 4 * (lane & 7); const size_t step = (size_t)8 * x.ldw;
#pragma unroll
    for (int i = 0; i < 8; ++i) { v[i] = __builtin_nontemporal_load((const f32x4*)q); q += step; asm volatile("" : "+v"(q)); }
}
__device__ __forceinline__ void xq_finish(const XpItem& x, int lane, const f32x4 (&v)[8], LAS float* scr) {
#pragma unroll
    for (int i = 0; i < 8; ++i) { LAS float* d = scr + (8 * i + (lane >> 3)) * 33 + 4 * (lane & 7); d[0] = v[i].x; d[1] = v[i].y; d[2] = v[i].z; d[3] = v[i].w; }
    asm volatile("s_waitcnt lgkmcnt(0)" ::: "memory");
    const int cch = lane & 7;
#pragma unroll
    for (int j = 0; j < 4; ++j) { const int n = (lane >> 3) + 8 * j; const LAS float* s = scr + (8 * cch) * 33 + n;
        u32x2 o; o.x = pk4_f8(s[0 * 33] * F8_SW, s[1 * 33] * F8_SW, s[2 * 33] * F8_SW, s[3 * 33] * F8_SW); o.y = pk4_f8(s[4 * 33] * F8_SW, s[5 * 33] * F8_SW, s[6 * 33] * F8_SW, s[7 * 33] * F8_SW);
        *(u32x2*)(x.dst + (size_t)n * x.ldd + 8 * cch) = o; }
    asm volatile("s_waitcnt lgkmcnt(0)" ::: "memory");
}
__device__ __forceinline__ void xh_decode(const Params& p, int R, XpItem& x) {
    const int which = R >> 13, r = R & 8191, e = r >> 8, q = r & 255, kb = q >> 4, nb = q & 15, f0 = 32 * nb;
    x.src = p.in[which ? I_W3 : I_W1] + (size_t)e * D * FE + (size_t)(128 * kb) * FE + f0; x.ldw = FE;
    x.dst = p.ws + WS_W13_T + ((size_t)e * 1024 + 256 * (f0 >> 7) + 128 * which + (f0 & 127)) * D + 128 * kb; x.ldd = D; x.f8 = 1;
}
__device__ __forceinline__ void xh_decode_w2(const Params& p, int R, XpItem& x) {
    const int e = R >> 8, q = R & 255, kb = q >> 6, nb = q & 63;
    x.src = p.in[I_W2] + (size_t)e * FE * D + (size_t)(128 * kb) * D + 32 * nb; x.ldw = D;
    x.dst = p.ws + WS_W2_T + ((size_t)e * D + 32 * nb) * FE + 128 * kb; x.ldd = FE; x.f8 = 1;
}
__device__ __forceinline__ void xh_issue(const XpItem& x, int lane, f32x4 (&v)[16]) {
    const float* q = x.src + (size_t)(lane >> 3) * x.ldw + 4 * (lane & 7); const size_t step = (size_t)8 * x.ldw;
#pragma unroll
    for (int i = 0; i < 16; ++i) { v[i] = __builtin_nontemporal_load((const f32x4*)q); q += step; asm volatile("" : "+v"(q)); }
}
template <bool NT>
__device__ __forceinline__ void xh_finish(const XpItem& x, int lane, const f32x4 (&v)[16], LAS float* scr) {
#pragma unroll
    for (int i = 0; i < 16; ++i) { LAS float* d = scr + (8 * i + (lane >> 3)) * 33 + 4 * (lane & 7); d[0] = v[i].x; d[1] = v[i].y; d[2] = v[i].z; d[3] = v[i].w; }
    asm volatile("s_waitcnt lgkmcnt(0)" ::: "memory");
    const int cch = lane & 15;
#pragma unroll
    for (int j = 0; j < 8; ++j) { const int n = (lane >> 4) + 4 * j; const LAS float* s = scr + (8 * cch) * 33 + n;
        u32x2 o; o.x = pk4_f8(s[0 * 33] * F8_SW, s[1 * 33] * F8_SW, s[2 * 33] * F8_SW, s[3 * 33] * F8_SW); o.y = pk4_f8(s[4 * 33] * F8_SW, s[5 * 33] * F8_SW, s[6 * 33] * F8_SW, s[7 * 33] * F8_SW);
        if (NT) __builtin_nontemporal_store(o, (u32x2*)(x.dst + (size_t)n * x.ldd + 8 * cch)); else *(u32x2*)(x.dst + (size_t)n * x.ldd + 8 * cch) = o; }
    asm volatile("s_waitcnt lgkmcnt(0)" ::: "memory");
}
__device__ __forceinline__ void p2_w13_convert(const Params& p, LAS unsigned char* lds, int gw, int ngw, int wave, int lane) {
    LAS float* scr = (LAS float*)(lds + wave * 17408);
    XpItem x0, x1; x0.src = nullptr; x0.dst = nullptr; x0.ldw = 0; x0.ldd = 0; x0.f8 = 1; x1 = x0; f32x4 r0[16], r1[16];
    int it = gw; bool p0 = false, p1 = false;
#define P2C_ISSUE(X, R, P) do { if (it < NEXP * 512) { xh_decode(p, it, X); xh_issue(X, lane, R); P = true; it += ngw; } } while (0)
#define P2C_STEP(X, R, P) do { if (P) { xh_finish<true>(X, lane, R, scr); P = false; P2C_ISSUE(X, R, P); } } while (0)
    P2C_ISSUE(x0, r0, p0); P2C_ISSUE(x1, r1, p1);
    while (p0 || p1) { P2C_STEP(x0, r0, p0); P2C_STEP(x1, r1, p1); }
#undef P2C_ISSUE
#undef P2C_STEP
}

__device__ __forceinline__ void p7_w2_convert(const Params& p, LAS unsigned char* lds, int first, int stride, int wave, int lane) {
    LAS float* scr = (LAS float*)(lds + wave * 17408);
    XpItem x0, x1; x0.src = nullptr; x0.dst = nullptr; x0.ldw = 0; x0.ldd = 0; x0.f8 = 1; x1 = x0; f32x4 r0[16], r1[16];
    int it = first; bool p0 = false, p1 = false;
#define P7C_ISSUE(X, R, P) do { if (it < NEXP * 256) { xh_decode_w2(p, it, X); xh_issue(X, lane, R); P = true; it += stride; } } while (0)
#define P7C_STEP(X, R, P) do { if (P) { xh_finish<false>(X, lane, R, scr); P = false; P7C_ISSUE(X, R, P); } } while (0)
    P7C_ISSUE(x0, r0, p0); P7C_ISSUE(x1, r1, p1);
    while (p0 || p1) { P7C_STEP(x0, r0, p0); P7C_STEP(x1, r1, p1); }
#undef P7C_ISSUE
#undef P7C_STEP
}

__global__ void __launch_bounds__(NTHREADS, 2) mk_fwd(Params p) {
    extern __shared__ __attribute__((aligned(16))) unsigned char lds_raw[];
    LAS unsigned char* lds = (LAS unsigned char*)lds_raw;
    const int wave = __builtin_amdgcn_readfirstlane(threadIdx.x >> 6);
    const int G = gridDim.x, blk = blockIdx.x, gw = blk * NWAVES + wave, ngw = G * NWAVES;
#define FRESH_IDS const int lane = fresh_lane(), tid = wave * 64 + lane; (void)tid; (void)lane
    MoeTab T{(LAS int*)(lds + MISC_OFF + 64), (LAS int*)(lds + MISC_OFF + 256), (LAS int*)(lds + MISC_OFF + 512)};
    const int lo = p.ph_lo, hi = p.ph_hi;
    if (threadIdx.x < 4) ((LAS unsigned*)(lds + MISC_OFF))[threadIdx.x] = 0u;
    __syncthreads();
    XcdBarrier bar = xcd_barrier_post((unsigned*)(p.ws + WS_CTL) + CW_BAR, (volatile LAS unsigned*)(lds + MISC_OFF));
#define IN(k) (lo <= (k) && (k) < hi)
#define SEAM(k) do { if (IN(k) && IN((k) + 1)) xcd_barrier(bar); } while (0)
    if (IN(0)) { FRESH_IDS; p0_prologue(p, lds, gw, ngw, wave, lane); }
    SEAM(0);
    if (IN(1)) { FRESH_IDS; p1_norm1(p, lds, blk, tid, wave, lane); }
    SEAM(1);
    unsigned char* ws = p.ws;
    if (IN(2)) {
        pg8::SchedGrid S{(const char*)(ws + WS_H), (const char*)(ws + WS_WIN_T), D / 2, D / 2, 64, 36, G, blk};
        pg8::EpiProj E{(bf16_t*)(p.alt), (bf16_t*)(p.alt + (WS_V - WS_U)), (bf16_t*)(p.alt + (WS_Q - WS_U)), (bf16_t*)(p.alt + (WS_K - WS_U)), (bf16_t*)(p.alt + (WS_VT - WS_U)), (bf16_t*)p.altg,
                       (const float*)(ws + WS_HSC), (const float*)(ws + WS_CS)};
        const bool early = (blk >> 3) & 1;
        if (early) { FRESH_IDS; p2_ada_late(p, blk, wave, lane); p2_w13_convert(p, lds, gw, ngw, wave, lane); __syncthreads(); }
        pg8::gemm_phase(lds, D / 2, S, E, wave);
        if (!early) { FRESH_IDS; p2_ada_late(p, blk, wave, lane); p2_w13_convert(p, lds, gw, ngw, wave, lane); }
    }
    SEAM(2);
    if (IN(3)) { FRESH_IDS;
        if (blk < 96 && tid < 256) {
            const float* modp = (const float*)(ws + WS_MODP); const int j = blk * 256 + tid, b2 = j / NMOD, col = j % NMOD; float v = p.in[I_ADAB][col];
            for (int q = 0; q < 32; ++q) v += modp[(size_t)(q * 2 + b2) * NMOD + col];
            ((float*)(ws + WS_MOD))[j] = v; }
        p3_gmlp(p, lds, blk, tid, wave, lane, 0, gw); p3_attn(p, lds, blk, tid, wave, lane, 0, gw, ngw); }
    SEAM(3);
    if (IN(4)) {
        pg8::SchedBranch S{(const char*)(ws + WS_YA8), (const char*)(ws + WS_WA_T), (const char*)(ws + WS_YB8), (const char*)(ws + WS_WB_T), G, blk};
        pg8::EpiBranch E{(const unsigned short*)(ws + WS_G), (bf16_t*)(ws + WS_MIX), {}};
        pg8::gemm_phase(lds, 512, S, E, wave);
    }
    SEAM(4);
    if (IN(5)) {
        { FRESH_IDS; rowquant2048((const bf16_t*)(ws + WS_MIX), ws + WS_V, (float*)(ws + WS_SM), gw, lane); }
        xcd_barrier(bar);
        pg8::SchedGrid S{(const char*)(ws + WS_V), (const char*)(ws + WS_WOUT_T), D / 2, D / 2, 64, 8, G, blk};
        pg8::EpiOut E{p.in[I_X], (const float*)(ws + WS_MOD), (bf16_t*)(ws + WS_X1B), (const float*)(ws + WS_SM), (const float*)(ws + WS_CSO)};
        pg8::gemm_phase(lds, D / 2, S, E, wave);
    }
    SEAM(5);
    if (IN(6)) { FRESH_IDS; p6_norm2_route(p, lds, blk, tid, wave, lane, false); }
    SEAM(6);
    if (IN(7)) {
        { FRESH_IDS; build_tables((const unsigned*)(ws + WS_CTL), T, tid); }
        LAS int* ltok = (LAS int*)(lds + MISC_OFF + 4096);
        { FRESH_IDS; const int* toklist = (const int*)(ws + WS_TOKLIST);
          if (tid < 256) for (int i = 0; i < 3; ++i) { const int L = i * G + blk, rt = L >> 2; if (rt < T.tb[NEXP]) { const int e = T.rte[rt], r0 = (rt - T.tb[e]) * 256, nv = T.cn[e] - r0; ltok[i * 256 + tid] = toklist[e * 16384 + r0 + (tid < nv ? tid : 0)] >> 1; } }
          __syncthreads(); }
        pg8::SchedMoeUp S{(const char*)(ws + WS_H), (const char*)(ws + WS_W13_T), (const LAS int*)ltok, T, G, blk};
        pg8::EpiMoeUp E{ws + WS_ACT};
        pg8::gemm_phase(lds, D / 2, S, E, wave);
        {
            FRESH_IDS; const int U = 4 * T.tb[NEXP], fi = (U - 2 * G) > 0 ? (U - 2 * G) : 0;
            if (blk >= fi) { const int nidle = G - fi; p7_w2_convert(p, lds, (blk - fi) * NWAVES + wave, nidle * NWAVES, wave, lane); }
        }
    }
    SEAM(7);
    if (IN(8)) {
        if (lo == 8) { FRESH_IDS; build_tables((const unsigned*)(ws + WS_CTL), T, tid); }
        pg8::SchedMoeDown S{(const char*)(ws + WS_ACT), (const char*)(ws + WS_W2_T), T, G, blk};
        pg8::EpiMoeDown E{(const float*)(ws + WS_ROWW), (unsigned char*)(ws + WS_YS)};
        pg8::gemm_phase(lds, FE / 2, S, E, wave);
    }
    SEAM(8);
    if (IN(9)) { FRESH_IDS; p9_final(p, lds, T, blk, tid, wave, lane, lo == 9, 0, nullptr); }
#undef IN
#undef SEAM
}

extern "C" void kernel_launch(void* const* d_in, const int* in_sizes, int n_in, void* d_out, int out_size, void* d_ws, size_t ws_size, hipStream_t stream) {
    static int grid = 0;
    if (grid == 0) {
        if (n_in != 21 || out_size != M * D || ws_size < WS_END) { fprintf(stderr, "kernel_launch: unexpected problem (n_in %d out %d ws %zu)\n", n_in, out_size, ws_size); grid = -1; return; }
        if (hipFuncSetAttribute((const void*)mk_fwd, hipFuncAttributeMaxDynamicSharedMemorySize, LDS_BYTES) != hipSuccess) { fprintf(stderr, "kernel_launch: hipFuncSetAttribute failed\n"); grid = -1; return; }
        int dev = 0, cus = 0, per_cu = 0;
        if (hipGetDevice(&dev) != hipSuccess || hipDeviceGetAttribute(&cus, hipDeviceAttributeMultiprocessorCount, dev) != hipSuccess) { fprintf(stderr, "kernel_launch: device query failed\n"); grid = -1; return; }
        if (hipOccupancyMaxActiveBlocksPerMultiprocessor(&per_cu, (const void*)mk_fwd, NTHREADS, LDS_BYTES) != hipSuccess) per_cu = 0;
        (void)hipGetLastError();
        if (cus != 256 || per_cu < 1) { fprintf(stderr, "kernel_launch: built for 256 CUs with one resident workgroup each (got %d CUs, %d per CU)\n", cus, per_cu); grid = -1; return; }
        grid = 256;
    }
    if (grid < 0) return;
    unsigned char* ws = (unsigned char*)d_ws;
    (void)hipMemsetAsync(ws + WS_CTL, 0, CTL_BYTES, stream);
    Params p{};
    for (int i = 0; i < 21; ++i) p.in[i] = (const float*)d_in[i];
    p.out = (float*)d_out; p.ws = ws; p.alt = ws + WS_U; p.altg = (float*)(ws + WS_G);
    auto frame = [&](int lo, int hi) { p.ph_lo = lo; p.ph_hi = hi; hipLaunchKernelGGL(mk_fwd, dim3(grid), dim3(NTHREADS), LDS_BYTES, stream, p); };
    frame(0, 10);
}
```

```cpp
#include <hip/hip_runtime.h>
#include <cstdio>
#include <cstdint>

#ifndef GMLP_ITEMS
#define GMLP_ITEMS 0
#endif
constexpr int D = 2048, NB = 2, SEQ = 8192, M = NB * SEQ;
constexpr int NCOLS = 9216, GW = 1024, AW = 1024, NH = 16, HD = 64;
constexpr int NEXP = 32, FE = 512, NMOD = 6 * D;
constexpr int MAXRT = 160, MPAD = MAXRT * 256;
constexpr float EPS = 1e-6f;
constexpr float LOG2E = 1.4426950408889634f;
constexpr float QSCALE = 0.125f * LOG2E;

constexpr size_t MiB = 1u << 20;
constexpr size_t WS_CTL = 0, CTL_BYTES = 1 * MiB;
constexpr size_t WS_MODP = 1 * MiB;
constexpr size_t WS_MOD = 4 * MiB;
constexpr size_t WS_HSC = 4 * MiB + 512 * 1024;
constexpr size_t WS_CS = WS_HSC + 64 * 1024;
constexpr size_t WS_WSB = WS_HSC + 128 * 1024;
constexpr size_t WS_COLMAX_O = WS_CTL + 576 * 1024;
constexpr size_t WS_CSO = WS_HSC + 112 * 1024;
constexpr size_t WS_SM = WS_HSC;
constexpr size_t WS_COLMAX = WS_CTL + 512 * 1024;
constexpr size_t WS_TOKLIST = 5 * MiB;
constexpr size_t WS_SLOTE = 7 * MiB;
constexpr size_t WS_SLOTW = 7 * MiB + 256 * 1024;
constexpr size_t WS_WRT = 7 * MiB + 512 * 1024;
constexpr size_t WS_WIN_T = 8 * MiB;
constexpr size_t WS_WA_T = 44 * MiB;
constexpr size_t WS_WB_T = 48 * MiB;
constexpr size_t WS_WOUT_T = 52 * MiB;
constexpr size_t WS_W13_T = 60 * MiB;
constexpr size_t WS_W2_T = 188 * MiB;
constexpr size_t WS_H = 252 * MiB;
constexpr size_t WS_YA8 = WS_H, WS_YB8 = WS_H + 16 * MiB;
constexpr size_t WS_U = 316 * MiB;
constexpr size_t WS_V = 348 * MiB;
constexpr size_t WS_Q = 380 * MiB;
constexpr size_t WS_K = 412 * MiB;
constexpr size_t WS_VT = 444 * MiB;
constexpr size_t WS_G = 476 * MiB;
constexpr size_t WS_MIX = 604 * MiB;
constexpr size_t WS_END = 668 * MiB;
constexpr size_t WS_X1B = 540 * MiB;
constexpr size_t WS_ROWW = WS_MIX;
constexpr size_t WS_ACT = WS_U;
constexpr size_t WS_YS = WS_U + 40 * MiB;
static_assert(WS_YS + (size_t)MPAD * D * 2 <= WS_X1B && WS_X1B + (size_t)M * D * 2 <= WS_MIX && WS_X1B >= WS_G, "MoE buffers overlay the dead mixer buffers");
constexpr int CW_TMO = 0, CW_CODE = 1, CW_CNT = 1024  , CW_BAR = 4096;

typedef unsigned short bf16_t;
typedef float f32x4 __attribute__((ext_vector_type(4)));
typedef float f32x2 __attribute__((ext_vector_type(2)));
typedef unsigned u32x4 __attribute__((ext_vector_type(4)));
typedef unsigned u32x2 __attribute__((ext_vector_type(2)));
#define LAS __attribute__((address_space(3)))

__device__ __forceinline__ int fresh_lane() { int l; asm volatile("v_mbcnt_lo_u32_b32 %0, -1, 0\n\tv_mbcnt_hi_u32_b32 %0, -1, %0" : "=v"(l)); return l; }
__device__ __forceinline__ float bf2f(bf16_t v) { return __uint_as_float(((unsigned)v) << 16); }
__device__ __forceinline__ unsigned f2bf(float f) { unsigned u = __float_as_uint(f); return (u + 0x7fffu + ((u >> 16) & 1u)) >> 16; }
typedef __bf16 bf16x2v_t __attribute__((ext_vector_type(2)));
__device__ __forceinline__ unsigned pk2(float lo, float hi) { f32x2 v = {lo, hi}; bf16x2v_t b = __builtin_convertvector(v, bf16x2v_t); return __builtin_bit_cast(unsigned, b); }
__device__ __forceinline__ float clamp448(float x) { return __builtin_fminf(__builtin_fmaxf(x, -448.f), 448.f); }
__device__ __forceinline__ unsigned pk4_f8(float a, float b, float c, float d) {
    const unsigned w = __builtin_amdgcn_cvt_pk_fp8_f32(clamp448(a), clamp448(b), 0, false); return __builtin_amdgcn_cvt_pk_fp8_f32(clamp448(c), clamp448(d), w, true); }
constexpr float F8_SW = 256.f, F8_SH2 = 16.f, F8_SACT = 8.f, F8_SY = 16.f;
__device__ __forceinline__ float wave_max(float v) {
#pragma unroll
    for (int o = 32; o > 0; o >>= 1) v = fmaxf(v, __shfl_xor(v, o, 64));
    return v; }
constexpr float I8MAGIC = 12582912.f;
__device__ __forceinline__ unsigned pack4_i8(unsigned a, unsigned b, unsigned c, unsigned d) { return (a & 0xffu) | ((b & 0xffu) << 8) | ((c & 0xffu) << 16) | (d << 24); }
__device__ __forceinline__ float wave_sum(float v) {
#pragma unroll
    for (int o = 1; o < 64; o <<= 1) v += __shfl_xor(v, o);
    return v;
}
__device__ __forceinline__ float gelu_erf(float x) { return 0.5f * x * (1.0f + erff(x * 0.70710678118654752f)); }
__device__ __forceinline__ float sigmoidf_(float x) { return 1.0f / (1.0f + __expf(-x)); }
__device__ __forceinline__ float siluf_(float x) { return x / (1.0f + __expf(-x)); }

struct Params {
    const float* in[21];
    float* out;
    unsigned char* ws;
    int ph_lo, ph_hi;
    unsigned char* alt;
    float* altg;
};
enum { I_X = 0, I_C, I_ADAW, I_ADAB, I_N1G, I_WIN, I_LNG, I_LNB, I_WS, I_BS, I_REL, I_WA, I_WB, I_WOUT, I_N2G, I_WGRP, I_WEXP, I_W1, I_W3, I_W2, I_FING };

struct MoeTab { LAS int* tb; LAS int* cn; LAS int* rte; };
__device__ __forceinline__ void build_tables(const unsigned* ctl, const MoeTab& T, int tid) {
    if (tid == 0) {
        int acc = 0;
        for (int e = 0; e < NEXP; ++e) {
            const int c = (int)__hip_atomic_load(ctl + CW_CNT + 64 * e, __ATOMIC_RELAXED, __HIP_MEMORY_SCOPE_AGENT);
            T.cn[e] = c; T.tb[e] = acc; const int nt = (c + 255) >> 8;
            for (int t = 0; t < nt; ++t) T.rte[acc + t] = e;
            acc += nt;
        }
        T.tb[NEXP] = acc;
    }
    __syncthreads();
}

namespace pg8 {
typedef short bf16x8 __attribute__((ext_vector_type(8)));
typedef int i32x4 __attribute__((ext_vector_type(4)));
typedef int i32x8 __attribute__((ext_vector_type(8)));
constexpr int BM = 256, BK = 64, HALF = 128, HTB = HALF * BK * 2, STAGE_BYTES = 8 * HTB;
__device__ __forceinline__ int lds_byte(int r, int c) { const int st = (r >> 4) * 2 + (c >> 5), rr = r & 15, cc = c & 31, ob = rr * 64 + cc * 2; return st * 1024 + (ob ^ (((ob >> 9) & 1) << 5)); }
__device__ __forceinline__ void stage_rc(int b, int& R, int& C) { const int st = b / 1024, sb = b % 1024, swz = sb ^ (((sb >> 9) & 1) << 5); R = (st >> 1) * 16 + swz / 64; C = (st & 1) * 32 + (swz % 64) / 2; }
__device__ __forceinline__ int perm32(int rho) { const int n = rho >> 4, i = rho & 15; return 8 * (i >> 2) + 4 * n + (i & 3); }
struct Unit { const char* A; const char* B; int pm, pn, aux, aux2; };
typedef __bf16 bf16x2_t __attribute__((ext_vector_type(2)));
__device__ __forceinline__ unsigned cvt_pk_bf16(float lo, float hi) { f32x2 v = {lo, hi}; bf16x2_t b = __builtin_convertvector(v, bf16x2_t); return __builtin_bit_cast(unsigned, b); }
__device__ __forceinline__ f32x2 gelu_pk(f32x2 v) {
    const f32x2 av = __builtin_elementwise_abs(v), d = av * 0.2316418882f + 1.0f;
    f32x2 t; t.x = __builtin_amdgcn_rcpf(d.x); t.y = __builtin_amdgcn_rcpf(d.y);
    f32x2 q = t * 0.5307027145f + (-0.7265760135f); q = q * t + 0.7107068705f; q = q * t + (-0.142248368f); q = q * t + 0.127414796f; q = q * t;
    const f32x2 s = (v * v) * (-0.72134752044f);
    f32x2 e; e.x = __builtin_amdgcn_exp2f(s.x); e.y = __builtin_amdgcn_exp2f(s.y);
    const f32x2 m = v * (q * e), r = v - m;
    f32x2 o; o.x = v.x < 0.f ? m.x : r.x; o.y = v.y < 0.f ? m.y : r.y; return o;
}
__device__ __forceinline__ bool static_tile(int L, int nM, int nN, int& pm, int& pn) {
    const int nwg = nM * nN; if (L >= nwg) return false;
    int wgid = L; { const int q = nwg / 8, r = nwg % 8, xcd = wgid % 8, off = wgid / 8; wgid = (xcd < r ? xcd * (q + 1) : r * (q + 1) + (xcd - r) * q) + off; }
    const int nig = 8 * nN, gid = wgid / nig, fm = gid * 8, gsz = (nM - fm) < 8 ? (nM - fm) : 8;
    pm = fm + ((wgid % nig) % gsz); pn = (wgid % nig) / gsz; return true;
}

template <class Epi, class Sched>
__device__ __forceinline__ void gemm_phase(LAS unsigned char* lds, const int K, const Sched& S, const Epi& E, const int wid) {
    const int lane = fresh_lane(), tid = wid * 64 + lane, wr = wid >> 2, wc = wid & 3, fr = lane & 15, fq = lane >> 4;
    const int nt = K / BK;
    int R[2], C[2]; unsigned voffB[2];
#pragma unroll
    for (int i = 0; i < 2; ++i) { stage_rc(tid * 16 + i * 8192, R[i], C[i]); const int Rb = Epi::PERM ? ((R[i] & ~31) + perm32(R[i] & 31)) : R[i]; voffB[i] = (unsigned)(Rb * K + C[i]) * 2u; }
    const size_t kstep = (size_t)(BK * 2);
    const size_t hstep = (size_t)HALF * K * 2;
    const unsigned ldsw = (unsigned)wid * 1024u;
    const int aoff = lds_byte(wr * 64 + fr, fq * 8), boff = lds_byte(wc * 32 + fr, fq * 8);
#define PG8_SA(b, h) (((b) * 2 + (h)) * HTB)
#define PG8_SB(b, h) ((4 + (b) * 2 + (h)) * HTB)
#define PG8_STAGE(bufoff, gbase, voff) do { _Pragma("unroll") for (int _i = 0; _i < 2; ++_i) \
        __builtin_amdgcn_global_load_lds((const unsigned*)((const char*)(gbase) + (voff)[_i]), (LAS unsigned*)(lds + (bufoff) + ldsw + _i * 8192), 16, 0, 0); } while (0)
#define PG8_LDA(dst, b, h) do { if constexpr (Epi::MODE == 2) { _Pragma("unroll") for (int m = 0; m < 4; ++m) dst##8[m] = __builtin_shufflevector(*(const LAS i32x4*)(lds + PG8_SA(b, h) + aoff + m * 2048), *(const LAS i32x4*)(lds + PG8_SA(b, h) + aoff + m * 2048 + 1024), 0, 1, 2, 3, 4, 5, 6, 7); } \
        else { _Pragma("unroll") for (int m = 0; m < 4; ++m) _Pragma("unroll") for (int k = 0; k < 2; ++k) dst[m][k] = *(const LAS bf16x8*)(lds + PG8_SA(b, h) + aoff + m * 2048 + k * 1024); } } while (0)
#define PG8_LDB(dst, b, h) do { if constexpr (Epi::MODE == 2) { _Pragma("unroll") for (int n = 0; n < 2; ++n) dst##8[n] = __builtin_shufflevector(*(const LAS i32x4*)(lds + PG8_SB(b, h) + boff + n * 2048), *(const LAS i32x4*)(lds + PG8_SB(b, h) + boff + n * 2048 + 1024), 0, 1, 2, 3, 4, 5, 6, 7); } \
        else { _Pragma("unroll") for (int n = 0; n < 2; ++n) _Pragma("unroll") for (int k = 0; k < 2; ++k) dst[n][k] = *(const LAS bf16x8*)(lds + PG8_SB(b, h) + boff + n * 2048 + k * 1024); } } while (0)
#define PG8_MMA(ai, bj, At, Bt) do { __builtin_amdgcn_s_setprio(1); _Pragma("unroll") for (int m = 0; m < 4; ++m) _Pragma("unroll") for (int n = 0; n < 2; ++n) _Pragma("unroll") for (int k = 0; k < 2; ++k) \
        { if constexpr (Epi::MODE == 1) acc[ai][bj][m][n] = __builtin_bit_cast(f32x4, __builtin_amdgcn_mfma_i32_16x16x64_i8(__builtin_bit_cast(i32x4, Bt[n][k]), __builtin_bit_cast(i32x4, At[m][k]), __builtin_bit_cast(i32x4, acc[ai][bj][m][n]), 0, 0, 0)); \
          else if constexpr (Epi::MODE == 2) { if (k == 0) asm volatile("v_mfma_f32_16x16x128_f8f6f4 %0, %1, %2, %0" : "+v"(acc[ai][bj][m][n]) : "v"(Bt##8[n]), "v"(At##8[m])); } \
          else acc[ai][bj][m][n] = __builtin_amdgcn_mfma_f32_16x16x32_bf16(Bt[n][k], At[m][k], acc[ai][bj][m][n], 0, 0, 0); } __builtin_amdgcn_s_setprio(0); } while (0)
#define PG8_WAIT_V(n) asm volatile("s_waitcnt vmcnt(" #n ")" ::: "memory")
#define PG8_WAIT_L(n) asm volatile("s_waitcnt lgkmcnt(" #n ")" ::: "memory")
#define PG8_BAR __builtin_amdgcn_s_barrier()
#define PG8_SCHED __builtin_amdgcn_sched_barrier(0)
    Unit cur, nxt; int ui = 0;
    if (!S.next(0, cur)) return;
    f32x4 acc[2][2][4][2];
#pragma unroll
    for (int a = 0; a < 2; ++a)
#pragma unroll
        for (int b = 0; b < 2; ++b)
#pragma unroll
            for (int m = 0; m < 4; ++m)
#pragma unroll
                for (int n = 0; n < 2; ++n) acc[a][b][m][n] = (f32x4){0.f, 0.f, 0.f, 0.f};
    bf16x8 At[4][2], B0[2][2], B1[2][2];
    i32x8 At8[4], B08[2], B18[2];
    unsigned voffA[2][2], nvoffA[2][2];
    S.arows(cur, voffA, R, C);
    const char* cA = cur.A; const char* cB = cur.B;
    PG8_STAGE(PG8_SB(0, 0), cB, voffB); PG8_STAGE(PG8_SB(0, 1), cB + hstep, voffB); PG8_STAGE(PG8_SA(0, 0), cA, voffA[0]); PG8_STAGE(PG8_SA(0, 1), cA, voffA[1]);
    if (wr == 1) PG8_BAR;
    PG8_WAIT_V(2); PG8_BAR;
    PG8_STAGE(PG8_SB(1, 0), cB + kstep, voffB); PG8_STAGE(PG8_SA(1, 0), cA + kstep, voffA[0]); PG8_STAGE(PG8_SB(1, 1), cB + hstep + kstep, voffB);
    PG8_WAIT_V(6); PG8_BAR;
    for (;;) {
        const bool has_next = S.next(ui + 1, nxt);
        if (has_next && Sched::GATHER) S.arows(nxt, nvoffA, R, C);
        else {
#pragma unroll
            for (int h = 0; h < 2; ++h)
#pragma unroll
                for (int i = 0; i < 2; ++i) nvoffA[h][i] = voffA[h][i]; }
        const char* nA = has_next ? nxt.A : cA; const char* nB = has_next ? nxt.B : cB;
#pragma nounroll
        for (int t = 0; t < nt; t += 2) {
            const bool last = (t == nt - 2);
            const char* a1 = cA + (size_t)(t + 1) * kstep;
            const char* a2 = last ? nA : cA + (size_t)(t + 2) * kstep; const char* b2 = last ? nB : cB + (size_t)(t + 2) * kstep;
            const char* a3 = a2 + kstep; const char* b3 = b2 + kstep;
            unsigned o2[2][2];
#pragma unroll
            for (int h = 0; h < 2; ++h)
#pragma unroll
                for (int i = 0; i < 2; ++i) o2[h][i] = (Sched::GATHER && last) ? nvoffA[h][i] : voffA[h][i];
            PG8_LDB(B0, 0, 0); PG8_LDB(B1, 0, 1); PG8_SCHED; PG8_LDA(At, 0, 0); PG8_STAGE(PG8_SA(1, 1), a1, voffA[1]);
            PG8_WAIT_V(8); PG8_WAIT_L(0); PG8_BAR; PG8_MMA(0, 0, At, B0); PG8_MMA(0, 1, At, B1); PG8_BAR; PG8_SCHED;
            PG8_LDA(At, 0, 1); PG8_STAGE(PG8_SB(0, 0), b2, voffB); PG8_STAGE(PG8_SB(0, 1), b2 + hstep, voffB); PG8_STAGE(PG8_SA(0, 0), a2, o2[0]);
            PG8_WAIT_V(8); PG8_WAIT_L(0); PG8_BAR; PG8_MMA(1, 0, At, B0); PG8_MMA(1, 1, At, B1); PG8_BAR; PG8_SCHED;
            PG8_LDB(B0, 1, 0); PG8_LDB(B1, 1, 1); PG8_SCHED; PG8_LDA(At, 1, 0); PG8_STAGE(PG8_SA(0, 1), a2, o2[1]);
            PG8_WAIT_V(8); PG8_WAIT_L(0); PG8_BAR; PG8_MMA(0, 0, At, B0); PG8_MMA(0, 1, At, B1); PG8_BAR; PG8_SCHED;
            PG8_LDA(At, 1, 1); PG8_STAGE(PG8_SB(1, 0), b3, voffB); PG8_STAGE(PG8_SB(1, 1), b3 + hstep, voffB); PG8_STAGE(PG8_SA(1, 0), a3, o2[0]);
            PG8_WAIT_V(8); PG8_WAIT_L(0); PG8_BAR; PG8_MMA(1, 0, At, B0); PG8_MMA(1, 1, At, B1); PG8_BAR; PG8_SCHED;
        }
        if constexpr (Epi::MODE == 2) asm volatile("s_nop 15\n\ts_nop 15" ::: "memory");
        if (wr == 0) PG8_BAR;
        const int le = fresh_lane();
        const bool keep = E(acc, cur, wr, wc, le & 15, le >> 4);
        if (!has_next) break;
        if (!keep) {
#pragma unroll
            for (int a = 0; a < 2; ++a)
#pragma unroll
                for (int b = 0; b < 2; ++b)
#pragma unroll
                    for (int m = 0; m < 4; ++m)
#pragma unroll
                        for (int n = 0; n < 2; ++n) acc[a][b][m][n] = (f32x4){0.f, 0.f, 0.f, 0.f}; }
        cur = nxt; cA = nA; cB = nB; ++ui;
#pragma unroll
        for (int h = 0; h < 2; ++h)
#pragma unroll
            for (int i = 0; i < 2; ++i) if (Sched::GATHER) voffA[h][i] = nvoffA[h][i];
        if (wr == 1) PG8_BAR;
    }
    PG8_WAIT_V(0);
    PG8_BAR;
#undef PG8_SA
#undef PG8_SB
#undef PG8_STAGE
#undef PG8_LDA
#undef PG8_LDB
#undef PG8_MMA
#undef PG8_WAIT_V
#undef PG8_WAIT_L
#undef PG8_BAR
#undef PG8_SCHED
}

struct SchedGrid {
    static constexpr bool GATHER = false;
    const char* A; const char* B; int lda, K, nM, nN, G, c;
    __device__ __forceinline__ bool next(int i, Unit& u) const { int pm, pn; if (!static_tile(i * G + c, nM, nN, pm, pn)) return false;
        u.A = A + (size_t)pm * 256 * lda * 2; u.B = B + (size_t)pn * 256 * K * 2; u.pm = pm; u.pn = pn; u.aux = 0; u.aux2 = 0; return true; }
    __device__ __forceinline__ void arows(const Unit&, unsigned (&off)[2][2], const int (&R)[2], const int (&C)[2]) const {
#pragma unroll
        for (int h = 0; h < 2; ++h)
#pragma unroll
            for (int i = 0; i < 2; ++i) off[h][i] = (unsigned)((h * 128 + R[i]) * lda + C[i]) * 2u; }
};
struct SchedBranch {
    static constexpr bool GATHER = false;
    const char* A0; const char* B0; const char* A1; const char* B1; int G, c;
    __device__ __forceinline__ bool next(int i, Unit& u) const { int pm, pn; if (!static_tile((i >> 1) * G + c, 64, 8, pm, pn)) return false; const int br = i & 1;
        u.A = (br ? A1 : A0) + (size_t)pm * 256 * 1024; u.B = (br ? B1 : B0) + (size_t)pn * 256 * 1024; u.pm = pm; u.pn = pn; u.aux = br; u.aux2 = 0; return true; }
    __device__ __forceinline__ void arows(const Unit&, unsigned (&off)[2][2], const int (&R)[2], const int (&C)[2]) const {
#pragma unroll
        for (int h = 0; h < 2; ++h)
#pragma unroll
            for (int i = 0; i < 2; ++i) off[h][i] = (unsigned)((h * 128 + R[i]) * 1024) + 2u * (unsigned)C[i]; }
};
struct SchedMoeUp {
    static constexpr bool GATHER = true;
    const char* H2; const char* W13; const LAS int* ltok; MoeTab T; int G, c;
    __device__ __forceinline__ bool next(int i, Unit& u) const { const int L = i * G + c, rt = L >> 2, ct = L & 3; if (rt >= __builtin_amdgcn_readfirstlane(T.tb[NEXP])) return false;
        const int e = __builtin_amdgcn_readfirstlane(T.rte[rt]), r0 = (rt - __builtin_amdgcn_readfirstlane(T.tb[e])) * 256, nv = __builtin_amdgcn_readfirstlane(T.cn[e]) - r0;
        u.A = H2; u.B = W13 + ((size_t)e * 1024 + ct * 256) * D; u.pm = rt; u.pn = ct; u.aux = nv < 256 ? nv : 256; u.aux2 = i; return true; }
    __device__ __forceinline__ void arows(const Unit& u, unsigned (&off)[2][2], const int (&R)[2], const int (&C)[2]) const {
#pragma unroll
        for (int h = 0; h < 2; ++h)
#pragma unroll
            for (int i = 0; i < 2; ++i) { const int tok = ltok[u.aux2 * 256 + h * 128 + R[0] + 64 * i]; off[h][i] = (unsigned)(tok * D) + 2u * (unsigned)C[0]; } }
};
struct SchedMoeDown {
    static constexpr bool GATHER = false;
    const char* ACT; const char* W2; MoeTab T; int G, c;
    __device__ __forceinline__ bool next(int i, Unit& u) const { const int L = i * G + c, rt = L >> 3, ct = L & 7; if (rt >= __builtin_amdgcn_readfirstlane(T.tb[NEXP])) return false;
        const int e = __builtin_amdgcn_readfirstlane(T.rte[rt]), r0 = (rt - __builtin_amdgcn_readfirstlane(T.tb[e])) * 256, nv = __builtin_amdgcn_readfirstlane(T.cn[e]) - r0;
        u.A = ACT + (size_t)rt * 256 * FE; u.B = W2 + ((size_t)e * D + ct * 256) * FE; u.pm = rt; u.pn = ct; u.aux = nv < 256 ? nv : 256; u.aux2 = e * 16384 + r0; return true; }
    __device__ __forceinline__ void arows(const Unit&, unsigned (&off)[2][2], const int (&R)[2], const int (&C)[2]) const {
#pragma unroll
        for (int h = 0; h < 2; ++h)
#pragma unroll
            for (int i = 0; i < 2; ++i) off[h][i] = (unsigned)((h * 128 + R[i]) * FE) + 2u * (unsigned)C[i]; }
};

__device__ __forceinline__ u32x4 pack8(const f32x4& v0, const f32x4& v1) { u32x4 w; w.x = cvt_pk_bf16(v0[0], v0[1]); w.y = cvt_pk_bf16(v0[2], v0[3]); w.z = cvt_pk_bf16(v1[0], v1[1]); w.w = cvt_pk_bf16(v1[2], v1[3]); return w; }
__device__ __forceinline__ void unpack8(const u32x4& w, f32x4& v0, f32x4& v1) {
    v0[0] = __uint_as_float(w.x << 16); v0[1] = __uint_as_float(w.x & 0xffff0000u); v0[2] = __uint_as_float(w.y << 16); v0[3] = __uint_as_float(w.y & 0xffff0000u);
    v1[0] = __uint_as_float(w.z << 16); v1[1] = __uint_as_float(w.z & 0xffff0000u); v1[2] = __uint_as_float(w.w << 16); v1[3] = __uint_as_float(w.w & 0xffff0000u); }
__device__ __forceinline__ f32x4 sig4(const f32x4& v) { f32x4 o;
#pragma unroll
    for (int j = 0; j < 4; ++j) o[j] = __builtin_amdgcn_rcpf(1.0f + __builtin_amdgcn_exp2f(-LOG2E * v[j])); return o; }

struct EpiProj {
    static constexpr bool PERM = true; static constexpr int MODE = 1;
    bf16_t *U, *V, *Q, *Kb, *VT, *G; const float *HSC, *CS;
    __device__ __forceinline__ bool operator()(f32x4 (&acc)[2][2][4][2], const Unit& u, int wr, int wc, int fr, int fq) const {
        const int pn = u.pn, row0 = u.pm * BM + wr * 64 + fr, cl = wc * 32 + 8 * fq;
        {
            const float* hs = HSC + row0; const f32x4* cp = (const f32x4*)(CS + pn * 256 + cl);
            float rs[2][4]; f32x4 cs[2][2];
#pragma unroll
            for (int ai = 0; ai < 2; ++ai)
#pragma unroll
                for (int m = 0; m < 4; ++m) rs[ai][m] = hs[ai * HALF + m * 16];
#pragma unroll
            for (int bj = 0; bj < 2; ++bj) { cs[bj][0] = cp[bj * 32]; cs[bj][1] = cp[bj * 32 + 1]; }
#pragma unroll
            for (int ai = 0; ai < 2; ++ai)
#pragma unroll
                for (int bj = 0; bj < 2; ++bj)
#pragma unroll
                    for (int m = 0; m < 4; ++m)
#pragma unroll
                        for (int n = 0; n < 2; ++n) acc[ai][bj][m][n] = __builtin_convertvector(__builtin_bit_cast(i32x4, acc[ai][bj][m][n]), f32x4) * (cs[bj][n] * rs[ai][m]);
        }
        if (pn < 8) {
            bf16_t* base = (pn < 4 ? U : V) + (pn & 3) * 256 + cl;
#pragma unroll
            for (int ai = 0; ai < 2; ++ai)
#pragma unroll
                for (int m = 0; m < 4; ++m) { bf16_t* rowp = base + (size_t)(row0 + ai * HALF + m * 16) * 1024;
#pragma unroll
                    for (int bj = 0; bj < 2; ++bj) { const f32x4 v0 = acc[ai][bj][m][0], v1 = acc[ai][bj][m][1];
                        const f32x2 a = gelu_pk((f32x2){v0[0], v0[1]}), b = gelu_pk((f32x2){v0[2], v0[3]}), c = gelu_pk((f32x2){v1[0], v1[1]}), d = gelu_pk((f32x2){v1[2], v1[3]});
                        *(u32x4*)(rowp + bj * HALF) = pack8((f32x4){a.x, a.y, b.x, b.y}, (f32x4){c.x, c.y, d.x, d.y}); } }
        } else if (pn < 16) {
            bf16_t* base = (pn < 12 ? Q : Kb) + (pn & 3) * 256 + cl; const float sc = pn < 12 ? QSCALE : 1.0f;
#pragma unroll
            for (int ai = 0; ai < 2; ++ai)
#pragma unroll
                for (int m = 0; m < 4; ++m) { bf16_t* rowp = base + (size_t)(row0 + ai * HALF + m * 16) * 1024;
#pragma unroll
                    for (int bj = 0; bj < 2; ++bj) *(u32x4*)(rowp + bj * HALF) = pack8(acc[ai][bj][m][0] * sc, acc[ai][bj][m][1] * sc); }
        } else if (pn < 20) {
#ifndef DIAG_NOVT
#pragma unroll
            for (int ai = 0; ai < 2; ++ai)
#pragma unroll
                for (int m = 0; m < 4; ++m) { const int row = row0 + ai * HALF + m * 16, b = row >> 13, s = row & 8191;
#pragma unroll
                    for (int bj = 0; bj < 2; ++bj) { const int c5 = (pn - 16) * 256 + bj * HALF + cl, hh = c5 >> 6, d = c5 & 63;
                        bf16_t* bp = VT + ((size_t)((b * 16 + hh) * 64 + d)) * 8192 + s; const u32x4 w = pack8(acc[ai][bj][m][0], acc[ai][bj][m][1]);
                        bp[0 * 8192] = (bf16_t)(w.x & 0xffffu); bp[1 * 8192] = (bf16_t)(w.x >> 16); bp[2 * 8192] = (bf16_t)(w.y & 0xffffu); bp[3 * 8192] = (bf16_t)(w.y >> 16);
                        bp[4 * 8192] = (bf16_t)(w.z & 0xffffu); bp[5 * 8192] = (bf16_t)(w.z >> 16); bp[6 * 8192] = (bf16_t)(w.w & 0xffffu); bp[7 * 8192] = (bf16_t)(w.w >> 16); } }
#endif
        } else {
            unsigned short* base = (unsigned short*)G + (pn - 20) * 128 + cl;
#pragma unroll
            for (int ai = 0; ai < 2; ++ai)
#pragma unroll
                for (int m = 0; m < 4; ++m) { unsigned short* rowp = base + (size_t)(row0 + ai * HALF + m * 16) * D;
                    const f32x4 a0 = sig4(acc[ai][0][m][0]), a1 = sig4(acc[ai][0][m][1]), b0 = sig4(acc[ai][1][m][0]), b1 = sig4(acc[ai][1][m][1]);
                    unsigned q[8];
#pragma unroll
                    for (int j = 0; j < 4; ++j) { unsigned qa = (unsigned)(a0[j] * 255.f + 0.5f), qb = (unsigned)(b0[j] * 255.f + 0.5f); qa = qa < 1u ? 1u : qa; qb = qb < 1u ? 1u : qb; q[j] = qa | (qb << 8);
                        unsigned ra = (unsigned)(a1[j] * 255.f + 0.5f), rb = (unsigned)(b1[j] * 255.f + 0.5f); ra = ra < 1u ? 1u : ra; rb = rb < 1u ? 1u : rb; q[4 + j] = ra | (rb << 8); }
                    u32x4 w; w.x = q[0] | (q[1] << 16); w.y = q[2] | (q[3] << 16); w.z = q[4] | (q[5] << 16); w.w = q[6] | (q[7] << 16);
                    __builtin_nontemporal_store(w, (u32x4*)rowp); }
        }
        return false;
    }
};
struct EpiBranch {
    static constexpr bool PERM = true; static constexpr int MODE = 2;
    const unsigned short* G; bf16_t* MIX;
    mutable unsigned gbk[2][4][2][2];
    __device__ __forceinline__ bool operator()(f32x4 (&acc)[2][2][4][2], const Unit& u, int wr, int wc, int fr, int fq) const {
        const int row0 = u.pm * BM + wr * 64 + fr, col0 = u.pn * BM + wc * 32 + 8 * fq; const bool brb = u.aux != 0;
        if (!brb) {
#pragma unroll
            for (int ai = 0; ai < 2; ++ai) {
                u32x4 g[4][2];
#pragma unroll
                for (int m = 0; m < 4; ++m)
#pragma unroll
                    for (int bj = 0; bj < 2; ++bj) g[m][bj] = __builtin_nontemporal_load((const u32x4*)(G + (size_t)(row0 + ai * HALF + m * 16) * D + col0 + bj * HALF));
#pragma unroll
                for (int m = 0; m < 4; ++m)
#pragma unroll
                    for (int bj = 0; bj < 2; ++bj) {
                        const unsigned w[4] = {g[m][bj].x, g[m][bj].y, g[m][bj].z, g[m][bj].w};
#pragma unroll
                        for (int j = 0; j < 4; ++j) {
                            const float r0 = (float)(w[j] & 0xffu) * __builtin_amdgcn_rcpf((float)((w[j] >> 8) & 0xffu)), r1 = (float)((w[j] >> 16) & 0xffu) * __builtin_amdgcn_rcpf((float)(w[j] >> 24));
                            acc[ai][bj][m][j >> 1][2 * (j & 1)] *= r0; acc[ai][bj][m][j >> 1][2 * (j & 1) + 1] *= r1; }
                        gbk[ai][m][bj][0] = ((w[0] >> 8) & 0xffu) | ((w[0] >> 24) << 8) | (((w[1] >> 8) & 0xffu) << 16) | ((w[1] >> 24) << 24);
                        gbk[ai][m][bj][1] = ((w[2] >> 8) & 0xffu) | ((w[2] >> 24) << 8) | (((w[3] >> 8) & 0xffu) << 16) | ((w[3] >> 24) << 24);
                    }
            }
            return true;
        }
#pragma unroll
        for (int ai = 0; ai < 2; ++ai)
#pragma unroll
            for (int m = 0; m < 4; ++m)
#pragma unroll
                for (int bj = 0; bj < 2; ++bj) {
                    const unsigned k0 = gbk[ai][m][bj][0], k1 = gbk[ai][m][bj][1];
                    const f32x4 b0 = (f32x4){(float)(k0 & 0xffu), (float)((k0 >> 8) & 0xffu), (float)((k0 >> 16) & 0xffu), (float)(k0 >> 24)} * (1.f / (255.f * F8_SY * F8_SW));
                    const f32x4 b1 = (f32x4){(float)(k1 & 0xffu), (float)((k1 >> 8) & 0xffu), (float)((k1 >> 16) & 0xffu), (float)(k1 >> 24)} * (1.f / (255.f * F8_SY * F8_SW));
                    *(u32x4*)(MIX + (size_t)(row0 + ai * HALF + m * 16) * D + col0 + bj * HALF) = pack8(acc[ai][bj][m][0] * b0, acc[ai][bj][m][1] * b1);
                }
        return false;
    }
};
struct EpiOut {
    static constexpr bool PERM = true; static constexpr int MODE = 1;
    const float* x; const float* mod; bf16_t* out; const float *SM, *CSO;
    __device__ __forceinline__ bool operator()(f32x4 (&acc)[2][2][4][2], const Unit& u, int wr, int wc, int fr, int fq) const {
        const int row0 = u.pm * BM + wr * 64 + fr, col0 = u.pn * BM + wc * 32 + 8 * fq; const float* g1 = mod + ((u.pm * BM) >> 13) * NMOD + 2 * D;
        f32x4 gv[2][2];
#pragma unroll
        for (int bj = 0; bj < 2; ++bj)
#pragma unroll
            for (int n = 0; n < 2; ++n) gv[bj][n] = *(const f32x4*)(g1 + col0 + bj * HALF + 4 * n) * *(const f32x4*)(CSO + col0 + bj * HALF + 4 * n);
#pragma unroll
        for (int ai = 0; ai < 2; ++ai)
#pragma unroll
            for (int m = 0; m < 4; ++m) { const float rs = SM[row0 + ai * HALF + m * 16];
#pragma unroll
                for (int bj = 0; bj < 2; ++bj)
#pragma unroll
                    for (int n = 0; n < 2; ++n) acc[ai][bj][m][n] = __builtin_convertvector(__builtin_bit_cast(i32x4, acc[ai][bj][m][n]), f32x4) * rs; }
#pragma unroll
        for (int ai = 0; ai < 2; ++ai)
#pragma unroll
            for (int mh = 0; mh < 2; ++mh) {
                f32x4 xv[2][2][2];
#pragma unroll
                for (int m = 0; m < 2; ++m)
#pragma unroll
                    for (int bj = 0; bj < 2; ++bj)
#pragma unroll
                        for (int n = 0; n < 2; ++n) xv[m][bj][n] = __builtin_nontemporal_load((const f32x4*)(x + (size_t)(row0 + ai * HALF + (2 * mh + m) * 16) * D + col0 + bj * HALF + 4 * n));
#pragma unroll
                for (int m = 0; m < 2; ++m)
#pragma unroll
                    for (int bj = 0; bj < 2; ++bj)
                        *(u32x4*)(out + (size_t)(row0 + ai * HALF + (2 * mh + m) * 16) * D + col0 + bj * HALF) =
                            pack8(xv[m][bj][0] + gv[bj][0] * acc[ai][bj][2 * mh + m][0], xv[m][bj][1] + gv[bj][1] * acc[ai][bj][2 * mh + m][1]);
            }
        return false;
    }
};
struct EpiMoeUp {
    static constexpr bool PERM = true; static constexpr int MODE = 2;
    unsigned char* ACT;
    __device__ __forceinline__ bool operator()(f32x4 (&acc)[2][2][4][2], const Unit& u, int wr, int wc, int fr, int fq) const {
        const int f0 = u.pn * 128 + wc * 32 + 8 * fq;
#pragma unroll
        for (int ai = 0; ai < 2; ++ai)
#pragma unroll
            for (int m = 0; m < 4; ++m) { const int r = ai * HALF + wr * 64 + m * 16 + fr; const bool valid = r < u.aux;
                f32x4 o[2];
#pragma unroll
                for (int n = 0; n < 2; ++n) { const f32x4 a = acc[ai][0][m][n] * (1.f / (F8_SH2 * F8_SW)), b = acc[ai][1][m][n] * (F8_SACT / (F8_SH2 * F8_SW));
#pragma unroll
                    for (int j = 0; j < 4; ++j) o[n][j] = valid ? a[j] * __builtin_amdgcn_rcpf(1.0f + __builtin_amdgcn_exp2f(-LOG2E * a[j])) * b[j] : 0.f; }
                *(u32x2*)(ACT + ((size_t)u.pm * 256 + r) * FE + f0) = (u32x2){pk4_f8(o[0][0], o[0][1], o[0][2], o[0][3]), pk4_f8(o[1][0], o[1][1], o[1][2], o[1][3])}; }
        return false;
    }
};
struct EpiMoeDown {
    static constexpr bool PERM = true; static constexpr int MODE = 2;
    const float* roww; unsigned char* YS;
    __device__ __forceinline__ bool operator()(f32x4 (&acc)[2][2][4][2], const Unit& u, int wr, int wc, int fr, int fq) const {
        const int col0 = u.pn * BM + wc * 32 + 8 * fq;
        float w[2][4];
#pragma unroll
        for (int ai = 0; ai < 2; ++ai)
#pragma unroll
            for (int m = 0; m < 4; ++m) { const int r = ai * HALF + wr * 64 + m * 16 + fr; w[ai][m] = (64.0f / (F8_SACT * F8_SW)) * roww[u.aux2 + (r < u.aux ? r : 0)]; }
#pragma unroll
        for (int ai = 0; ai < 2; ++ai)
#pragma unroll
            for (int m = 0; m < 4; ++m) { const int r = ai * HALF + wr * 64 + m * 16 + fr;
#pragma unroll
                for (int bj = 0; bj < 2; ++bj) { const f32x4 v0 = acc[ai][bj][m][0] * w[ai][m], v1 = acc[ai][bj][m][1] * w[ai][m];
                    unsigned lo = __builtin_amdgcn_cvt_pk_fp8_f32(v0[0], v0[1], 0, false); lo = __builtin_amdgcn_cvt_pk_fp8_f32(v0[2], v0[3], lo, true);
                    unsigned hi = __builtin_amdgcn_cvt_pk_fp8_f32(v1[0], v1[1], 0, false); hi = __builtin_amdgcn_cvt_pk_fp8_f32(v1[2], v1[3], hi, true);
                    *(u32x2*)(YS + ((size_t)u.pm * 256 + r) * D + col0 + bj * HALF) = (u32x2){lo, hi}; } }
        return false;
    }
};
}

#define XB_TMO      128
#define XB_XCNT(j)  (256  + 64 * (j))
#define XB_XSUB(j)  (1280 + 64 * (j))
#define XB_XGEN(j)  (2304 + 64 * (j))
#define XB_TOP      3328
#define XB_TOPGEN   3392
#define XCD_BAR_WORDS 3456
#define XB_SPIN_CAP (1u << 18)

__device__ __forceinline__ unsigned xb_ld(unsigned* p)              { return __hip_atomic_load(p, __ATOMIC_RELAXED, __HIP_MEMORY_SCOPE_AGENT); }
__device__ __forceinline__ unsigned xb_add(unsigned* p, unsigned v) { return __hip_atomic_fetch_add(p, v, __ATOMIC_RELAXED, __HIP_MEMORY_SCOPE_AGENT); }
__device__ __forceinline__ unsigned xb_xcc_id() { return (unsigned)__builtin_amdgcn_s_getreg((3 << 11) | 20) & 0xFu; }
#define XB_SPIN(cond, bar) do { unsigned _sp = 0; while (cond) { __builtin_amdgcn_s_sleep(1); \
    if ((++_sp & 255u) == 0u) { if (xb_ld(&(bar)[XB_TMO])) break; if (_sp > XB_SPIN_CAP) { atomicAdd(&(bar)[XB_TMO], 1u); break; } } } } while (0)

struct XcdBarrier {
    unsigned* bar; unsigned x;
    volatile LAS unsigned* st;
};

__device__ __forceinline__ XcdBarrier xcd_barrier_post(unsigned* bar, volatile LAS unsigned* st) {
    XcdBarrier b; b.bar = bar; b.x = xb_xcc_id(); b.st = st;
    if (threadIdx.x == 0) (void)xb_add(&bar[XB_XCNT(b.x)], 1u);
    return b;
}
__device__ __forceinline__ void xcd_barrier_complete(unsigned* bar, unsigned x, unsigned& nloc, unsigned& nx) {
    const unsigned G = gridDim.x * gridDim.y * gridDim.z;
    unsigned sum, cnt, mine, sp = 0u;
    for (;;) {
        sum = 0u; cnt = 0u; mine = 0u;
#pragma unroll
        for (unsigned j = 0; j < 16; ++j) { const unsigned c = xb_ld(&bar[XB_XCNT(j)]); sum += c; cnt += (c > 0u) ? 1u : 0u; mine = (j == x) ? c : mine; }
        if (sum == G) break;
        __builtin_amdgcn_s_sleep(1);
        if ((++sp & 255u) == 0u) { if (xb_ld(&bar[XB_TMO])) break; if (sp > XB_SPIN_CAP) { atomicAdd(&bar[XB_TMO], 1u); break; } }
    }
    nloc = mine > 0u ? mine : 1u; nx = cnt > 0u ? cnt : 1u;
}

__device__ __forceinline__ void xcd_barrier(const XcdBarrier& b) {
    asm volatile("s_waitcnt vmcnt(0)" ::: "memory");
    __syncthreads();
    if (threadIdx.x == 0) {
        unsigned* bar = b.bar;
        __builtin_amdgcn_s_waitcnt(0);
        unsigned nloc = b.st[0], nx = b.st[1];
        if (nloc == 0u) { xcd_barrier_complete(bar, b.x, nloc, nx); b.st[0] = nloc; b.st[1] = nx; }
        const unsigned old = xb_add(&bar[XB_XSUB(b.x)], 1u);
        const unsigned gen = old / nloc;
        if (old + 1u == (gen + 1u) * nloc) {
            __builtin_amdgcn_fence(__ATOMIC_RELEASE, "agent");
            asm volatile("s_waitcnt vmcnt(0)" ::: "memory");
            const unsigned og = xb_add(&bar[XB_TOP], 1u);
            const unsigned tg = og / nx;
            if (og + 1u == (tg + 1u) * nx) xb_add(&bar[XB_TOPGEN], 1u);
            else XB_SPIN(xb_ld(&bar[XB_TOPGEN]) == tg, bar);
            __builtin_amdgcn_fence(__ATOMIC_ACQUIRE, "agent");
            xb_add(&bar[XB_XGEN(b.x)], 1u);
            asm volatile("s_waitcnt vmcnt(0)" ::: "memory");
        } else {
            XB_SPIN(xb_ld(&bar[XB_XGEN(b.x)]) == gen, bar);
            __builtin_amdgcn_fence(__ATOMIC_ACQUIRE, "agent");
            asm volatile("s_waitcnt vmcnt(0)" ::: "memory");
        }
    }
    __syncthreads();
}

constexpr int NWAVES = 8, NTHREADS = NWAVES * 64;
constexpr int RING_BYTES = 131072, MISC_OFF = 147456, LDS_BYTES = 155648;

__device__ __forceinline__ void p0_mod_unit(const float* c, const float* ada_w, float* modp, int unit, int lane) {
    const int rb = unit >> 6, cc = unit & 63;
    if (lane < 48) {
        f32x4 a0 = {0.f, 0.f, 0.f, 0.f}, a1 = {0.f, 0.f, 0.f, 0.f};
        const float* wp = ada_w + (size_t)(rb * 64) * NMOD + cc * 192 + lane * 4;
#pragma unroll 8
        for (int r = 0; r < 64; ++r) {
            const float c0 = c[rb * 64 + r], c1 = c[D + rb * 64 + r];
            const float s0 = siluf_(c0), s1 = siluf_(c1);
            const f32x4 w = __builtin_nontemporal_load((const f32x4*)(wp + (size_t)r * NMOD));
            a0 += s0 * w; a1 += s1 * w;
        }
        *(f32x4*)(modp + (size_t)(rb * 2 + 0) * NMOD + cc * 192 + lane * 4) = a0;
        *(f32x4*)(modp + (size_t)(rb * 2 + 1) * NMOD + cc * 192 + lane * 4) = a1;
    }
}
__device__ __forceinline__ void p0_amax_item(const float* Wsrc  , int ldw, unsigned* colmax  , int lane) {
    const float* src = Wsrc + (size_t)(lane >> 5) * ldw + (lane & 31);
    float wv[32];
#pragma unroll
    for (int i = 0; i < 32; ++i) wv[i] = src[(size_t)(2 * i) * ldw];
    float am = 0.f;
#pragma unroll
    for (int i = 0; i < 32; ++i) am = fmaxf(am, fabsf(wv[i]));
    am = fmaxf(am, __shfl_xor(am, 32, 64));
    if (lane < 32) __hip_atomic_fetch_max(colmax + lane, __float_as_uint(am), __ATOMIC_RELAXED, __HIP_MEMORY_SCOPE_AGENT);
}
constexpr int ADA_EARLY = 22;
__device__ __forceinline__ void p2_ada_late(const Params& p, int blk, int wave, int lane) {
    const int idx = wave * 256 + blk;
    if (idx < 32 * (64 - ADA_EARLY)) p0_mod_unit(p.in[I_C], p.in[I_ADAW], (float*)(p.ws + WS_MODP), (idx / (64 - ADA_EARLY)) * 64 + ADA_EARLY + idx % (64 - ADA_EARLY), lane);
}
__device__ __forceinline__ void p0_transpose_item(const float* Wsrc  , int ldw, unsigned char* dst  , int ldd, LAS float* scr, int lane) {
#pragma unroll 8
    for (int i = 0; i < 32; ++i) { const int kk = 2 * i + (lane >> 5); scr[kk * 33 + (lane & 31)] = __builtin_nontemporal_load(Wsrc + (size_t)kk * ldw + (lane & 31)); }
    asm volatile("s_waitcnt lgkmcnt(0)" ::: "memory");
    const int cch = lane & 7;
#pragma unroll
    for (int j = 0; j < 4; ++j) { const int n = (lane >> 3) + 8 * j; const LAS float* s = scr + (8 * cch) * 33 + n;
        u32x2 o; o.x = pk4_f8(s[0 * 33] * F8_SW, s[1 * 33] * F8_SW, s[2 * 33] * F8_SW, s[3 * 33] * F8_SW); o.y = pk4_f8(s[4 * 33] * F8_SW, s[5 * 33] * F8_SW, s[6 * 33] * F8_SW, s[7 * 33] * F8_SW);
        *(u32x2*)(dst + (size_t)n * ldd + 8 * cch) = o; }
    asm volatile("s_waitcnt lgkmcnt(0)" ::: "memory");
}
__device__ __forceinline__ void p1_quant_item(const float* Wsrc, int ldw, unsigned char* dst  , int ldd, const unsigned* colmax  , float* cs  , LAS float* scr, int lane) {
    const float amax = __uint_as_float(__hip_atomic_load(colmax + (lane & 31), __ATOMIC_RELAXED, __HIP_MEMORY_SCOPE_AGENT)), inv = amax > 0.f ? 127.f / amax : 0.f;
    if (cs && lane < 32) cs[lane] = amax * (1.f / 127.f);
#pragma unroll 8
    for (int i = 0; i < 32; ++i) { const int kk = 2 * i + (lane >> 5); scr[kk * 33 + (lane & 31)] = __builtin_nontemporal_load(Wsrc + (size_t)kk * ldw + (lane & 31)) * inv + I8MAGIC; }
    asm volatile("s_waitcnt lgkmcnt(0)" ::: "memory");
    const int c4 = lane & 3;
#pragma unroll
    for (int j = 0; j < 2; ++j) { const int n = (lane >> 2) + 16 * j; const LAS unsigned* s = (const LAS unsigned*)scr + (16 * c4) * 33 + n;
        u32x4 o; o.x = pack4_i8(s[0 * 33], s[1 * 33], s[2 * 33], s[3 * 33]); o.y = pack4_i8(s[4 * 33], s[5 * 33], s[6 * 33], s[7 * 33]);
        o.z = pack4_i8(s[8 * 33], s[9 * 33], s[10 * 33], s[11 * 33]); o.w = pack4_i8(s[12 * 33], s[13 * 33], s[14 * 33], s[15 * 33]);
        *(u32x4*)(dst + (size_t)n * ldd + 16 * c4) = o; }
    asm volatile("s_waitcnt lgkmcnt(0)" ::: "memory");
}
struct XpItem { const float* src; unsigned char* dst; int ldw, ldd, f8; };
__device__ __forceinline__ void xp_issue(const XpItem& x, int lane, float (&xr)[32]) {
    const float* q = x.src + (size_t)(lane >> 5) * x.ldw + (lane & 31); const size_t step = (size_t)2 * x.ldw;
#pragma unroll
    for (int i = 0; i < 32; ++i) { xr[i] = __builtin_nontemporal_load(q); q += step; asm volatile("" : "+v"(q)); }
}
__device__ __forceinline__ void xp_finish(const XpItem& x, int lane, const float (&xr)[32], LAS float* scr) {
#pragma unroll
    for (int i = 0; i < 32; ++i) { const int kk = 2 * i + (lane >> 5); scr[kk * 33 + (lane & 31)] = xr[i]; }
    asm volatile("s_waitcnt lgkmcnt(0)" ::: "memory");
    const int cch = lane & 7;
#pragma unroll
    for (int j = 0; j < 4; ++j) { const int n = (lane >> 3) + 8 * j; const LAS float* s = scr + (8 * cch) * 33 + n;
        u32x2 o; o.x = pk4_f8(s[0 * 33] * F8_SW, s[1 * 33] * F8_SW, s[2 * 33] * F8_SW, s[3 * 33] * F8_SW); o.y = pk4_f8(s[4 * 33] * F8_SW, s[5 * 33] * F8_SW, s[6 * 33] * F8_SW, s[7 * 33] * F8_SW);
        *(u32x2*)(x.dst + (size_t)n * x.ldd + 8 * cch) = o; }
    asm volatile("s_waitcnt lgkmcnt(0)" ::: "memory");
}
constexpr int NMOE_ITEMS = 2 * NEXP * 512;
__device__ __forceinline__ void moe_xp_item(const Params& p, int r, XpItem& x) {
    constexpr int I_E = 512; unsigned char* ws = p.ws;
    if (r < 2 * NEXP * I_E) {
        const int which = r / (NEXP * I_E); r -= which * NEXP * I_E; const int e = r / I_E, q = r % I_E, kb = q / 16, nb = q % 16, f0 = 32 * nb;
        x.src = p.in[which ? I_W3 : I_W1] + (size_t)e * D * FE + (size_t)(64 * kb) * FE + f0; x.ldw = FE;
        x.dst = ws + WS_W13_T + ((size_t)e * 1024 + 256 * (f0 >> 7) + 128 * which + (f0 & 127)) * D + 64 * kb; x.ldd = D; x.f8 = 1;
    } else { r -= 2 * NEXP * I_E; const int e = r / I_E, q = r % I_E, kb = q / 64, nb = q % 64;
        x.src = p.in[I_W2] + (size_t)e * FE * D + (size_t)(64 * kb) * D + 32 * nb; x.ldw = D;
        x.dst = ws + WS_W2_T + ((size_t)e * D + 32 * nb) * FE + 64 * kb; x.ldd = FE; x.f8 = 1; }
}
__device__ __forceinline__ void p0_prologue(const Params& p, LAS unsigned char* lds, int gw, int ngw, int wave, int lane) {
    unsigned char* ws = p.ws;
    LAS float* scr = (LAS float*)(lds + wave * 16384);
    const int blk = gw >> 3, nada = blk < (32 * ADA_EARLY - 512) ? 3 : 2;
    if (wave < nada) { const int idx = wave * 256 + blk; p0_mod_unit(p.in[I_C], p.in[I_ADAW], (float*)(ws + WS_MODP), (idx / ADA_EARLY) * 64 + idx % ADA_EARLY, lane); }
    if (gw < 8 * 128) { const int t = gw & 127; const float* wsrc = p.in[I_WS] + (size_t)gw * 128 + 2 * lane; float w0 = wsrc[0], w1 = wsrc[1];
        if (t < 64 && lane >= 32) { w0 = 0.f; w1 = 0.f; }
        ((unsigned*)(ws + WS_WSB))[gw * 64 + lane] = pk2(w0, w1); }
    for (int it = gw; it < 48 * 32; it += ngw) {
        const int col = it >> 5, k = 64 * (it & 31) + lane;
        float w = 0.f;
        if (col < 4) w = p.in[I_WGRP][k * 4 + col];
        else if (col < 36) w = p.in[I_WEXP][(size_t)((col - 4) >> 3) * D * 8 + (size_t)k * 8 + ((col - 4) & 7)];
        const unsigned hi = f2bf(w), lo = f2bf(w - __uint_as_float(hi << 16));
        bf16_t* wrt = (bf16_t*)(ws + WS_WRT);
        wrt[col * D + k] = (bf16_t)hi; wrt[48 * D + col * D + k] = (bf16_t)lo;
    }
    constexpr int I_IN = 32 * 288, I_A = 16 * 64, I_O = 32 * 64, I_E = 512;
    constexpr int NITEMS = I_IN;
    if (wave >= nada) for (int j = wave - nada; j < NITEMS / 256; j += 8 - nada) {
        int r = blk + 256 * j;
        if (r < I_IN) { const int kb = r / 288, nb = r % 288; int drow = 32 * nb;
            if (drow >= 5120) { const int c = drow - 5120, which = c >> 11, cc = c & 2047; drow = 5120 + 256 * (cc >> 7) + 128 * which + (cc & 127); }
            p0_amax_item(p.in[I_WIN] + (size_t)(64 * kb) * NCOLS + 32 * nb, NCOLS, (unsigned*)(ws + WS_COLMAX) + drow, lane); }
    }
    if (wave >= nada) for (int j = wave - nada; j < I_O / 256; j += 8 - nada) { const int it = blk + 256 * j, kb = it >> 6, nb = it & 63;
        p0_amax_item(p.in[I_WOUT] + (size_t)(64 * kb) * D + 32 * nb, D, (unsigned*)(ws + WS_COLMAX_O) + 32 * nb, lane); }
}
__device__ __forceinline__ void p1_norm1(const Params& p, LAS unsigned char* lds, int blk, int tid, int wave, int lane) {
    unsigned char* ws = p.ws; const float* modp = (const float*)(ws + WS_MODP); float* mod = (float*)(ws + WS_MOD);
    LAS float* A1 = (LAS float*)lds; LAS float* S1 = A1 + D;
    const int bb = blk >> 7;
    for (int k = tid; k < D; k += NTHREADS) {
        float sh = p.in[I_ADAB][k], sc = p.in[I_ADAB][D + k];
        for (int q = 0; q < 32; ++q) { sh += modp[(size_t)(q * 2 + bb) * NMOD + k]; sc += modp[(size_t)(q * 2 + bb) * NMOD + D + k]; }
        A1[k] = p.in[I_N1G][k] * (1.f + sc); S1[k] = sh;
    }
    __syncthreads();
    LAS float* scr = (LAS float*)(lds + 16384 + wave * 16384);
    for (int it = blk * NWAVES + wave; it < 32 * 288; it += 256 * NWAVES) {
        const int kb = it / 288, nb = it % 288; int drow = 32 * nb;
        if (drow >= 5120) { const int c = drow - 5120, which = c >> 11, cc = c & 2047; drow = 5120 + 256 * (cc >> 7) + 128 * which + (cc & 127); }
        p1_quant_item(p.in[I_WIN] + (size_t)(64 * kb) * NCOLS + 32 * nb, NCOLS, ws + WS_WIN_T + (size_t)drow * D + 64 * kb, D, (const unsigned*)(ws + WS_COLMAX) + drow,
                      kb == 0 ? (float*)(ws + WS_CS) + drow : (float*)nullptr, scr, lane);
    }
    for (int it = blk * NWAVES + wave; it < 32 * 64; it += 256 * NWAVES) { const int kb = it >> 6, nb = it & 63;
        p1_quant_item(p.in[I_WOUT] + (size_t)(64 * kb) * D + 32 * nb, D, ws + WS_WOUT_T + (size_t)(32 * nb) * D + 64 * kb, D, (const unsigned*)(ws + WS_COLMAX_O) + 32 * nb,
                      kb == 0 ? (float*)(ws + WS_CSO) + 32 * nb : (float*)nullptr, scr, lane);
    }
    const float* x = p.in[I_X]; unsigned char* H = ws + WS_H; float* hsc = (float*)(ws + WS_HSC);
    for (int i = 0; i < 8; i += 2) {
        const int row = blk * 64 + wave * 8 + i;
        const f32x4* xr = (const f32x4*)(x + (size_t)row * D) + lane;
        f32x4 v[2][8]; float ss[2] = {0.f, 0.f};
#pragma unroll
        for (int r = 0; r < 2; ++r)
#pragma unroll
            for (int j = 0; j < 8; ++j) v[r][j] = __builtin_nontemporal_load(xr + (size_t)r * (D / 4) + 64 * j);
#pragma unroll
        for (int r = 0; r < 2; ++r)
#pragma unroll
            for (int j = 0; j < 8; ++j) ss[r] += (v[r][j].x * v[r][j].x + v[r][j].y * v[r][j].y) + (v[r][j].z * v[r][j].z + v[r][j].w * v[r][j].w);
#pragma unroll
        for (int r = 0; r < 2; ++r) {
            const float rstd = rsqrtf(wave_sum(ss[r]) * (1.f / D) + EPS);
            unsigned* o = (unsigned*)(H + (size_t)(row + r) * D) + lane;
            float am = 0.f;
#pragma unroll
            for (int j = 0; j < 8; ++j) { const f32x4 a = *(const LAS f32x4*)(A1 + 256 * j + 4 * lane), s = *(const LAS f32x4*)(S1 + 256 * j + 4 * lane);
                v[r][j] = v[r][j] * rstd * a + s; am = fmaxf(fmaxf(am, fmaxf(fabsf(v[r][j].x), fabsf(v[r][j].y))), fmaxf(fabsf(v[r][j].z), fabsf(v[r][j].w))); }
            am = wave_max(am); const float sq = am > 0.f ? 127.f / am : 0.f;
            if (lane == 0) hsc[row + r] = am * (1.f / 127.f);
#pragma unroll
            for (int j = 0; j < 8; ++j) { const f32x4 h = v[r][j] * sq + I8MAGIC;
                o[64 * j] = pack4_i8(__float_as_uint(h.x), __float_as_uint(h.y), __float_as_uint(h.z), __float_as_uint(h.w)); }
        }
    }
    __syncthreads();
}
typedef short bf16x8_t __attribute__((ext_vector_type(8)));
typedef short bf16x4_t __attribute__((ext_vector_type(4)));
__device__ __forceinline__ void p3_gmlp(const Params& p, LAS unsigned char* lds, int blk, int tid, int wave, int lane, size_t out_off, int gw) {
    unsigned char* ws = p.ws; bf16_t* U = (bf16_t*)(ws + WS_U); const bf16_t* V = (const bf16_t*)(ws + WS_V);
    const int tb0 = (((blk >> 4) << 3) | (blk & 7)) * 128, gh = (blk >> 3) & 1, l15 = lane & 15, lg = lane >> 4;
    LAS float* st = (LAS float*)lds;
    LAS unsigned char* XT = lds + 1024;
    LAS unsigned char* WL = lds + 1024 + 34816;
    for (int i0 = 0; i0 < 16; i0 += 8) {
        u32x4 raw[8][2];
#pragma unroll
        for (int i = 0; i < 8; ++i) { const u32x4* vp = (const u32x4*)(V + (size_t)(tb0 + 16 * wave + i0 + i) * 1024) + lane * 2; raw[i][0] = vp[0]; raw[i][1] = vp[1]; }
        float s[8], q[8];
#pragma unroll
        for (int i = 0; i < 8; ++i) { f32x4 x[4]; pg8::unpack8(raw[i][0], x[0], x[1]); pg8::unpack8(raw[i][1], x[2], x[3]);
            s[i] = ((x[0].x + x[0].y) + (x[0].z + x[0].w)) + ((x[1].x + x[1].y) + (x[1].z + x[1].w)) + ((x[2].x + x[2].y) + (x[2].z + x[2].w)) + ((x[3].x + x[3].y) + (x[3].z + x[3].w)); }
#pragma unroll
        for (int o = 32; o > 0; o >>= 1)
#pragma unroll
            for (int i = 0; i < 8; ++i) s[i] += __shfl_xor(s[i], o, 64);
#pragma unroll
        for (int i = 0; i < 8; ++i) { f32x4 x[4]; pg8::unpack8(raw[i][0], x[0], x[1]); pg8::unpack8(raw[i][1], x[2], x[3]); const float mean = s[i] * (1.f / 1024.f); s[i] = mean; q[i] = 0.f;
#pragma unroll
            for (int j = 0; j < 4; ++j) { const f32x4 d = x[j] - mean; q[i] += (d.x * d.x + d.y * d.y) + (d.z * d.z + d.w * d.w); } }
#pragma unroll
        for (int o = 32; o > 0; o >>= 1)
#pragma unroll
            for (int i = 0; i < 8; ++i) q[i] += __shfl_xor(q[i], o, 64);
#pragma unroll
        for (int i = 0; i < 8; ++i) if (lane == 0) { st[2 * (16 * wave + i0 + i)] = s[i]; st[2 * (16 * wave + i0 + i) + 1] = rsqrtf(q[i] * (1.f / 1024.f) + EPS); }
    }
    __syncthreads();
    const float* lng = p.in[I_LNG]; const float* lnb = p.in[I_LNB]; const float* w_s = p.in[I_WS]; const float* b_s = p.in[I_BS];
    LAS float* scr = (LAS float*)(lds + 77824 + wave * 8448);
    int xk = 0; bool xpend = false; XpItem xi; xi.src = nullptr; xi.dst = nullptr; xi.ldw = 0; xi.ldd = 0; xi.f8 = 1; float xr[32];
#pragma unroll
    for (int q = 0; q < 32; ++q) xr[q] = 0.f;
    for (int gi = 0; gi < 4; ++gi) {
        const int g = gh * 4 + gi;
#pragma unroll
        for (int i = 0; i < 4; ++i) {
            const int q = tid + 512 * i, s = q & 127, cch = q >> 7;
            const u32x4 raw = *(const u32x4*)(V + (size_t)(tb0 + s) * 1024 + 128 * g + 8 * cch);
            f32x4 x0, x1; pg8::unpack8(raw, x0, x1);
            const float mean = st[2 * s], rstd = st[2 * s + 1];
            const f32x4 g0 = *(const f32x4*)(lng + 128 * g + 8 * cch), g1 = *(const f32x4*)(lng + 128 * g + 8 * cch + 4), b0 = *(const f32x4*)(lnb + 128 * g + 8 * cch), b1 = *(const f32x4*)(lnb + 128 * g + 8 * cch + 4);
            x0 = (x0 - mean) * rstd * g0 + b0; x1 = (x1 - mean) * rstd * g1 + b1;
            LAS bf16_t* xp = (LAS bf16_t*)(XT + (8 * cch) * 272 + 2 * s);
            xp[0 * 136] = (bf16_t)f2bf(x0.x); xp[1 * 136] = (bf16_t)f2bf(x0.y); xp[2 * 136] = (bf16_t)f2bf(x0.z); xp[3 * 136] = (bf16_t)f2bf(x0.w);
            xp[4 * 136] = (bf16_t)f2bf(x1.x); xp[5 * 136] = (bf16_t)f2bf(x1.y); xp[6 * 136] = (bf16_t)f2bf(x1.z); xp[7 * 136] = (bf16_t)f2bf(x1.w);
        }
#pragma unroll
        for (int i = 0; i < 4; ++i) {
            const int q = tid + 512 * i, t = q >> 4, c16 = q & 15;
            *(LAS u32x4*)(WL + t * 272 + 16 * c16) = *(const u32x4*)(ws + WS_WSB + (size_t)(g * 128 + t) * 256 + 16 * c16);
        }
        __syncthreads();
        if (xpend) { xp_finish(xi, lane, xr, scr); xpend = false; }
        if (xk < GMLP_ITEMS) { moe_xp_item(p, gw * GMLP_ITEMS + xk, xi); xp_issue(xi, lane, xr); ++xk; xpend = true; }
        f32x4 acc[8];
#pragma unroll
        for (int cb = 0; cb < 8; ++cb) acc[cb] = (f32x4){0.f, 0.f, 0.f, 0.f};
        const int nks = (wave < 4) ? 2 : 4;
        for (int ks = 0; ks < nks; ++ks) {
            const bf16x8_t bfrag = *(const LAS bf16x8_t*)(WL + (16 * wave + l15) * 272 + (32 * ks + 8 * lg) * 2);
#pragma unroll
            for (int cb = 0; cb < 8; ++cb) { const bf16x8_t afrag = *(const LAS bf16x8_t*)(XT + (16 * cb + l15) * 272 + (32 * ks + 8 * lg) * 2);
                acc[cb] = __builtin_amdgcn_mfma_f32_16x16x32_bf16(afrag, bfrag, acc[cb], 0, 0, 0); }
        }
        const int t = 16 * wave + l15; const float bias = b_s[g * 128 + t];
        bf16_t* up = U + (size_t)(tb0 + t) * 1024 + 128 * g + 4 * lg; unsigned char* ya = ws + WS_YA8 + (size_t)(tb0 + t) * 1024 + 128 * g + 4 * lg;
#pragma unroll
        for (int cb = 0; cb < 8; ++cb) { const u32x2 uu = *(const u32x2*)(up + 16 * cb);
            const float u0 = __uint_as_float(uu.x << 16), u1 = __uint_as_float(uu.x & 0xffff0000u), u2 = __uint_as_float(uu.y << 16), u3 = __uint_as_float(uu.y & 0xffff0000u);
            *(unsigned*)(ya + 16 * cb) = pk4_f8(F8_SY * u0 * (acc[cb].x + bias), F8_SY * u1 * (acc[cb].y + bias), F8_SY * u2 * (acc[cb].z + bias), F8_SY * u3 * (acc[cb].w + bias)); }
        if (xpend) { xp_finish(xi, lane, xr, scr); xpend = false; }
        if (xk < GMLP_ITEMS) { moe_xp_item(p, gw * GMLP_ITEMS + xk, xi); xp_issue(xi, lane, xr); ++xk; xpend = true; }
        __syncthreads();
    }
    if (xpend) xp_finish(xi, lane, xr, scr);
    for (; xk < GMLP_ITEMS; ++xk) { moe_xp_item(p, gw * GMLP_ITEMS + xk, xi); xp_issue(xi, lane, xr); xp_finish(xi, lane, xr, scr); }
}
constexpr int XPG_DONE = 2048 * GMLP_ITEMS;
constexpr int XP3_W13 = 0;
constexpr int NW13_ITEMS = XP3_W13 + 2 * 2048;
__device__ __forceinline__ void lds_dma16(const void* gsrc, unsigned lds_dst) {
    unsigned keep;
    asm volatile("s_mov_b32 %0, m0\n\ts_mov_b32 m0, %2\n\ts_nop 0\n\tglobal_load_lds_dwordx4 %1, off\n\ts_mov_b32 m0, %0" : "=&s"(keep) : "v"(gsrc), "s"(lds_dst) : "memory");
}
__device__ __forceinline__ void p3_attn(const Params& p, LAS unsigned char* lds, int blk, int tid, int wave, int lane, size_t out_off, int gw, int ngw) {
    unsigned char* ws = p.ws; bf16_t* Q = (bf16_t*)(ws + WS_Q); const bf16_t* Kb = (const bf16_t*)(ws + WS_K); const bf16_t* VT = (const bf16_t*)(ws + WS_VT); const float* rel = p.in[I_REL];
    constexpr int TILE = 8192, STEPB = 4 * TILE;
    constexpr int QS_OFF = 2 * STEPB;
    static_assert(QS_OFF + 8 * 4096 <= MISC_OFF, "attention LDS map");
    LAS float* bt2 = (LAS float*)(lds + MISC_OFF + 2048);
    const int l15 = lane & 15, lg = lane >> 4;
    const unsigned onew = ((l15 & 3) == 0) ? 0x3f803f80u : 0u;
    const bf16x8_t ones = __builtin_bit_cast(bf16x8_t, (u32x4){onew, onew, onew, onew});
    const int bh = (blk & 7) * 4 + (blk >> 6), cpb = ((blk >> 3) & 7) * 8, b = bh >> 4, h = bh & 15;
    __syncthreads();
    if (tid < 384) { int idx = 575 - tid; idx = idx > 512 ? 512 : idx; bt2[tid] = rel[h * 513 + idx] * LOG2E; }
    const float bfar = rel[h * 513 + 512] * LOG2E;
    const f32x4 farv = {bfar, bfar, bfar, bfar}, negv = {-1e30f, -1e30f, -1e30f, -1e30f};
    const int srow = tid >> 3, spc = (tid & 7) ^ (((tid >> 4) & 7) ^ (((tid >> 7) & 1) << 1));
    const bf16_t* gk = Kb + (size_t)(b * SEQ + srow) * 1024 + h * 64 + 8 * spc;
    const bf16_t* gv = VT + ((size_t)((b * 16 + h) * 64 + srow)) * 8192 + 8 * spc;
    const bf16_t* gq = Q + (size_t)(b * SEQ + cpb * 128 + 16 * wave + (lane >> 3)) * 1024 + h * 64;
    const int qpc0 = (lane & 7) ^ ((lane >> 4) & 7), qpc1 = (lane & 7) ^ ((((lane >> 3) + 8) >> 1) & 7);
    const unsigned wbase = (unsigned)wave * 1024u;
    int T = 0;
    for (int i = 0; i < 4; ++i) { const int j0 = 4 - (cpb + 2 * i); T += 6 - (j0 > 0 ? j0 : 0); }
    int li = 0, ljp = (4 - cpb) > 0 ? (4 - cpb) : 0, lbuf = 0;
#define AT_DMA() do { const int _kc = 2 * (cpb + 2 * li) - 8 + 2 * ljp; const unsigned _d = (unsigned)(lbuf * STEPB) + wbase; \
        lds_dma16(gk + (size_t)_kc * 64 * 1024, _d); lds_dma16(gk + (size_t)(_kc + 1) * 64 * 1024, _d + TILE); lds_dma16(gv + _kc * 64, _d + 2 * TILE); lds_dma16(gv + (_kc + 1) * 64, _d + 3 * TILE); \
        lbuf ^= 1; if (++ljp == 6) { ++li; const int _j0 = 4 - (cpb + 2 * li); ljp = _j0 > 0 ? _j0 : 0; } } while (0)
#define AT_QDMA(unit) do { const unsigned _d = (unsigned)QS_OFF + (unsigned)wave * 4096u; const bf16_t* _g = gq + (size_t)(unit) * 256 * 1024; \
        lds_dma16(_g + 8 * qpc0, _d); lds_dma16(_g + (size_t)8 * 1024 + 8 * qpc1, _d + 1024); \
        lds_dma16(_g + (size_t)128 * 1024 + 8 * qpc0, _d + 2048); lds_dma16(_g + (size_t)136 * 1024 + 8 * qpc1, _d + 3072); } while (0)
    AT_QDMA(0);
    AT_DMA();
    asm volatile("s_waitcnt vmcnt(0)" ::: "memory");
    __builtin_amdgcn_s_barrier();
    asm volatile("" ::: "memory");
    const int xv0 = (l15 >> 1) & 7, rl = 8 * (l15 >> 2) + (l15 & 3);
    const int xk0 = ((4 * ((l15 >> 2) & 1)) + ((l15 >> 1) & 1)) ^ (2 * ((l15 >> 3) & 1));
    int kofs[2][2], vofs[2][2];
#pragma unroll
    for (int e = 0; e < 2; ++e)
#pragma unroll
        for (int ks = 0; ks < 2; ++ks) { kofs[e][ks] = rl * 128 + (((lg + 4 * ks) ^ (xk0 ^ (2 * e))) << 4); vofs[e][ks] = l15 * 128 + (((lg + 4 * ks) ^ (xv0 ^ (2 * e))) << 4); }
    const int ko0 = vofs[0][0], ko1 = vofs[0][1];
    int ci = 0, cjp = (4 - cpb) > 0 ? (4 - cpb) : 0, cbuf = 0;
    bf16_t* qp = Q + (size_t)(b * SEQ + cpb * 128 + 16 * wave + l15) * 1024 + h * 64;
    bf16x8_t qA0, qA1, qB0, qB1;
    f32x4 oA[4], oB[4], osA = {0.f, 0.f, 0.f, 0.f}, osB = {0.f, 0.f, 0.f, 0.f};
#pragma unroll
    for (int db = 0; db < 4; ++db) { oA[db] = (f32x4){0.f, 0.f, 0.f, 0.f}; oB[db] = (f32x4){0.f, 0.f, 0.f, 0.f}; }
    float mA = -1e30f, mB = -1e30f;
    const int iq = 16 * (wave & 3) + l15;
    bool ufirst = true;
    auto sblock = [&](const bf16x8_t (&kf)[4][2], const bf16x8_t& q0, const bf16x8_t& q1, int dc, f32x4* s) {
        if (dc >= 0 && dc <= 4) {
            const LAS float* bp = bt2 + (319 - dc * 64 - iq + 8 * lg);
#pragma unroll
            for (int kb = 0; kb < 4; ++kb) { const int ko = 32 * (kb >> 1) + 4 * (kb & 1); const f32x4 cin = {bp[ko], bp[ko + 1], bp[ko + 2], bp[ko + 3]};
                s[kb] = __builtin_amdgcn_mfma_f32_16x16x32_bf16(kf[kb][0], q0, cin, 0, 0, 0);
                s[kb] = __builtin_amdgcn_mfma_f32_16x16x32_bf16(kf[kb][1], q1, s[kb], 0, 0, 0); }
        } else if (dc >= 5 && dc <= 8) {
#pragma unroll
            for (int kb = 0; kb < 4; ++kb) { s[kb] = __builtin_amdgcn_mfma_f32_16x16x32_bf16(kf[kb][0], q0, farv, 0, 0, 0);
                s[kb] = __builtin_amdgcn_mfma_f32_16x16x32_bf16(kf[kb][1], q1, s[kb], 0, 0, 0); }
        } else {
#pragma unroll
            for (int kb = 0; kb < 4; ++kb) s[kb] = negv;
        }
    };
    auto smax = [&](f32x4* s, float& m, f32x4* o, f32x4& osum, bf16x8_t (&pb)[2][2]) {
        float lm = s[0].x;
#pragma unroll
        for (int kb = 0; kb < 8; ++kb) lm = fmaxf(lm, fmaxf(fmaxf(s[kb].x, s[kb].y), fmaxf(s[kb].z, s[kb].w)));
        if (__any(lm > m + 64.0f)) {
            float mx = fmaxf(lm, __shfl_xor(lm, 16)); mx = fmaxf(mx, __shfl_xor(mx, 32));
            const float mn = fmaxf(m, mx), alpha = __builtin_amdgcn_exp2f(m - mn); m = mn;
#pragma unroll
            for (int db = 0; db < 4; ++db) o[db] *= alpha;
            osum *= alpha;
        }
#pragma unroll
        for (int kb = 0; kb < 8; ++kb)
#pragma unroll
            for (int r = 0; r < 4; ++r) s[kb][r] = __builtin_amdgcn_exp2f(s[kb][r] - m);
#pragma unroll
        for (int hf = 0; hf < 2; ++hf) { pb[hf][0] = __builtin_bit_cast(bf16x8_t, pg8::pack8(s[4 * hf + 0], s[4 * hf + 1])); pb[hf][1] = __builtin_bit_cast(bf16x8_t, pg8::pack8(s[4 * hf + 2], s[4 * hf + 3])); }
    };
    for (int t = 0; t < T; ++t) {
        if (ufirst) {
            const LAS unsigned char* qs = lds + QS_OFF + wave * 4096;
            qA0 = *(const LAS bf16x8_t*)(qs + ko0); qA1 = *(const LAS bf16x8_t*)(qs + ko1); qB0 = *(const LAS bf16x8_t*)(qs + 2048 + ko0); qB1 = *(const LAS bf16x8_t*)(qs + 2048 + ko1);
            asm volatile("s_waitcnt lgkmcnt(0)" ::: "memory");
            if (ci + 1 < 4) AT_QDMA(ci + 1);
            ufirst = false; }
        const bool tile = li < 4;
        if (tile) AT_DMA();
        const int cp = cpb + 2 * ci, kc = 2 * cp - 8 + 2 * cjp, cwA = 2 * cp + (wave >> 2);
        const bool actA = cjp <= 4, actB = cjp >= 1;
        const LAS unsigned char* kb_ = lds + cbuf * STEPB; const LAS unsigned char* vb_ = kb_ + 2 * TILE;
        f32x4 sA[8], sB[8];
#pragma unroll
        for (int hf = 0; hf < 2; ++hf) {
            const LAS unsigned char* kt_ = kb_ + hf * TILE; bf16x8_t kf[4][2];
#pragma unroll
            for (int kb = 0; kb < 4; ++kb) { const LAS unsigned char* kr = kt_ + (32 * (kb >> 1) + 4 * (kb & 1)) * 128;
                kf[kb][0] = *(const LAS bf16x8_t*)(kr + kofs[kb & 1][0]); kf[kb][1] = *(const LAS bf16x8_t*)(kr + kofs[kb & 1][1]); }
            const int dcA = cwA - kc - hf;
            if (actA) sblock(kf, qA0, qA1, dcA, &sA[4 * hf]);
            if (actB) sblock(kf, qB0, qB1, dcA + 2, &sB[4 * hf]);
        }
        bf16x8_t vf[2][4][2];
#pragma unroll
        for (int hf = 0; hf < 2; ++hf)
#pragma unroll
            for (int db = 0; db < 4; ++db) { const LAS unsigned char* vr = vb_ + hf * TILE + db * 2048;
                vf[hf][db][0] = *(const LAS bf16x8_t*)(vr + vofs[db & 1][0]); vf[hf][db][1] = *(const LAS bf16x8_t*)(vr + vofs[db & 1][1]); }
        bf16x8_t pA[2][2], pB[2][2];
        if (actA) smax(sA, mA, oA, osA, pA);
        if (actB) smax(sB, mB, oB, osB, pB);
#pragma unroll
        for (int hf = 0; hf < 2; ++hf) {
#pragma unroll
            for (int db = 0; db < 4; ++db) {
                const bf16x8_t v0 = vf[hf][db][0], v1 = vf[hf][db][1];
                if (actA) { oA[db] = __builtin_amdgcn_mfma_f32_16x16x32_bf16(v0, pA[hf][0], oA[db], 0, 0, 0); oA[db] = __builtin_amdgcn_mfma_f32_16x16x32_bf16(v1, pA[hf][1], oA[db], 0, 0, 0); }
                if (actB) { oB[db] = __builtin_amdgcn_mfma_f32_16x16x32_bf16(v0, pB[hf][0], oB[db], 0, 0, 0); oB[db] = __builtin_amdgcn_mfma_f32_16x16x32_bf16(v1, pB[hf][1], oB[db], 0, 0, 0); }
            }
            if (actA) { osA = __builtin_amdgcn_mfma_f32_16x16x32_bf16(ones, pA[hf][0], osA, 0, 0, 0); osA = __builtin_amdgcn_mfma_f32_16x16x32_bf16(ones, pA[hf][1], osA, 0, 0, 0); }
            if (actB) { osB = __builtin_amdgcn_mfma_f32_16x16x32_bf16(ones, pB[hf][0], osB, 0, 0, 0); osB = __builtin_amdgcn_mfma_f32_16x16x32_bf16(ones, pB[hf][1], osB, 0, 0, 0); }
        }
        cbuf ^= 1;
        if (++cjp == 6) {
            const float invA = F8_SY / osA.x, invB = F8_SY / osB.x;
#pragma unroll
            for (int db = 0; db < 4; ++db) { *(unsigned*)(ws + WS_YB8 + (size_t)(qp - Q) + 16 * db + 4 * lg) = pk4_f8(oA[db].x * invA, oA[db].y * invA, oA[db].z * invA, oA[db].w * invA);
                *(unsigned*)(ws + WS_YB8 + (size_t)(qp - Q) + (size_t)128 * 1024 + 16 * db + 4 * lg) = pk4_f8(oB[db].x * invB, oB[db].y * invB, oB[db].z * invB, oB[db].w * invB); }
            ++ci; const int j0 = 4 - (cpb + 2 * ci); cjp = j0 > 0 ? j0 : 0; ufirst = true;
            if (ci < 4) {
                qp += (size_t)256 * 1024;
#pragma unroll
                for (int db = 0; db < 4; ++db) { oA[db] = (f32x4){0.f, 0.f, 0.f, 0.f}; oB[db] = (f32x4){0.f, 0.f, 0.f, 0.f}; }
                osA = (f32x4){0.f, 0.f, 0.f, 0.f}; osB = (f32x4){0.f, 0.f, 0.f, 0.f}; mA = -1e30f; mB = -1e30f;
            }
        }
        asm volatile("s_waitcnt vmcnt(0) lgkmcnt(0)" ::: "memory");
        __builtin_amdgcn_s_barrier();
        asm volatile("" ::: "memory");
        (void)tile;
    }
#undef AT_DMA
#undef AT_QDMA
    asm volatile("s_waitcnt vmcnt(0)" ::: "memory");
}
__device__ __forceinline__ void p6_norm2_route(const Params& p, LAS unsigned char* lds, int blk, int tid, int wave, int lane, bool dry) {
    unsigned char* ws = p.ws; const float* mod = (const float*)(ws + WS_MOD);
    LAS float* A2 = (LAS float*)lds; LAS float* S2 = A2 + D; LAS float* rs = (LAS float*)(lds + 16384);
    LAS int* hist = (LAS int*)(lds + 16640); LAS int* base = hist + 32; LAS int* ent_e = base + 32; LAS int* ent_r = ent_e + 128; LAS float* ent_w = (LAS float*)(ent_r + 128);
    LAS float* part = (LAS float*)(lds + 32768);
    const int bb = blk >> 7, l15 = lane & 15, kg = lane >> 4;
    for (int k = tid; k < D; k += NTHREADS) { A2[k] = p.in[I_N2G][k] * (1.f + mod[bb * NMOD + 4 * D + k]); S2[k] = mod[bb * NMOD + 3 * D + k]; }
    if (tid < 32) hist[tid] = 0;
    const bf16_t* x1 = (const bf16_t*)(ws + WS_X1B); unsigned char* H2 = ws + WS_H;
    for (int i = 0; i < 8; i += 4) {
        const int r = wave * 8 + i; const u32x4* xr = (const u32x4*)(x1 + (size_t)(blk * 64 + r) * D) + lane; u32x4 raw[4][4];
#pragma unroll
        for (int q = 0; q < 4; ++q)
#pragma unroll
            for (int j = 0; j < 4; ++j) raw[q][j] = xr[(size_t)q * (D / 8) + 64 * j];
#pragma unroll
        for (int q = 0; q < 4; ++q) { float ss = 0.f;
#pragma unroll
            for (int j = 0; j < 4; ++j) { f32x4 v, w; pg8::unpack8(raw[q][j], v, w); ss += ((v.x * v.x + v.y * v.y) + (v.z * v.z + v.w * v.w)) + ((w.x * w.x + w.y * w.y) + (w.z * w.z + w.w * w.w)); }
            ss = wave_sum(ss);
            if (lane == 0) rs[r + q] = rsqrtf(ss * (1.f / D) + EPS); }
    }
    __syncthreads();
    {
        float rs4[4];
#pragma unroll
        for (int rb = 0; rb < 4; ++rb) rs4[rb] = rs[16 * rb + l15];
        f32x4 acc[4][3];
#pragma unroll
        for (int rb = 0; rb < 4; ++rb)
#pragma unroll
            for (int cb = 0; cb < 3; ++cb) acc[rb][cb] = (f32x4){0.f, 0.f, 0.f, 0.f};
        const bf16_t* wrt = (const bf16_t*)(ws + WS_WRT);
        for (int kh = 0; kh < 2; ++kh) {
            const int k0 = 256 * wave + 128 * kh + 32 * kg;
            u32x4 xr[4][4];
#pragma unroll
            for (int rb = 0; rb < 4; ++rb)
#pragma unroll
                for (int j = 0; j < 4; ++j) xr[rb][j] = *(const u32x4*)(x1 + (size_t)(blk * 64 + 16 * rb + l15) * D + k0 + 8 * j);
            unsigned f8w[4][8];
#pragma unroll
            for (int j = 0; j < 4; ++j) {
                const f32x4 a0 = *(const LAS f32x4*)(A2 + k0 + 8 * j), a1 = *(const LAS f32x4*)(A2 + k0 + 8 * j + 4), s0 = *(const LAS f32x4*)(S2 + k0 + 8 * j), s1 = *(const LAS f32x4*)(S2 + k0 + 8 * j + 4);
                bf16x8_t bh[3], bl[3];
#pragma unroll
                for (int cb = 0; cb < 3; ++cb) { bh[cb] = *(const bf16x8_t*)(wrt + (size_t)(16 * cb + l15) * D + k0 + 8 * j); bl[cb] = *(const bf16x8_t*)(wrt + (size_t)(48 + 16 * cb + l15) * D + k0 + 8 * j); }
#pragma unroll
                for (int rb = 0; rb < 4; ++rb) {
                    f32x4 x0, x1v; pg8::unpack8(xr[rb][j], x0, x1v);
                    const f32x4 h0 = x0 * rs4[rb] * a0 + s0, h1 = x1v * rs4[rb] * a1 + s1;
                    const u32x4 hw = pg8::pack8(h0, h1);
                    f8w[rb][2 * j] = pk4_f8(h0.x * F8_SH2, h0.y * F8_SH2, h0.z * F8_SH2, h0.w * F8_SH2); f8w[rb][2 * j + 1] = pk4_f8(h1.x * F8_SH2, h1.y * F8_SH2, h1.z * F8_SH2, h1.w * F8_SH2);
                    f32x4 c0, c1; pg8::unpack8(hw, c0, c1);
                    const u32x4 lw = pg8::pack8(h0 - c0, h1 - c1);
                    const bf16x8_t hi = __builtin_bit_cast(bf16x8_t, hw), lo = __builtin_bit_cast(bf16x8_t, lw);
#pragma unroll
                    for (int cb = 0; cb < 3; ++cb) {
                        acc[rb][cb] = __builtin_amdgcn_mfma_f32_16x16x32_bf16(hi, bh[cb], acc[rb][cb], 0, 0, 0);
                        acc[rb][cb] = __builtin_amdgcn_mfma_f32_16x16x32_bf16(lo, bh[cb], acc[rb][cb], 0, 0, 0);
                        acc[rb][cb] = __builtin_amdgcn_mfma_f32_16x16x32_bf16(hi, bl[cb], acc[rb][cb], 0, 0, 0);
                    }
                }
            }
#pragma unroll
            for (int rb = 0; rb < 4; ++rb) { unsigned char* hp = H2 + (size_t)(blk * 64 + 16 * rb + l15) * D + k0;
                *(u32x4*)hp = (u32x4){f8w[rb][0], f8w[rb][1], f8w[rb][2], f8w[rb][3]}; *(u32x4*)(hp + 16) = (u32x4){f8w[rb][4], f8w[rb][5], f8w[rb][6], f8w[rb][7]}; }
        }
#pragma unroll
        for (int rb = 0; rb < 4; ++rb)
#pragma unroll
            for (int cb = 0; cb < 3; ++cb)
#pragma unroll
                for (int rr = 0; rr < 4; ++rr) part[(wave * 64 + 16 * rb + 4 * kg + rr) * 48 + 16 * cb + l15] = acc[rb][cb][rr];
    }
    __syncthreads();
    for (int q = tid; q < 64 * 48; q += NTHREADS) { float s = 0.f;
#pragma unroll
        for (int w = 0; w < 8; ++w) s += part[w * 64 * 48 + q];
        part[q] = s; }
    __syncthreads();
    if (tid < 64) {
        const LAS float* lg = part + tid * 48;
        const float g0 = lg[0], g1 = lg[1], g2 = lg[2], g3 = lg[3];
        int g = 0; float gm = g0;
        if (g1 > gm) { gm = g1; g = 1; } if (g2 > gm) { gm = g2; g = 2; } if (g3 > gm) { gm = g3; g = 3; }
        const float gweight = 1.f / (expf(g0 - gm) + expf(g1 - gm) + expf(g2 - gm) + expf(g3 - gm));
        const LAS float* el = lg + 4 + 8 * g;
        int i1 = 0; float m1 = el[0];
        for (int q = 1; q < 8; ++q) { const float v = el[q]; if (v > m1) { m1 = v; i1 = q; } }
        int i2 = -1; float m2 = -3.0e38f;
        for (int q = 0; q < 8; ++q) { const float v = el[q]; if (q != i1 && v > m2) { m2 = v; i2 = q; } }
        const float t = expf(m2 - m1), p1 = 1.f / (1.f + t), p2 = t / (1.f + t);
        const int e1 = g * 8 + i1, e2 = g * 8 + i2;
        ent_e[2 * tid] = e1; ent_r[2 * tid] = __hip_atomic_fetch_add(hist + e1, 1, __ATOMIC_RELAXED, __HIP_MEMORY_SCOPE_WORKGROUP); ent_w[2 * tid] = gweight * p1;
        ent_e[2 * tid + 1] = e2; ent_r[2 * tid + 1] = __hip_atomic_fetch_add(hist + e2, 1, __ATOMIC_RELAXED, __HIP_MEMORY_SCOPE_WORKGROUP); ent_w[2 * tid + 1] = gweight * p2;
    }
    __syncthreads();
    unsigned* ctl = (unsigned*)(ws + WS_CTL);
    if (tid < 32) base[tid] = (hist[tid] && !dry) ? (int)__hip_atomic_fetch_add(ctl + CW_CNT + 64 * tid, (unsigned)hist[tid], __ATOMIC_RELAXED, __HIP_MEMORY_SCOPE_AGENT) : 0;
    __syncthreads();
    if (tid < 128 && !dry) {
        const int e = ent_e[tid], idx = base[e] + ent_r[tid], slot = (blk * 64 + (tid >> 1)) * 2 + (tid & 1);
        ((int*)(ws + WS_TOKLIST))[e * 16384 + idx] = slot; ((int*)(ws + WS_SLOTE))[slot] = e * 16384 + idx; ((float*)(ws + WS_ROWW))[e * 16384 + idx] = ent_w[tid];
    }
    __syncthreads();
}
__device__ __forceinline__ void p9_final(const Params& p, LAS unsigned char* lds, const MoeTab& T, int blk, int tid, int wave, int lane, bool build, size_t dry_off, unsigned char* dry_base) {
    unsigned char* ws = p.ws; const float* mod = (const float*)(ws + WS_MOD);
    if (build) build_tables((const unsigned*)(ws + WS_CTL), T, tid);
    const int bb = blk >> 7; const float* g2 = mod + bb * NMOD + 5 * D; const float* fg = p.in[I_FING];
    const unsigned char* YS = (const unsigned char*)(ws + WS_YS); const int* slote = (const int*)(ws + WS_SLOTE);
    for (int i = 0; i < 8; ++i) {
        const int row = blk * 64 + wave * 8 + i;
        const int se0 = slote[2 * row], se1 = slote[2 * row + 1];
        const size_t p0 = (size_t)T.tb[se0 >> 14] * 256 + (se0 & 16383), p1 = (size_t)T.tb[se1 >> 14] * 256 + (se1 & 16383);
        f32x4* xr = (f32x4*)(p.out + (size_t)row * D) + lane; const u32x2* x1r = (const u32x2*)((const bf16_t*)(ws + WS_X1B) + (size_t)row * D) + lane;
        const unsigned* y0 = (const unsigned*)(YS + p0 * D) + lane; const unsigned* y1 = (const unsigned*)(YS + p1 * D) + lane;
        f32x4 v[8]; float ss = 0.f;
#pragma unroll
        for (int j = 0; j < 8; ++j) { const u32x2 xw = __builtin_nontemporal_load(x1r + 64 * j); const f32x4 xv = {__uint_as_float(xw.x << 16), __uint_as_float(xw.x & 0xffff0000u), __uint_as_float(xw.y << 16), __uint_as_float(xw.y & 0xffff0000u)}; const unsigned a = __builtin_nontemporal_load(y0 + 64 * j), b = __builtin_nontemporal_load(y1 + 64 * j); const f32x4 gg = *(const f32x4*)(g2 + 256 * j + 4 * lane) * (1.0f / 64.0f);
            f32x4 ys; ys.x = __builtin_amdgcn_cvt_f32_fp8(a, 0) + __builtin_amdgcn_cvt_f32_fp8(b, 0); ys.y = __builtin_amdgcn_cvt_f32_fp8(a, 1) + __builtin_amdgcn_cvt_f32_fp8(b, 1);
            ys.z = __builtin_amdgcn_cvt_f32_fp8(a, 2) + __builtin_amdgcn_cvt_f32_fp8(b, 2); ys.w = __builtin_amdgcn_cvt_f32_fp8(a, 3) + __builtin_amdgcn_cvt_f32_fp8(b, 3);
            v[j] = xv + gg * ys; ss += (v[j].x * v[j].x + v[j].y * v[j].y) + (v[j].z * v[j].z + v[j].w * v[j].w); }
        const float rstd = rsqrtf(wave_sum(ss) * (1.f / D) + EPS);
        f32x4* xo = dry_base ? (f32x4*)(dry_base + dry_off + (size_t)row * D * 4) + lane : xr;
#pragma unroll
        for (int j = 0; j < 8; ++j) { const f32x4 f = *(const f32x4*)(fg + 256 * j + 4 * lane); xo[64 * j] = v[j] * rstd * f; }
    }
}

__device__ __forceinline__ void rowquant2048(const bf16_t* src, unsigned char* dst, float* step, int gw, int lane) {
    for (int i = 0; i < 8; i += 4) {
        const int row = gw * 8 + i; u32x4 raw[4][4];
#pragma unroll
        for (int r = 0; r < 4; ++r)
#pragma unroll
            for (int j = 0; j < 4; ++j) raw[r][j] = *((const u32x4*)(src + (size_t)(row + r) * D) + lane + 64 * j);
#pragma unroll
        for (int r = 0; r < 4; ++r) {
            f32x4 v[4][2]; float am = 0.f;
#pragma unroll
            for (int j = 0; j < 4; ++j) { pg8::unpack8(raw[r][j], v[j][0], v[j][1]);
#pragma unroll
                for (int h = 0; h < 2; ++h) am = fmaxf(fmaxf(am, fmaxf(fabsf(v[j][h].x), fabsf(v[j][h].y))), fmaxf(fabsf(v[j][h].z), fabsf(v[j][h].w))); }
            am = wave_max(am); const float sq = am > 0.f ? 127.f / am : 0.f;
            if (lane == 0) step[row + r] = am * (1.f / 127.f);
#pragma unroll
            for (int j = 0; j < 4; ++j) { const f32x4 a = v[j][0] * sq + I8MAGIC, b = v[j][1] * sq + I8MAGIC;
                u32x2 o; o.x = pack4_i8(__float_as_uint(a.x), __float_as_uint(a.y), __float_as_uint(a.z), __float_as_uint(a.w)); o.y = pack4_i8(__float_as_uint(b.x), __float_as_uint(b.y), __float_as_uint(b.z), __float_as_uint(b.w));
                *((u32x2*)(dst + (size_t)(row + r) * D) + lane + 64 * j) = o; }
        }
    }
}

__device__ __forceinline__ void xq_issue(const XpItem& x, int lane, f32x4 (&v)[8]) {
    const float* q = x.src + (size_t)(lane >> 3) * x.ldw + 4 * (lane & 7); const size_t step = (size_t)8 * x.ldw;
#pragma unroll
    for (int i = 0; i < 8; ++i) { v[i] = __builtin_nontemporal_load((const f32x4*)q); q += step; asm volatile("" : "+v"(q)); }
}
__device__ __forceinline__ void xq_finish(const XpItem& x, int lane, const f32x4 (&v)[8], LAS float* scr) {
#pragma unroll
    for (int i = 0; i < 8; ++i) { LAS float* d = scr + (8 * i + (lane >> 3)) * 33 + 4 * (lane & 7); d[0] = v[i].x; d[1] = v[i].y; d[2] = v[i].z; d[3] = v[i].w; }
    asm volatile("s_waitcnt lgkmcnt(0)" ::: "memory");
    const int cch = lane & 7;
#pragma unroll
    for (int j = 0; j < 4; ++j) { const int n = (lane >> 3) + 8 * j; const LAS float* s = scr + (8 * cch) * 33 + n;
        u32x2 o; o.x = pk4_f8(s[0 * 33] * F8_SW, s[1 * 33] * F8_SW, s[2 * 33] * F8_SW, s[3 * 33] * F8_SW); o.y = pk4_f8(s[4 * 33] * F8_SW, s[5 * 33] * F8_SW, s[6 * 33] * F8_SW, s[7 * 33] * F8_SW);
        *(u32x2*)(x.dst + (size_t)n * x.ldd + 8 * cch) = o; }
    asm volatile("s_waitcnt lgkmcnt(0)" ::: "memory");
}
__device__ __forceinline__ void xh_decode(const Params& p, int R, XpItem& x) {
    const int which = R >> 13, r = R & 8191, e = r >> 8, q = r & 255, kb = q >> 4, nb = q & 15, f0 = 32 * nb;
    x.src = p.in[which ? I_W3 : I_W1] + (size_t)e * D * FE + (size_t)(128 * kb) * FE + f0; x.ldw = FE;
    x.dst = p.ws + WS_W13_T + ((size_t)e * 1024 + 256 * (f0 >> 7) + 128 * which + (f0 & 127)) * D + 128 * kb; x.ldd = D; x.f8 = 1;
}
__device__ __forceinline__ void xh_decode_w2(const Params& p, int R, XpItem& x) {
    const int e = R >> 8, q = R & 255, kb = q >> 6, nb = q & 63;
    x.src = p.in[I_W2] + (size_t)e * FE * D + (size_t)(128 * kb) * D + 32 * nb; x.ldw = D;
    x.dst = p.ws + WS_W2_T + ((size_t)e * D + 32 * nb) * FE + 128 * kb; x.ldd = FE; x.f8 = 1;
}
__device__ __forceinline__ void xh_decode_br(const Params& p, int r, XpItem& x) {
    const int which = r >> 9, q = r & 511, kb = q >> 6, nb = q & 63;
    x.src = p.in[which ? I_WB : I_WA] + (size_t)(128 * kb) * D + 32 * nb; x.ldw = D;
    x.dst = p.ws + (which ? WS_WB_T : WS_WA_T) + (size_t)(32 * nb) * 1024 + 128 * kb; x.ldd = 1024; x.f8 = 1;
}
__device__ __forceinline__ void xh_issue(const XpItem& x, int lane, f32x4 (&v)[16]) {
    const float* q = x.src + (size_t)(lane >> 3) * x.ldw + 4 * (lane & 7); const size_t step = (size_t)8 * x.ldw;
#pragma unroll
    for (int i = 0; i < 16; ++i) { v[i] = __builtin_nontemporal_load((const f32x4*)q); q += step; asm volatile("" : "+v"(q)); }
}
template <bool NT>
__device__ __forceinline__ void xh_finish(const XpItem& x, int lane, const f32x4 (&v)[16], LAS float* scr) {
#pragma unroll
    for (int i = 0; i < 16; ++i) { LAS f32x4* d = (LAS f32x4*)(scr + (8 * i + (lane >> 3)) * 32 + 4 * ((lane & 7) ^ (i >> 1)));
        *d = (i & 1) ? (f32x4){v[i].z, v[i].w, v[i].x, v[i].y} : v[i]; }
    asm volatile("s_waitcnt lgkmcnt(0)" ::: "memory");
    const int cch = lane & 15;
#pragma unroll
    for (int j = 0; j < 8; ++j) { const int n = (lane >> 4) + 4 * j; const LAS float* s = scr + (8 * cch) * 32 + (n ^ (2 * cch));
        u32x2 o; o.x = pk4_f8(s[0 * 32] * F8_SW, s[1 * 32] * F8_SW, s[2 * 32] * F8_SW, s[3 * 32] * F8_SW); o.y = pk4_f8(s[4 * 32] * F8_SW, s[5 * 32] * F8_SW, s[6 * 32] * F8_SW, s[7 * 32] * F8_SW);
        if (NT) __builtin_nontemporal_store(o, (u32x2*)(x.dst + (size_t)n * x.ldd + 8 * cch)); else *(u32x2*)(x.dst + (size_t)n * x.ldd + 8 * cch) = o; }
    asm volatile("s_waitcnt lgkmcnt(0)" ::: "memory");
}
__device__ __forceinline__ void p2_w13_convert(const Params& p, LAS unsigned char* lds, int gw, int ngw, int wave, int lane) {
    LAS float* scr = (LAS float*)(lds + wave * 17408);
    XpItem x0, x1; x0.src = nullptr; x0.dst = nullptr; x0.ldw = 0; x0.ldd = 0; x0.f8 = 1; x1 = x0; f32x4 r0[16], r1[16];
    int it = gw; bool p0 = false, p1 = false;
#define P2C_ISSUE(X, R, P) do { if (it < NEXP * 512 + 1024) { if (it < NEXP * 512) xh_decode(p, it, X); else xh_decode_br(p, it - NEXP * 512, X); xh_issue(X, lane, R); P = true; it += ngw; } } while (0)
#define P2C_STEP(X, R, P) do { if (P) { xh_finish<true>(X, lane, R, scr); P = false; P2C_ISSUE(X, R, P); } } while (0)
    P2C_ISSUE(x0, r0, p0); P2C_ISSUE(x1, r1, p1);
    while (p0 || p1) { P2C_STEP(x0, r0, p0); P2C_STEP(x1, r1, p1); }
#undef P2C_ISSUE
#undef P2C_STEP
}

__device__ __forceinline__ void p7_w2_convert(const Params& p, LAS unsigned char* lds, int first, int stride, int wave, int lane) {
    LAS float* scr = (LAS float*)(lds + wave * 17408);
    XpItem x0, x1; x0.src = nullptr; x0.dst = nullptr; x0.ldw = 0; x0.ldd = 0; x0.f8 = 1; x1 = x0; f32x4 r0[16], r1[16];
    int it = first; bool p0 = false, p1 = false;
#define P7C_ISSUE(X, R, P) do { if (it < NEXP * 256) { xh_decode_w2(p, it, X); xh_issue(X, lane, R); P = true; it += stride; } } while (0)
#define P7C_STEP(X, R, P) do { if (P) { xh_finish<false>(X, lane, R, scr); P = false; P7C_ISSUE(X, R, P); } } while (0)
    P7C_ISSUE(x0, r0, p0); P7C_ISSUE(x1, r1, p1);
    while (p0 || p1) { P7C_STEP(x0, r0, p0); P7C_STEP(x1, r1, p1); }
#undef P7C_ISSUE
#undef P7C_STEP
}

__global__ void __launch_bounds__(NTHREADS, 2) mk_fwd(Params p) {
    extern __shared__ __attribute__((aligned(16))) unsigned char lds_raw[];
    LAS unsigned char* lds = (LAS unsigned char*)lds_raw;
    const int wave = __builtin_amdgcn_readfirstlane(threadIdx.x >> 6);
    const int G = gridDim.x, blk = blockIdx.x, gw = blk * NWAVES + wave, ngw = G * NWAVES;
#define FRESH_IDS const int lane = fresh_lane(), tid = wave * 64 + lane; (void)tid; (void)lane
    MoeTab T{(LAS int*)(lds + MISC_OFF + 64), (LAS int*)(lds + MISC_OFF + 256), (LAS int*)(lds + MISC_OFF + 512)};
    const int lo = p.ph_lo, hi = p.ph_hi;
    if (threadIdx.x < 4) ((LAS unsigned*)(lds + MISC_OFF))[threadIdx.x] = 0u;
    __syncthreads();
    XcdBarrier bar = xcd_barrier_post((unsigned*)(p.ws + WS_CTL) + CW_BAR, (volatile LAS unsigned*)(lds + MISC_OFF));
#define IN(k) (lo <= (k) && (k) < hi)
#define SEAM(k) do { if (IN(k) && IN((k) + 1)) xcd_barrier(bar); } while (0)
    if (IN(0)) { FRESH_IDS; p0_prologue(p, lds, gw, ngw, wave, lane); }
    SEAM(0);
    if (IN(1)) { FRESH_IDS; p1_norm1(p, lds, blk, tid, wave, lane); }
    SEAM(1);
    unsigned char* ws = p.ws;
    if (IN(2)) {
        pg8::SchedGrid S{(const char*)(ws + WS_H), (const char*)(ws + WS_WIN_T), D / 2, D / 2, 64, 36, G, blk};
        pg8::EpiProj E{(bf16_t*)(p.alt), (bf16_t*)(p.alt + (WS_V - WS_U)), (bf16_t*)(p.alt + (WS_Q - WS_U)), (bf16_t*)(p.alt + (WS_K - WS_U)), (bf16_t*)(p.alt + (WS_VT - WS_U)), (bf16_t*)p.altg,
                       (const float*)(ws + WS_HSC), (const float*)(ws + WS_CS)};
        const bool early = (blk >> 3) & 1;
        if (early) { FRESH_IDS; p2_ada_late(p, blk, wave, lane); p2_w13_convert(p, lds, gw, ngw, wave, lane); __syncthreads(); }
        pg8::gemm_phase(lds, D / 2, S, E, wave);
        if (!early) { FRESH_IDS; p2_ada_late(p, blk, wave, lane); p2_w13_convert(p, lds, gw, ngw, wave, lane); }
    }
    SEAM(2);
    if (IN(3)) { FRESH_IDS;
        if (blk < 96 && tid < 256) {
            const float* modp = (const float*)(ws + WS_MODP); const int j = blk * 256 + tid, b2 = j / NMOD, col = j % NMOD; float v = p.in[I_ADAB][col];
            for (int q = 0; q < 32; ++q) v += modp[(size_t)(q * 2 + b2) * NMOD + col];
            ((float*)(ws + WS_MOD))[j] = v; }
        p3_attn(p, lds, blk, tid, wave, lane, 0, gw, ngw); __syncthreads(); p3_gmlp(p, lds, blk, tid, wave, lane, 0, gw); }
    SEAM(3);
    if (IN(4)) {
        pg8::SchedBranch S{(const char*)(ws + WS_YA8), (const char*)(ws + WS_WA_T), (const char*)(ws + WS_YB8), (const char*)(ws + WS_WB_T), G, blk};
        pg8::EpiBranch E{(const unsigned short*)(ws + WS_G), (bf16_t*)(ws + WS_MIX), {}};
        pg8::gemm_phase(lds, 512, S, E, wave);
    }
    SEAM(4);
    if (IN(5)) {
        { FRESH_IDS; rowquant2048((const bf16_t*)(ws + WS_MIX), ws + WS_V, (float*)(ws + WS_SM), gw, lane); }
        xcd_barrier(bar);
        pg8::SchedGrid S{(const char*)(ws + WS_V), (const char*)(ws + WS_WOUT_T), D / 2, D / 2, 64, 8, G, blk};
        pg8::EpiOut E{p.in[I_X], (const float*)(ws + WS_MOD), (bf16_t*)(ws + WS_X1B), (const float*)(ws + WS_SM), (const float*)(ws + WS_CSO)};
        pg8::gemm_phase(lds, D / 2, S, E, wave);
    }
    SEAM(5);
    if (IN(6)) { FRESH_IDS; p6_norm2_route(p, lds, blk, tid, wave, lane, false); }
    SEAM(6);
    if (IN(7)) {
        { FRESH_IDS; build_tables((const unsigned*)(ws + WS_CTL), T, tid); }
        LAS int* ltok = (LAS int*)(lds + MISC_OFF + 4096);
        { FRESH_IDS; const int* toklist = (const int*)(ws + WS_TOKLIST);
          if (tid < 256) for (int i = 0; i < 3; ++i) { const int L = i * G + blk, rt = L >> 2; if (rt < T.tb[NEXP]) { const int e = T.rte[rt], r0 = (rt - T.tb[e]) * 256, nv = T.cn[e] - r0; ltok[i * 256 + tid] = toklist[e * 16384 + r0 + (tid < nv ? tid : 0)] >> 1; } }
          __syncthreads(); }
        pg8::SchedMoeUp S{(const char*)(ws + WS_H), (const char*)(ws + WS_W13_T), (const LAS int*)ltok, T, G, blk};
        pg8::EpiMoeUp E{ws + WS_ACT};
        pg8::gemm_phase(lds, D / 2, S, E, wave);
        {
            FRESH_IDS; const int U = 4 * T.tb[NEXP], fi = (U - 2 * G) > 0 ? (U - 2 * G) : 0;
            if (blk >= fi) { const int nidle = G - fi; p7_w2_convert(p, lds, (blk - fi) * NWAVES + wave, nidle * NWAVES, wave, lane); }
        }
    }
    SEAM(7);
    if (IN(8)) {
        if (lo == 8) { FRESH_IDS; build_tables((const unsigned*)(ws + WS_CTL), T, tid); }
        pg8::SchedMoeDown S{(const char*)(ws + WS_ACT), (const char*)(ws + WS_W2_T), T, G, blk};
        pg8::EpiMoeDown E{(const float*)(ws + WS_ROWW), (unsigned char*)(ws + WS_YS)};
        pg8::gemm_phase(lds, FE / 2, S, E, wave);
    }
    SEAM(8);
    if (IN(9)) { FRESH_IDS; p9_final(p, lds, T, blk, tid, wave, lane, lo == 9, 0, nullptr); }
#undef IN
#undef SEAM
}

extern "C" void kernel_launch(void* const* d_in, const int* in_sizes, int n_in, void* d_out, int out_size, void* d_ws, size_t ws_size, hipStream_t stream) {
    static int grid = 0;
    if (grid == 0) {
        if (n_in != 21 || out_size != M * D || ws_size < WS_END) { fprintf(stderr, "kernel_launch: unexpected problem (n_in %d out %d ws %zu)\n", n_in, out_size, ws_size); grid = -1; return; }
        if (hipFuncSetAttribute((const void*)mk_fwd, hipFuncAttributeMaxDynamicSharedMemorySize, LDS_BYTES) != hipSuccess) { fprintf(stderr, "kernel_launch: hipFuncSetAttribute failed\n"); grid = -1; return; }
        int dev = 0, cus = 0, per_cu = 0;
        if (hipGetDevice(&dev) != hipSuccess || hipDeviceGetAttribute(&cus, hipDeviceAttributeMultiprocessorCount, dev) != hipSuccess) { fprintf(stderr, "kernel_launch: device query failed\n"); grid = -1; return; }
        if (hipOccupancyMaxActiveBlocksPerMultiprocessor(&per_cu, (const void*)mk_fwd, NTHREADS, LDS_BYTES) != hipSuccess) per_cu = 0;
        (void)hipGetLastError();
        if (cus != 256 || per_cu < 1) { fprintf(stderr, "kernel_launch: built for 256 CUs with one resident workgroup each (got %d CUs, %d per CU)\n", cus, per_cu); grid = -1; return; }
        grid = 256;
    }
    if (grid < 0) return;
    unsigned char* ws = (unsigned char*)d_ws;
    (void)hipMemsetAsync(ws + WS_CTL, 0, CTL_BYTES, stream);
    Params p{};
    for (int i = 0; i < 21; ++i) p.in[i] = (const float*)d_in[i];
    p.out = (float*)d_out; p.ws = ws; p.alt = ws + WS_U; p.altg = (float*)(ws + WS_G);
    auto frame = [&](int lo, int hi) { p.ph_lo = lo; p.ph_hi = hi; hipLaunchKernelGGL(mk_fwd, dim3(grid), dim3(NTHREADS), LDS_BYTES, stream, p); };
    frame(0, 10);
}
```
